# Optimizing an MI355X kernel written in HIP

```python
import jax, jax.numpy as jnp
from jax import lax
import numpy as np

D_MODEL = 1024
BATCH = 2
SEQ = 8192
DEPTH = 2

HEAD_DIM = 64
ROPE_THETA = 10000.0
NORM_EPS = 1e-6
BLOCK = 128
A_CONFIGS = ((128, 1), (512, 4), (2048, 16))
A_HEADS_PER_GROUP = 8
A_HEADS = A_HEADS_PER_GROUP * len(A_CONFIGS)
A_WIDTH = A_HEADS_PER_GROUP * HEAD_DIM
B_Q_HEADS = 8
B_KV_HEADS = 2
B_GROUP = B_Q_HEADS // B_KV_HEADS
B_WINDOW = 128
B_WIDTH = B_Q_HEADS * HEAD_DIM
C_HEADS = 4
C_DK = 64
C_DV = 128
C_GATE_RANK = 16
C_TAU = 16.0
C_CHUNK = 64
C_WIDTH = C_HEADS * C_DV
N_BRANCH = 3
BRANCH_WIDTH = 512
D_FF = 2816
IN_WIDTHS = (3 * A_HEADS * HEAD_DIM,
             B_Q_HEADS * HEAD_DIM,
             2 * B_KV_HEADS * HEAD_DIM,
             C_HEADS * C_DK,
             C_HEADS * C_DK,
             C_HEADS * C_DV,
             C_GATE_RANK,
             C_WIDTH,
             N_BRANCH * D_MODEL)
IN_WIDTH = sum(IN_WIDTHS)

kernel_name = 'hybrid_gated_dilated_swa_gla'


def rmsnorm(x, g):
    x32 = x.astype(jnp.float32)
    y = x32 * lax.rsqrt(jnp.mean(x32 * x32, axis=-1, keepdims=True) + NORM_EPS)
    return (y * g.astype(jnp.float32)).astype(x.dtype)


def swiglu(h, w_in, w_out):
    g, u = jnp.split(h @ w_in, 2, axis=-1)
    return (jax.nn.silu(g) * u) @ w_out


def rope_tables(positions):
    inv = ROPE_THETA ** (-jnp.arange(0, HEAD_DIM, 2, dtype=jnp.float32) / HEAD_DIM)
    ang = positions.astype(jnp.float32)[..., None] * inv
    return jnp.cos(ang)[:, :, None, :], jnp.sin(ang)[:, :, None, :]


def apply_rope(x, cos, sin):
    x1, x2 = jnp.split(x.astype(jnp.float32), 2, axis=-1)
    return jnp.concatenate([x1 * cos - x2 * sin, x2 * cos + x1 * sin], axis=-1).astype(x.dtype)


def band_attention(q, k, v, window, sink):
    bq, n, hkv, grp, hd = q.shape
    nb = -(-n // BLOCK)
    pad = nb * BLOCK - n
    qb = jnp.pad(q, ((0, 0), (0, pad), (0, 0), (0, 0), (0, 0))).reshape(bq, nb, BLOCK, hkv, grp, hd)

    def key_windows(t):
        tb = jnp.pad(t, ((0, 0), (BLOCK, pad), (0, 0), (0, 0))).reshape(bq, nb + 1, BLOCK, hkv, hd)
        return jnp.concatenate([tb[:, :-1], tb[:, 1:]], axis=2)

    kw, vw = key_windows(k), key_windows(v)
    s = jnp.einsum('bnqkgd,bnskd->bnkgqs', qb, kw).astype(jnp.float32) * (hd ** -0.5)
    qi = jnp.arange(BLOCK)[:, None]
    kj = jnp.arange(2 * BLOCK)[None, :]
    dist = qi + BLOCK - kj
    key_pos = jnp.arange(nb)[:, None, None] * BLOCK + kj - BLOCK
    valid = (dist >= 0) & (dist <= window) & (key_pos >= 0)
    s = jnp.where(valid[None, :, None, None], s, -jnp.inf)
    m = jnp.max(s, axis=-1)
    if sink is not None:
        sk = sink.astype(jnp.float32)[None, None, :, :, None]
        m = jnp.maximum(m, sk)
    p = jnp.exp(s - m[..., None])
    denom = jnp.sum(p, axis=-1)
    if sink is not None:
        denom = denom + jnp.exp(sk - m)
    o = jnp.einsum('bnkgqs,bnskd->bnqkgd', p / denom[..., None], vw.astype(jnp.float32))
    o = o.reshape(bq, nb * BLOCK, hkv, grp, hd)[:, :n].astype(q.dtype)
    lse = (m + jnp.log(denom)).transpose(0, 1, 4, 2, 3).reshape(bq, nb * BLOCK, hkv, grp)[:, :n]
    return o, lse


def dilated_group(q, k, v, window, dilation):
    bn, s, hh, hd = q.shape
    n = s // dilation

    def to_classes(t):
        return t.reshape(bn, n, dilation, hh, hd).transpose(0, 2, 1, 3, 4).reshape(bn * dilation, n, hh, hd)

    o, lse = band_attention(to_classes(q)[:, :, :, None, :], to_classes(k), to_classes(v),
                            window // dilation, None)
    o = o[:, :, :, 0].reshape(bn, dilation, n, hh, hd).transpose(0, 2, 1, 3, 4).reshape(bn, s, hh, hd)
    lse = lse[:, :, :, 0].reshape(bn, dilation, n, hh).transpose(0, 2, 1, 3).reshape(bn, s, hh)
    return o, lse


def dilated_mixer(q, k, v):
    bn, s = q.shape[:2]
    outs, lses = [], []
    for g, (window, dilation) in enumerate(A_CONFIGS):
        sl = slice(g * A_HEADS_PER_GROUP, (g + 1) * A_HEADS_PER_GROUP)
        o, lse = dilated_group(q[:, :, sl], k[:, :, sl], v[:, :, sl], window, dilation)
        outs.append(o)
        lses.append(lse)
    w = jax.nn.softmax(jnp.stack(lses, axis=2), axis=2)
    o = jnp.sum(w[..., None] * jnp.stack(outs, axis=2).astype(jnp.float32), axis=2)
    return o.reshape(bn, s, A_WIDTH).astype(q.dtype)


def gla_chunked(q, k, v, log_g):
    bn, s, hh, dk = q.shape
    dv = v.shape[-1]
    nc = s // C_CHUNK

    def chunks(t):
        return t.astype(jnp.float32).reshape(bn, nc, C_CHUNK, hh, t.shape[-1]).transpose(1, 0, 3, 2, 4)

    qc = chunks(q) * (dk ** -0.5)
    kc, vc, gc = chunks(k), chunks(v), chunks(log_g)
    causal = jnp.tril(jnp.ones((C_CHUNK, C_CHUNK), dtype=bool))[:, :, None]

    def step(state, inp):
        qi, ki, vi, gi = inp
        b = jnp.cumsum(gi, axis=-2)
        o_inter = jnp.einsum('bhtd,bhde->bhte', qi * jnp.exp(b), state)
        diff = b[:, :, :, None, :] - b[:, :, None, :, :]
        decay = jnp.where(causal, jnp.exp(jnp.where(causal, diff, 0.0)), 0.0)
        att = jnp.einsum('bhtd,bhsd,bhtsd->bhts', qi, ki, decay)
        o_intra = jnp.einsum('bhts,bhse->bhte', att, vi)
        b_last = b[:, :, -1:, :]
        new_state = (jnp.exp(b_last[:, :, 0, :])[..., None] * state
                     + jnp.einsum('bhsd,bhse->bhde', ki * jnp.exp(b_last - b), vi))
        return new_state, o_inter + o_intra

    state0 = jnp.zeros((bn, hh, dk, dv), jnp.float32)
    _, o = lax.scan(step, state0, (qc, kc, vc, gc))
    return o.transpose(1, 0, 3, 2, 4).reshape(bn, s, hh, dv).astype(q.dtype)


def hybrid_mixer(h, cos, sin, w_in, a_q_norm, a_k_norm, b_q_norm, b_k_norm, b_sinks,
                 c_gate_up, c_gate_bias, c_out_norm, w_branch, w_out):
    bn, s, _ = h.shape
    splits = np.cumsum(IN_WIDTHS)[:-1].tolist()
    a_qkv, b_q, b_kv, c_q, c_k, c_v, c_glow, c_r, gate_pre = jnp.split(h @ w_in, splits, axis=-1)
    a_qkv = a_qkv.reshape(bn, s, 3, A_HEADS, HEAD_DIM)
    a_q = apply_rope(rmsnorm(a_qkv[:, :, 0], a_q_norm), cos, sin)
    a_k = apply_rope(rmsnorm(a_qkv[:, :, 1], a_k_norm), cos, sin)
    y_a = dilated_mixer(a_q, a_k, a_qkv[:, :, 2])
    b_q = apply_rope(rmsnorm(b_q.reshape(bn, s, B_Q_HEADS, HEAD_DIM), b_q_norm), cos, sin)
    b_kv = b_kv.reshape(bn, s, 2, B_KV_HEADS, HEAD_DIM)
    b_k = apply_rope(rmsnorm(b_kv[:, :, 0], b_k_norm), cos, sin)
    o_b, _ = band_attention(b_q.reshape(bn, s, B_KV_HEADS, B_GROUP, HEAD_DIM), b_k, b_kv[:, :, 1],
                            B_WINDOW - 1, b_sinks.reshape(B_KV_HEADS, B_GROUP))
    y_b = o_b.reshape(bn, s, B_WIDTH)
    log_g = jax.nn.log_sigmoid((c_glow @ c_gate_up + c_gate_bias).astype(jnp.float32)) / C_TAU
    o_c = gla_chunked(c_q.reshape(bn, s, C_HEADS, C_DK), c_k.reshape(bn, s, C_HEADS, C_DK),
                      c_v.reshape(bn, s, C_HEADS, C_DV), log_g.reshape(bn, s, C_HEADS, C_DK))
    y_c = (rmsnorm(o_c, c_out_norm) * jax.nn.silu(c_r.reshape(bn, s, C_HEADS, C_DV))).reshape(bn, s, C_WIDTH)
    gates = jax.nn.sigmoid(gate_pre.reshape(bn, s, N_BRANCH, D_MODEL))
    merged = (gates[:, :, 0] * (y_a @ w_branch[0])
              + gates[:, :, 1] * (y_b @ w_branch[1])
              + gates[:, :, 2] * (y_c @ w_branch[2]))
    return merged @ w_out


def setup_inputs(seed: int = 0) -> dict:
    key = jax.random.key(seed)
    ks = jax.random.split(key, 20)

    def nrm(k, shape, scale):
        return jax.random.normal(k, shape, jnp.float32) * scale

    def gain(k, shape):
        return 1.0 + nrm(k, shape, 0.02)

    L = DEPTH
    return {
        'x': nrm(ks[0], (BATCH, SEQ, D_MODEL), 1.0),
        'positions': jnp.broadcast_to(jnp.arange(SEQ, dtype=jnp.int32), (BATCH, SEQ)),
        'norm_ffn1': gain(ks[1], (L, D_MODEL)),
        'w_ffn1_in': nrm(ks[2], (L, D_MODEL, 2 * D_FF), D_MODEL ** -0.5),
        'w_ffn1_out': nrm(ks[3], (L, D_FF, D_MODEL), D_FF ** -0.5),
        'norm_mix': gain(ks[4], (L, D_MODEL)),
        'w_in': nrm(ks[5], (L, D_MODEL, IN_WIDTH), D_MODEL ** -0.5),
        'a_q_norm': gain(ks[6], (L, HEAD_DIM)),
        'a_k_norm': gain(ks[7], (L, HEAD_DIM)),
        'b_q_norm': gain(ks[8], (L, HEAD_DIM)),
        'b_k_norm': gain(ks[9], (L, HEAD_DIM)),
        'b_sinks': nrm(ks[10], (L, B_Q_HEADS), 1.0),
        'c_gate_up': nrm(ks[11], (L, C_GATE_RANK, C_HEADS * C_DK), C_GATE_RANK ** -0.5),
        'c_gate_bias': nrm(ks[12], (L, C_HEADS * C_DK), 0.1),
        'c_out_norm': gain(ks[13], (L, C_DV)),
        'w_branch': nrm(ks[14], (L, N_BRANCH, BRANCH_WIDTH, D_MODEL), BRANCH_WIDTH ** -0.5),
        'w_out': nrm(ks[15], (L, D_MODEL, D_MODEL), D_MODEL ** -0.5),
        'norm_ffn2': gain(ks[16], (L, D_MODEL)),
        'w_ffn2_in': nrm(ks[17], (L, D_MODEL, 2 * D_FF), D_MODEL ** -0.5),
        'w_ffn2_out': nrm(ks[18], (L, D_FF, D_MODEL), D_FF ** -0.5),
    }


def reference(x, positions, norm_ffn1, w_ffn1_in, w_ffn1_out, norm_mix, w_in, a_q_norm, a_k_norm,
              b_q_norm, b_k_norm, b_sinks, c_gate_up, c_gate_bias, c_out_norm, w_branch, w_out,
              norm_ffn2, w_ffn2_in, w_ffn2_out):
    cos, sin = rope_tables(positions)
    for l in range(DEPTH):
        x = x + 0.5 * swiglu(rmsnorm(x, norm_ffn1[l]), w_ffn1_in[l], w_ffn1_out[l])
        h = rmsnorm(x, norm_mix[l])
        x = x + hybrid_mixer(h, cos, sin, w_in[l], a_q_norm[l], a_k_norm[l], b_q_norm[l], b_k_norm[l],
                             b_sinks[l], c_gate_up[l], c_gate_bias[l], c_out_norm[l], w_branch[l], w_out[l])
        x = x + 0.5 * swiglu(rmsnorm(x, norm_ffn2[l]), w_ffn2_in[l], w_ffn2_out[l])
    return x
```

```cpp
#include <hip/hip_runtime.h>
#include <cstdio>
#include <cstdint>

#ifndef MK_PER_PHASE
#define MK_PER_PHASE 1
#endif

namespace pg8 {
#define PG8_LAS __attribute__((address_space(3)))
typedef unsigned short bf16_t;
typedef short bf16x8 __attribute__((ext_vector_type(8)));
typedef float f32x4 __attribute__((ext_vector_type(4)));
typedef unsigned u32x4 __attribute__((ext_vector_type(4)));
constexpr int BM = 256, BK = 64, HALF = 128, HTB = HALF * BK * 2  , STAGE_BYTES = 8 * HTB, NXCD = 8, WGM = 8;

__host__ __device__ __forceinline__ int lds_byte(int r, int c) { const int st = (r >> 4) * 2 + (c >> 5), rr = r & 15, cc = c & 31, ob = rr * 64 + cc * 2; return st * 1024 + (ob ^ (((ob >> 9) & 1) << 5)); }
__host__ __device__ __forceinline__ void stage_rc(int b, int& R, int& C) { const int st = b / 1024, sb = b % 1024, swz = sb ^ (((sb >> 9) & 1) << 5); R = (st >> 1) * 16 + swz / 64; C = (st & 1) * 32 + (swz % 64) / 2; }
__host__ __device__ __forceinline__ int perm32(int rho) { const int n = rho >> 4, i = rho & 15; return 8 * (i >> 2) + 4 * n + (i & 3); }

struct Unit { int pm, pn, seg; };
struct Gemm { const bf16_t* A0; const bf16_t* A1; const bf16_t* A2; const bf16_t* B0; const bf16_t* B1; const bf16_t* B2; int M, N, K; };

struct StaticOrder {
    int nM, nN, nwg, G, c;
    __host__ __device__ void init(int M, int N, int G_, int c_) { nM = M / BM; nN = N / BM; nwg = nM * nN; G = G_; c = c_; }
    __host__ __device__ bool next(int i, Unit& u) const {
        const long L = (long)i * G + c; if (L >= nwg) return false;
        int wgid = (int)L; { const int q = nwg / NXCD, r = nwg % NXCD, xcd = wgid % NXCD, off = wgid / NXCD; wgid = (xcd < r ? xcd * (q + 1) : r * (q + 1) + (xcd - r) * q) + off; }
        const int nig = WGM * nN, gid = wgid / nig, fm = gid * WGM, gsz = (nM - fm) < WGM ? (nM - fm) : WGM;
        u.pm = fm + ((wgid % nig) % gsz); u.pn = (wgid % nig) / gsz; u.seg = 0; return true;
    }
};
struct Seg3Order {
    StaticOrder b;
    __host__ __device__ bool next(int i, Unit& u) const { if (!b.next(i / 3, u)) return false; u.seg = i % 3; return true; }
};

typedef float f32x2_t __attribute__((ext_vector_type(2))); typedef __bf16 bf16x2_t __attribute__((ext_vector_type(2)));
__device__ __forceinline__ unsigned cvt_pk_bf16(float lo, float hi) { f32x2_t v = {lo, hi}; bf16x2_t b = __builtin_convertvector(v, bf16x2_t); return __builtin_bit_cast(unsigned, b); }

template <class Epi, class Sched, bool ALIGN_EPI = false>
__device__ __forceinline__ void gemm_phase(PG8_LAS unsigned char* lds, const Gemm g, const Sched& S, const Epi& E) {
    int tid_ = threadIdx.x; asm volatile("" : "+v"(tid_));
    const int tid = tid_ & 511, wid = __builtin_amdgcn_readfirstlane(tid >> 6), lane = tid & 63, wr = wid >> 2, wc = wid & 3, fr = lane & 15, fq = lane >> 4;
    const int K = g.K, nt = K / BK;
    unsigned voffA[2], voffB[2];
#pragma unroll
    for (int i = 0; i < 2; ++i) { int R, C; stage_rc(tid * 16 + i * 8192, R, C); const int Rb = Epi::PERM ? ((R & ~31) + perm32(R & 31)) : R;
        voffA[i] = (unsigned)(R * K + C) * 2u; voffB[i] = (unsigned)(Rb * K + C) * 2u; }
    const size_t kstep = (size_t)(BK * 2);
    const size_t hstep = (size_t)HALF * K * 2;
    const size_t tstep = 2 * hstep;
    const unsigned ldsw = (unsigned)wid * 1024u;
    const int aoff = lds_byte(wr * 64 + fr, fq * 8), boff = lds_byte(wc * 32 + fr, fq * 8);
#define PG8_SA(b, h) (((b) * 2 + (h)) * HTB)
#define PG8_SB(b, h) ((4 + (b) * 2 + (h)) * HTB)
#define PG8_STAGE(bufoff, gbase, voff) do { _Pragma("unroll") for (int _i = 0; _i < 2; ++_i) \
        __builtin_amdgcn_global_load_lds((const unsigned*)((const char*)(gbase) + (voff)[_i]), (PG8_LAS unsigned*)(lds + (bufoff) + ldsw + _i * 8192), 16, 0, 0); } while (0)
#define PG8_LDA(dst, b, h) do { _Pragma("unroll") for (int m = 0; m < 4; ++m) _Pragma("unroll") for (int k = 0; k < 2; ++k) dst[m][k] = *(const PG8_LAS bf16x8*)(lds + PG8_SA(b, h) + aoff + m * 2048 + k * 1024); } while (0)
#define PG8_LDB(dst, b, h) do { _Pragma("unroll") for (int n = 0; n < 2; ++n) _Pragma("unroll") for (int k = 0; k < 2; ++k) dst[n][k] = *(const PG8_LAS bf16x8*)(lds + PG8_SB(b, h) + boff + n * 2048 + k * 1024); } while (0)
#define PG8_MMA(ai, bj, At, Bt) do { __builtin_amdgcn_s_setprio(1); _Pragma("unroll") for (int m = 0; m < 4; ++m) _Pragma("unroll") for (int n = 0; n < 2; ++n) _Pragma("unroll") for (int k = 0; k < 2; ++k) \
        acc[ai][bj][m][n] = __builtin_amdgcn_mfma_f32_16x16x32_bf16(Bt[n][k], At[m][k], acc[ai][bj][m][n], 0, 0, 0); __builtin_amdgcn_s_setprio(0); } while (0)
#define PG8_WAIT_V(n) asm volatile("s_waitcnt vmcnt(" #n ")" ::: "memory")
#define PG8_WAIT_L(n) asm volatile("s_waitcnt lgkmcnt(" #n ")" ::: "memory")
#define PG8_BAR __builtin_amdgcn_s_barrier()
#define PG8_SCHED __builtin_amdgcn_sched_barrier(0)
#define PG8_ASEL(u) ((u).seg == 0 ? g.A0 : ((u).seg == 1 ? g.A1 : g.A2))
#define PG8_BSEL(u) ((u).seg == 0 ? g.B0 : ((u).seg == 1 ? g.B1 : g.B2))
    Unit cur, nxt; int ui = 0;
    if (!S.next(0, cur)) return;
    f32x4 acc[2][2][4][2];
#pragma unroll
    for (int a = 0; a < 2; ++a)
#pragma unroll
        for (int b = 0; b < 2; ++b)
#pragma unroll
            for (int m = 0; m < 4; ++m)
#pragma unroll
                for (int n = 0; n < 2; ++n) acc[a][b][m][n] = (f32x4){0.f, 0.f, 0.f, 0.f};
    bf16x8 At[4][2], B0[2][2], B1[2][2];
    const char* cA = (const char*)PG8_ASEL(cur) + (size_t)cur.pm * tstep; const char* cB = (const char*)PG8_BSEL(cur) + (size_t)cur.pn * tstep;
    PG8_STAGE(PG8_SB(0, 0), cB, voffB); PG8_STAGE(PG8_SB(0, 1), cB + hstep, voffB); PG8_STAGE(PG8_SA(0, 0), cA, voffA); PG8_STAGE(PG8_SA(0, 1), cA + hstep, voffA);
    if (wr == 1) PG8_BAR;
    PG8_WAIT_V(2); PG8_BAR;
    PG8_STAGE(PG8_SB(1, 0), cB + kstep, voffB); PG8_STAGE(PG8_SA(1, 0), cA + kstep, voffA); PG8_STAGE(PG8_SB(1, 1), cB + hstep + kstep, voffB);
    PG8_WAIT_V(6); PG8_BAR;
    for (;;) {
        const bool has_next = S.next(ui + 1, nxt);
        const char* nA = has_next ? (const char*)PG8_ASEL(nxt) + (size_t)nxt.pm * tstep : cA; const char* nB = has_next ? (const char*)PG8_BSEL(nxt) + (size_t)nxt.pn * tstep : cB;
        for (int t = 0; t < nt; t += 2) {
            const bool last = (t == nt - 2);
            const char* a1 = cA + (size_t)(t + 1) * kstep;
            const char* a2 = last ? nA : cA + (size_t)(t + 2) * kstep; const char* b2 = last ? nB : cB + (size_t)(t + 2) * kstep;
            const char* a3 = a2 + kstep; const char* b3 = b2 + kstep;
            PG8_LDB(B0, 0, 0); PG8_LDB(B1, 0, 1); PG8_SCHED; PG8_LDA(At, 0, 0); PG8_STAGE(PG8_SA(1, 1), a1 + hstep, voffA);
            PG8_WAIT_V(8); PG8_WAIT_L(0); PG8_BAR; PG8_MMA(0, 0, At, B0); PG8_MMA(0, 1, At, B1); PG8_BAR; PG8_SCHED;
            PG8_LDA(At, 0, 1); PG8_STAGE(PG8_SB(0, 0), b2, voffB); PG8_STAGE(PG8_SB(0, 1), b2 + hstep, voffB); PG8_STAGE(PG8_SA(0, 0), a2, voffA);
            PG8_WAIT_V(8); PG8_WAIT_L(0); PG8_BAR; PG8_MMA(1, 0, At, B0); PG8_MMA(1, 1, At, B1); PG8_BAR; PG8_SCHED;
            PG8_LDB(B0, 1, 0); PG8_LDB(B1, 1, 1); PG8_SCHED; PG8_LDA(At, 1, 0); PG8_STAGE(PG8_SA(0, 1), a2 + hstep, voffA);
            PG8_WAIT_V(8); PG8_WAIT_L(0); PG8_BAR; PG8_MMA(0, 0, At, B0); PG8_MMA(0, 1, At, B1); PG8_BAR; PG8_SCHED;
            PG8_LDA(At, 1, 1); PG8_STAGE(PG8_SB(1, 0), b3, voffB); PG8_STAGE(PG8_SB(1, 1), b3 + hstep, voffB); PG8_STAGE(PG8_SA(1, 0), a3, voffA);
            PG8_WAIT_V(8); PG8_WAIT_L(0); PG8_BAR; PG8_MMA(1, 0, At, B0); PG8_MMA(1, 1, At, B1); PG8_BAR; PG8_SCHED;
        }
        if constexpr (ALIGN_EPI) { if (wr == 0) PG8_BAR; }
        const bool keep = E(acc, cur, wr, wc, fr, fq, lane);
        if (!has_next) break;
        if (!keep) {
#pragma unroll
        for (int a = 0; a < 2; ++a)
#pragma unroll
            for (int b = 0; b < 2; ++b)
#pragma unroll
                for (int m = 0; m < 4; ++m)
#pragma unroll
                    for (int n = 0; n < 2; ++n) acc[a][b][m][n] = (f32x4){0.f, 0.f, 0.f, 0.f};
        }
        cur = nxt; cA = nA; cB = nB; ++ui;
        if constexpr (ALIGN_EPI) { if (wr == 1) PG8_BAR; }
    }
    PG8_WAIT_V(0);
    if constexpr (!ALIGN_EPI) { if (wr == 0) PG8_BAR; }
    PG8_BAR;
#undef PG8_SA
#undef PG8_SB
#undef PG8_STAGE
#undef PG8_LDA
#undef PG8_LDB
#undef PG8_MMA
#undef PG8_WAIT_V
#undef PG8_WAIT_L
#undef PG8_BAR
#undef PG8_SCHED
#undef PG8_ASEL
#undef PG8_BSEL
}
}

constexpr int NWAVES = 8;
constexpr int BATCH = 2, SEQ = 8192, DM = 1024, M = BATCH * SEQ, DFF = 2816, NLAYER = 2, INW = 10000;
constexpr float NORM_EPS = 1e-6f;
constexpr float LOG2E = 1.4426950408889634f;
constexpr float QSCALE = 0.125f * LOG2E;

constexpr size_t MiB = 1u << 20;
constexpr size_t WS_CTL = 0, CTL_ZERO_BYTES = 1 * MiB;
constexpr size_t WS_SSQ = 1 * MiB;
constexpr size_t WS_COS = 2 * MiB, WS_SIN = 4 * MiB;
constexpr size_t WS_S1 = 6 * MiB;
constexpr size_t WS_S2 = 17 * MiB;
constexpr size_t WS_DC = 22 * MiB + 512 * 1024;
constexpr size_t WS_WG = 23 * MiB;
constexpr size_t WS_WB = 29 * MiB;
constexpr size_t WS_WO = 32 * MiB;
constexpr size_t WS_ACT = 34 * MiB;
constexpr size_t UU = 4 * MiB;
constexpr size_t WS_AQ0 = WS_ACT + 0 * UU, WS_AQ1 = WS_ACT + 4 * UU, WS_AQ2 = WS_ACT + 8 * UU;
constexpr size_t WS_AK0 = WS_ACT + 12 * UU, WS_AV0 = WS_ACT + 24 * UU;
constexpr size_t WS_GATES = WS_ACT + 4 * UU;
constexpr size_t WS_MERGED = WS_ACT + 28 * UU;
constexpr size_t WS_BQ = WS_ACT + 36 * UU, WS_BK = WS_ACT + 40 * UU, WS_BV = WS_ACT + 41 * UU;
constexpr size_t WS_CQ = WS_ACT + 42 * UU, WS_CK = WS_ACT + 44 * UU, WS_CV = WS_ACT + 46 * UU;
constexpr size_t WS_LOGG = WS_ACT + 50 * UU;
constexpr size_t WS_CR = WS_ACT + 52 * UU;
constexpr size_t WS_STATE = WS_ACT + 56 * UU;
constexpr size_t WS_XB = WS_ACT + 60 * UU;
constexpr size_t WS_ACTH = WS_ACT;
constexpr size_t WS_END = WS_ACT + 68 * UU;
static_assert(WS_S1 + (size_t)2 * DFF * DM * 2 <= WS_S2 && WS_S2 + (size_t)DM * DFF * 2 <= WS_DC && WS_DC + 8 * 128 * 64 * 4 <= WS_WG, "ws map");
static_assert((size_t)M * DFF * 2 <= 22 * UU && (size_t)7168 * 1024 * 2 <= 4 * UU, "ws map 2");
constexpr int CW_TMO = 0, CW_CODE = 1;
constexpr int CW_BAR = 4096;

constexpr int RING_OFF = 0, RING_BYTES = 131072;
constexpr int LDSCTL_OFF = RING_BYTES, MISC_OFF = LDSCTL_OFF + 320;
constexpr int LDS_BYTES = 147456;
constexpr int INTAB_OFF = MISC_OFF + 256;

#define GAS __attribute__((address_space(1)))
#define LAS __attribute__((address_space(3)))
typedef unsigned short bf16;
typedef unsigned v4u __attribute__((ext_vector_type(4)));
typedef unsigned v2u __attribute__((ext_vector_type(2)));
typedef float f32x4 __attribute__((ext_vector_type(4)));
typedef short bf16x8 __attribute__((ext_vector_type(8)));
typedef _Float16 h16x2 __attribute__((ext_vector_type(2)));
typedef GAS unsigned gu32;
#define RLX_AGENT __ATOMIC_RELAXED, __HIP_MEMORY_SCOPE_AGENT
#define LDS_WAIT() asm volatile("s_waitcnt lgkmcnt(0)" ::: "memory")
#define VM_WAIT() asm volatile("s_waitcnt vmcnt(0)" ::: "memory")
__device__ __forceinline__ unsigned f2bf(float f) { unsigned u = __builtin_bit_cast(unsigned, f); return (u + 0x7fffu + ((u >> 16) & 1u)) >> 16; }
__device__ __forceinline__ unsigned pk2(float lo, float hi) { return f2bf(lo) | (f2bf(hi) << 16); }
__device__ __forceinline__ float bflo(unsigned w) { return __builtin_bit_cast(float, w << 16); }
__device__ __forceinline__ float bfhi(unsigned w) { return __builtin_bit_cast(float, w & 0xffff0000u); }
__device__ __forceinline__ float bf2f(bf16 h) { return __builtin_bit_cast(float, (unsigned)h << 16); }
__device__ __forceinline__ float fexp2(float x) { return __builtin_amdgcn_exp2f(x); }
__device__ __forceinline__ float fexp(float x) { return __builtin_amdgcn_exp2f(x * LOG2E); }
__device__ __forceinline__ float frcp(float x) { return __builtin_amdgcn_rcpf(x); }
__device__ __forceinline__ float sigmoidf_(float x) { return frcp(1.0f + fexp(-x)); }
__device__ __forceinline__ float siluf_(float x) { return x * sigmoidf_(x); }

#define XB_TMO      128
#define XB_XCNT(j)  (256  + 64 * (j))
#define XB_XSUB(j)  (1280 + 64 * (j))
#define XB_XGEN(j)  (2304 + 64 * (j))
#define XB_TOP      3328
#define XB_TOPGEN   3392
#define XCD_BAR_WORDS 3456
#define XB_SPIN_CAP (1u << 18)
__device__ __forceinline__ unsigned xb_ld(unsigned* p)              { return __hip_atomic_load(p, __ATOMIC_RELAXED, __HIP_MEMORY_SCOPE_AGENT); }
__device__ __forceinline__ unsigned xb_add(unsigned* p, unsigned v) { return __hip_atomic_fetch_add(p, v, __ATOMIC_RELAXED, __HIP_MEMORY_SCOPE_AGENT); }
__device__ __forceinline__ unsigned xb_xcc_id() { return (unsigned)__builtin_amdgcn_s_getreg((3 << 11) | 20) & 0xFu; }
#define XB_SPIN(cond, bar) do { unsigned _sp = 0; while (cond) { __builtin_amdgcn_s_sleep(1); \
    if ((++_sp & 255u) == 0u) { if (xb_ld(&(bar)[XB_TMO])) break; if (_sp > XB_SPIN_CAP) { atomicAdd(&(bar)[XB_TMO], 1u); break; } } } } while (0)
struct XcdBarrier { unsigned* bar; unsigned x; volatile LAS unsigned* st; };
__device__ __forceinline__ XcdBarrier xcd_barrier_post(unsigned* bar, volatile LAS unsigned* st) {
    XcdBarrier b; b.bar = bar; b.x = xb_xcc_id(); b.st = st;
    if (threadIdx.x == 0) (void)xb_add(&bar[XB_XCNT(b.x)], 1u);
    return b;
}
__device__ __forceinline__ void xcd_barrier_complete(unsigned* bar, unsigned x, unsigned& nloc, unsigned& nx) {
    const unsigned G = gridDim.x * gridDim.y * gridDim.z;
    unsigned sum, cnt, mine, sp = 0u;
    for (;;) {
        sum = 0u; cnt = 0u; mine = 0u;
#pragma unroll
        for (unsigned j = 0; j < 16; ++j) { const unsigned c = xb_ld(&bar[XB_XCNT(j)]); sum += c; cnt += (c > 0u) ? 1u : 0u; mine = (j == x) ? c : mine; }
        if (sum == G) break;
        __builtin_amdgcn_s_sleep(1);
        if ((++sp & 255u) == 0u) { if (xb_ld(&bar[XB_TMO])) break; if (sp > XB_SPIN_CAP) { atomicAdd(&bar[XB_TMO], 1u); break; } }
    }
    nloc = mine > 0u ? mine : 1u; nx = cnt > 0u ? cnt : 1u;
}
__device__ __forceinline__ void xcd_barrier(const XcdBarrier& b) {
    asm volatile("s_waitcnt vmcnt(0)" ::: "memory");
    __syncthreads();
    if (threadIdx.x == 0) {
        unsigned* bar = b.bar;
        __builtin_amdgcn_s_waitcnt(0);
        unsigned nloc = b.st[0], nx = b.st[1];
        if (nloc == 0u) { xcd_barrier_complete(bar, b.x, nloc, nx); b.st[0] = nloc; b.st[1] = nx; }
        const unsigned old = xb_add(&bar[XB_XSUB(b.x)], 1u);
        const unsigned gen = old / nloc;
        if (old + 1u == (gen + 1u) * nloc) {
            __builtin_amdgcn_fence(__ATOMIC_RELEASE, "agent");
            asm volatile("s_waitcnt vmcnt(0)" ::: "memory");
            const unsigned og = xb_add(&bar[XB_TOP], 1u);
            const unsigned tg = og / nx;
            if (og + 1u == (tg + 1u) * nx) xb_add(&bar[XB_TOPGEN], 1u);
            else XB_SPIN(xb_ld(&bar[XB_TOPGEN]) == tg, bar);
            __builtin_amdgcn_fence(__ATOMIC_ACQUIRE, "agent");
            xb_add(&bar[XB_XGEN(b.x)], 1u);
            asm volatile("s_waitcnt vmcnt(0)" ::: "memory");
        } else {
            XB_SPIN(xb_ld(&bar[XB_XGEN(b.x)]) == gen, bar);
            __builtin_amdgcn_fence(__ATOMIC_ACQUIRE, "agent");
            asm volatile("s_waitcnt vmcnt(0)" ::: "memory");
        }
    }
    __syncthreads();
}

struct Frame {
    LAS unsigned char* lds;
    volatile LAS unsigned* MISC;
    gu32* ctl;
    int tid, lane, wave;
    int vcu, G;
    unsigned char* ws;
    float* X;
};
__device__ __forceinline__ const float* inptr(const Frame& F, int i) {
    const LAS unsigned* t = (const LAS unsigned*)(F.lds + INTAB_OFF); unsigned lo = t[2 * i], hi = t[2 * i + 1];
    lo = __builtin_amdgcn_readfirstlane(lo); hi = __builtin_amdgcn_readfirstlane(hi);
    return (const float*)(((unsigned long long)hi << 32) | lo);
}
__device__ __forceinline__ float wave_sum(float v) {
#pragma unroll
    for (int o = 1; o < 64; o <<= 1) v += __shfl_xor(v, o);
    return v;
}
__device__ __forceinline__ float wave_max(float v) {
#pragma unroll
    for (int o = 1; o < 64; o <<= 1) v = fmaxf(v, __shfl_xor(v, o));
    return v;
}

namespace pg8 {
__device__ __forceinline__ void load_rstd(const float* ssq, int pm, int wr, int lane, float (&rs)[2][4]) {
    float mine[2];
#pragma unroll
    for (int ai = 0; ai < 2; ++ai) { const f32x4* p = (const f32x4*)(ssq + (size_t)(pm * 256 + ai * 128 + wr * 64 + lane) * 16);
        const f32x4 a = p[0], b = p[1], c = p[2], d = p[3]; const f32x4 s = (a + b) + (c + d);
        mine[ai] = 1.0f / sqrtf(((s[0] + s[1]) + (s[2] + s[3])) * (1.0f / DM) + NORM_EPS); }
#pragma unroll
    for (int ai = 0; ai < 2; ++ai)
#pragma unroll
        for (int m = 0; m < 4; ++m) rs[ai][m] = __shfl(mine[ai], 16 * m + (lane & 15));
}
__device__ __forceinline__ u32x4 pack8(const f32x4& a, const f32x4& b) { u32x4 w; w.x = cvt_pk_bf16(a[0], a[1]); w.y = cvt_pk_bf16(a[2], a[3]); w.z = cvt_pk_bf16(b[0], b[1]); w.w = cvt_pk_bf16(b[2], b[3]); return w; }

struct EpiSwiglu {
    static constexpr bool PERM = true;
    bf16_t* O; const float* ssq;
    __device__ __forceinline__ bool operator()(f32x4 (&acc)[2][2][4][2], const Unit& u, int wr, int wc, int fr, int fq, int lane) const {
        float rs[2][4]; load_rstd(ssq, u.pm, wr, lane, rs);
        const int col0 = u.pn * 128 + wc * 32 + 8 * fq;
#pragma unroll
        for (int ai = 0; ai < 2; ++ai)
#pragma unroll
            for (int m = 0; m < 4; ++m) { const float r = rs[ai][m]; const size_t row = (size_t)(u.pm * BM + ai * HALF + wr * 64 + m * 16 + fr);
                f32x4 o[2];
#pragma unroll
                for (int n = 0; n < 2; ++n) { const f32x4 gg = acc[ai][0][m][n] * r, uu = acc[ai][1][m][n] * r;
#pragma unroll
                    for (int j = 0; j < 4; ++j) o[n][j] = siluf_(gg[j]) * uu[j]; }
                *(u32x4*)(O + row * DFF + col0) = pack8(o[0], o[1]); }
        return false;
    }
};
struct EpiResidual {
    static constexpr bool PERM = true;
    float* X; bf16_t* XB; float* ssq; float scale;
    __device__ __forceinline__ bool operator()(f32x4 (&acc)[2][2][4][2], const Unit& u, int wr, int wc, int fr, int fq, int lane) const {
        const int col0 = u.pn * BM + wc * 32 + 8 * fq;
#pragma unroll
        for (int ai = 0; ai < 2; ++ai)
#pragma unroll
            for (int m = 0; m < 4; ++m) { const size_t row = (size_t)(u.pm * BM + ai * HALF + wr * 64 + m * 16 + fr); float q = 0.f;
#pragma unroll
                for (int bj = 0; bj < 2; ++bj) { float* xp = X + row * DM + col0 + bj * HALF;
                    f32x4 x0 = *(const f32x4*)xp, x1 = *(const f32x4*)(xp + 4);
                    x0 = x0 + acc[ai][bj][m][0] * scale; x1 = x1 + acc[ai][bj][m][1] * scale;
                    *(f32x4*)xp = x0; *(f32x4*)(xp + 4) = x1;
                    q += (x0[0] * x0[0] + x0[1] * x0[1]) + (x0[2] * x0[2] + x0[3] * x0[3]) + (x1[0] * x1[0] + x1[1] * x1[1]) + (x1[2] * x1[2] + x1[3] * x1[3]);
                    *(u32x4*)(XB + row * DM + col0 + bj * HALF) = pack8(x0, x1); }
                q += __shfl_xor(q, 16); q += __shfl_xor(q, 32);
                if (fq == 0) ssq[row * 16 + u.pn * 4 + wc] = q; }
        return false;
    }
};
struct EpiSigmoid {
    static constexpr bool PERM = true;
    bf16_t* O; const float* ssq;
    __device__ __forceinline__ bool operator()(f32x4 (&acc)[2][2][4][2], const Unit& u, int wr, int wc, int fr, int fq, int lane) const {
        float rs[2][4]; load_rstd(ssq, u.pm, wr, lane, rs);
        bf16_t* base = O + (size_t)(u.pn >> 2) * M * DM + (u.pn & 3) * 256 + wc * 32 + 8 * fq;
#pragma unroll
        for (int ai = 0; ai < 2; ++ai)
#pragma unroll
            for (int m = 0; m < 4; ++m) { const float r = rs[ai][m]; const size_t row = (size_t)(u.pm * BM + ai * HALF + wr * 64 + m * 16 + fr);
#pragma unroll
                for (int bj = 0; bj < 2; ++bj) { f32x4 o[2];
#pragma unroll
                    for (int n = 0; n < 2; ++n)
#pragma unroll
                        for (int j = 0; j < 4; ++j) o[n][j] = sigmoidf_(acc[ai][bj][m][n][j] * r);
                    *(u32x4*)(base + row * DM + bj * HALF) = pack8(o[0], o[1]); } }
        return false;
    }
};
struct EpiMerge {
    static constexpr bool PERM = true;
    const bf16_t* GT; bf16_t* O;
    __device__ __forceinline__ bool operator()(f32x4 (&acc)[2][2][4][2], const Unit& u, int wr, int wc, int fr, int fq, int lane) const {
        const int col0 = u.pn * BM + wc * 32 + 8 * fq; const int s = u.seg;
        const bf16_t* g0 = GT + (size_t)s * M * DM; const bf16_t* g1 = GT + (size_t)(s + 1) * M * DM;
#pragma unroll
        for (int ai = 0; ai < 2; ++ai)
#pragma unroll
            for (int m = 0; m < 4; ++m) { const size_t row = (size_t)(u.pm * BM + ai * HALF + wr * 64 + m * 16 + fr);
#pragma unroll
                for (int bj = 0; bj < 2; ++bj) { const size_t off = row * DM + col0 + bj * HALF;
                    const u32x4 a = *(const u32x4*)(g0 + off);
                    float ga[8] = {bflo(a.x), bfhi(a.x), bflo(a.y), bfhi(a.y), bflo(a.z), bfhi(a.z), bflo(a.w), bfhi(a.w)};
                    if (s < 2) { const u32x4 b = *(const u32x4*)(g1 + off);
                        float gb[8] = {bflo(b.x), bfhi(b.x), bflo(b.y), bfhi(b.y), bflo(b.z), bfhi(b.z), bflo(b.w), bfhi(b.w)};
#pragma unroll
                        for (int e = 0; e < 8; ++e) acc[ai][bj][m][e >> 2][e & 3] *= fmaxf(ga[e], 1e-30f) / fmaxf(gb[e], 1e-30f);
                    } else { f32x4 o[2];
#pragma unroll
                        for (int e = 0; e < 8; ++e) o[e >> 2][e & 3] = acc[ai][bj][m][e >> 2][e & 3] * fmaxf(ga[e], 1e-30f);
                        *(u32x4*)(O + off) = pack8(o[0], o[1]); } } }
        return s < 2;
    }
};
struct EpiInProj {
    static constexpr bool PERM = true;
    unsigned char* ws; const float* ssq; const float* cosT; const float* sinT;
    const float* aq_n; const float* ak_n; const float* bq_n; const float* bk_n; const float* gbias;
    __device__ __forceinline__ bool operator()(f32x4 (&acc)[2][2][4][2], const Unit& u, int wr, int wc, int fr, int fq, int lane) const {
        float rs[2][4]; load_rstd(ssq, u.pm, wr, lane, rs);
        const int t = u.pn;
        int mode, pitch, colA, colB; bf16_t* dst; const float* gain = nullptr; float sc = 1.f; bool act = false;
        if (t < 18) { const int w = t / 6, tt = t % 6, g = tt >> 1, hd = ((tt & 1) * 4 + wc) * 64 + 8 * fq;
            dst = (bf16_t*)(ws + (w == 0 ? (g == 0 ? WS_AQ0 : (g == 1 ? WS_AQ1 : WS_AQ2)) : (w == 1 ? WS_AK0 + (size_t)g * 4 * UU : WS_AV0 + (size_t)g * 4 * UU)));
            pitch = 512; colA = hd; colB = hd + 32; mode = (w == 2) ? 1 : 0; gain = (w == 0) ? aq_n : ak_n; sc = (w == 0) ? QSCALE : 1.f; }
        else if (t < 20) { dst = (bf16_t*)(ws + WS_BQ); pitch = 512; colA = ((t - 18) * 4 + wc) * 64 + 8 * fq; colB = colA + 32; mode = 0; gain = bq_n; sc = QSCALE; }
        else if (t == 20) { pitch = 128; colA = (wc & 1) * 64 + 8 * fq; colB = colA + 32;
            if (wc < 2) { dst = (bf16_t*)(ws + WS_BK); mode = 0; gain = bk_n; } else { dst = (bf16_t*)(ws + WS_BV); mode = 1; } }
        else { colA = wc * 32 + 8 * fq; colB = colA + 128; mode = 2;
            if (t == 21) { dst = (bf16_t*)(ws + WS_CQ); pitch = 256; sc = 0.125f; }
            else if (t == 22) { dst = (bf16_t*)(ws + WS_CK); pitch = 256; }
            else if (t < 25) { dst = (bf16_t*)(ws + WS_CV); pitch = 512; colA += (t - 23) * 256; colB += (t - 23) * 256; }
            else if (t == 25) { dst = (bf16_t*)(ws + WS_LOGG); pitch = 256; mode = 3; }
            else { dst = (bf16_t*)(ws + WS_CR); pitch = 512; colA += (t - 26) * 256; colB += (t - 26) * 256; act = true; } }
        if (mode == 0) {
            f32x4 gA[2], gB[2];
#pragma unroll
            for (int n = 0; n < 2; ++n) { gA[n] = *(const f32x4*)(gain + 8 * fq + 4 * n); gB[n] = *(const f32x4*)(gain + 32 + 8 * fq + 4 * n); }
#pragma unroll
            for (int ai = 0; ai < 2; ++ai)
#pragma unroll
                for (int m = 0; m < 4; ++m) { const float r = rs[ai][m]; const size_t row = (size_t)(u.pm * BM + ai * HALF + wr * 64 + m * 16 + fr);
                    f32x4 a[2], b[2]; float ss = 0.f;
#pragma unroll
                    for (int n = 0; n < 2; ++n) { a[n] = acc[ai][0][m][n] * r; b[n] = acc[ai][1][m][n] * r;
                        ss += (a[n][0] * a[n][0] + a[n][1] * a[n][1]) + (a[n][2] * a[n][2] + a[n][3] * a[n][3]) + (b[n][0] * b[n][0] + b[n][1] * b[n][1]) + (b[n][2] * b[n][2] + b[n][3] * b[n][3]); }
                    ss += __shfl_xor(ss, 16); ss += __shfl_xor(ss, 32);
                    const float rn = 1.0f / sqrtf(ss * (1.0f / 64.0f) + NORM_EPS);
                    f32x4 oa[2], ob[2];
#pragma unroll
                    for (int n = 0; n < 2; ++n) { const f32x4 c = *(const f32x4*)(cosT + row * 32 + 8 * fq + 4 * n), s = *(const f32x4*)(sinT + row * 32 + 8 * fq + 4 * n);
                        const f32x4 y1 = a[n] * rn * gA[n], y2 = b[n] * rn * gB[n];
                        oa[n] = (y1 * c - y2 * s) * sc; ob[n] = (y2 * c + y1 * s) * sc; }
                    *(u32x4*)(dst + row * pitch + colA) = pack8(oa[0], oa[1]); *(u32x4*)(dst + row * pitch + colB) = pack8(ob[0], ob[1]); }
        } else if (mode == 3) {
            f32x4 bA[2], bB[2];
#pragma unroll
            for (int n = 0; n < 2; ++n) { bA[n] = *(const f32x4*)(gbias + colA + 4 * n); bB[n] = *(const f32x4*)(gbias + colB + 4 * n); }
#pragma unroll
            for (int ai = 0; ai < 2; ++ai)
#pragma unroll
                for (int m = 0; m < 4; ++m) { const float r = rs[ai][m]; const size_t row = (size_t)(u.pm * BM + ai * HALF + wr * 64 + m * 16 + fr);
#pragma unroll
                    for (int bj = 0; bj < 2; ++bj) { float v[8];
#pragma unroll
                        for (int e = 0; e < 8; ++e) { const float x = acc[ai][bj][m][e >> 2][e & 3] * r + (bj == 0 ? bA[e >> 2][e & 3] : bB[e >> 2][e & 3]);
                            v[e] = (fminf(x, 0.f) - __logf(1.0f + fexp(-fabsf(x)))) * (1.0f / 16.0f); }
                        u32x4 w; { h16x2 p0 = {(_Float16)v[0], (_Float16)v[1]}, p1 = {(_Float16)v[2], (_Float16)v[3]}, p2 = {(_Float16)v[4], (_Float16)v[5]}, p3 = {(_Float16)v[6], (_Float16)v[7]};
                            w.x = __builtin_bit_cast(unsigned, p0); w.y = __builtin_bit_cast(unsigned, p1); w.z = __builtin_bit_cast(unsigned, p2); w.w = __builtin_bit_cast(unsigned, p3); }
                        *(u32x4*)(dst + row * pitch + (bj == 0 ? colA : colB)) = w; } }
        } else {
#pragma unroll
            for (int ai = 0; ai < 2; ++ai)
#pragma unroll
                for (int m = 0; m < 4; ++m) { const float r = rs[ai][m] * sc; const size_t row = (size_t)(u.pm * BM + ai * HALF + wr * 64 + m * 16 + fr);
#pragma unroll
                    for (int bj = 0; bj < 2; ++bj) { f32x4 o[2];
#pragma unroll
                        for (int n = 0; n < 2; ++n) { o[n] = acc[ai][bj][m][n] * r;
                            if (act) {
#pragma unroll
                                for (int j = 0; j < 4; ++j) o[n][j] = siluf_(o[n][j]); } }
                        *(u32x4*)(dst + row * pitch + (bj == 0 ? colA : colB)) = pack8(o[0], o[1]); } }
        }
        return false;
    }
};
}

__constant__ float ROPE_INV[32] = {
    1.000000000e+00f, 7.498942614e-01f, 5.623413324e-01f, 4.216965139e-01f, 3.162277639e-01f, 2.371373773e-01f, 1.778279394e-01f, 1.333521307e-01f,
    1.000000015e-01f, 7.498941571e-02f, 5.623413250e-02f, 4.216965288e-02f, 3.162277490e-02f, 2.371373773e-02f, 1.778279431e-02f, 1.333521493e-02f,
    9.999999776e-03f, 7.498941850e-03f, 5.623413250e-03f, 4.216964822e-03f, 3.162277630e-03f, 2.371373586e-03f, 1.778279431e-03f, 1.333521446e-03f,
    1.000000047e-03f, 7.498942432e-04f, 5.623413017e-04f, 4.216965172e-04f, 3.162277571e-04f, 2.371373703e-04f, 1.778279402e-04f, 1.333521504e-04f};

struct ConvJob { const float* W; int ldw; int K; bf16* WT; int nrows; const float* gain; int mode; int base; const float* gate_up; };
__device__ __forceinline__ int conv_src0(int mode, int base, int n0) {
    if (mode == 0) return base + n0;
    const int t = n0 >> 8, c = n0 & 255;
    if (mode == 1) return c < 128 ? t * 128 + c : DFF + t * 128 + (c - 128);
    const int bj = c >> 7, wc = (c >> 5) & 3;
    if (t < 18) return (t / 6) * 1536 + (4 * (t % 6) + wc) * 64 + 32 * bj;
    if (t < 20) return 4608 + (4 * (t - 18) + wc) * 64 + 32 * bj;
    if (t == 20) return 5120 + wc * 64 + 32 * bj;
    if (t == 21) return 5376 + c;
    if (t == 22) return 5632 + c;
    if (t < 25) return 5888 + 256 * (t - 23) + c;
    if (t == 25) return -1;
    return 6416 + 256 * (t - 26) + c;
}
__device__ __forceinline__ void conv_item(const ConvJob& J, LAS float* scr, int item, int lane) {
    const int nblk = J.nrows / 32, kb = item / nblk, nb = item % nblk, k0 = 64 * kb, n0 = 32 * nb;
    const int src0 = conv_src0(J.mode, J.base, n0);
    if (src0 >= 0) {
#pragma unroll 8
        for (int i = 0; i < 32; ++i) { const int kk = 2 * i + (lane >> 5); float w = J.W[(size_t)(k0 + kk) * J.ldw + src0 + (lane & 31)];
            if (J.gain) w *= J.gain[k0 + kk];
            scr[kk * 33 + (lane & 31)] = w; }
    } else {
        float ug[16];
#pragma unroll
        for (int r = 0; r < 16; ++r) ug[r] = J.gate_up[r * 256 + (n0 & 255) + (lane & 31)];
#pragma unroll 4
        for (int i = 0; i < 32; ++i) { const int kk = 2 * i + (lane >> 5); const float* wrow = J.W + (size_t)(k0 + kk) * J.ldw + 6400; float s = 0.f;
#pragma unroll
            for (int r = 0; r < 16; ++r) s += wrow[r] * ug[r];
            scr[kk * 33 + (lane & 31)] = s * J.gain[k0 + kk]; }
    }
    LDS_WAIT(); asm volatile("" ::: "memory");
    const int c = lane & 7;
#pragma unroll
    for (int j = 0; j < 4; ++j) { const int n = (lane >> 3) + 8 * j; const LAS float* s = scr + (8 * c) * 33 + n;
        v4u o; o.x = pk2(s[0 * 33], s[1 * 33]); o.y = pk2(s[2 * 33], s[3 * 33]); o.z = pk2(s[4 * 33], s[5 * 33]); o.w = pk2(s[6 * 33], s[7 * 33]);
        *(GAS v4u*)(J.WT + (size_t)(n0 + n) * J.K + k0 + 8 * c) = o; }
    LDS_WAIT(); asm volatile("" ::: "memory");
}
__device__ __forceinline__ void conv_job(Frame& F, const ConvJob& J) {
    LAS float* scr = (LAS float*)(F.lds + RING_OFF + F.wave * 16384);
    const int gw = F.vcu * NWAVES + F.wave, NGW = F.G * NWAVES, nitems = (J.nrows / 32) * (J.K / 64);
    for (int it = gw; it < nitems; it += NGW) conv_item(J, scr, it, F.lane);
}
__device__ __forceinline__ void conv_set(Frame& F, int set, int l) {
    if (set == 0 || set == 4) { ConvJob J{inptr(F, set == 0 ? 3 : 18) + (size_t)l * DM * 2 * DFF, 2 * DFF, DM, (bf16*)(F.ws + WS_S1), 2 * DFF, inptr(F, set == 0 ? 2 : 17) + (size_t)l * DM, 1, 0, nullptr}; conv_job(F, J); }
    else if (set == 1 || set == 5) { ConvJob J{inptr(F, set == 1 ? 4 : 19) + (size_t)l * DFF * DM, DM, DFF, (bf16*)(F.ws + WS_S2), DM, nullptr, 0, 0, nullptr}; conv_job(F, J); }
    else if (set == 2) { ConvJob J{inptr(F, 6) + (size_t)l * DM * INW, INW, DM, (bf16*)(F.ws + WS_STATE), 7168, inptr(F, 5) + (size_t)l * DM, 2, 0, inptr(F, 12) + (size_t)l * 16 * 256}; conv_job(F, J); }
    else {
        { ConvJob J{inptr(F, 6) + (size_t)l * DM * INW, INW, DM, (bf16*)(F.ws + WS_WG), 3072, inptr(F, 5) + (size_t)l * DM, 0, 6928, nullptr}; conv_job(F, J); }
        for (int i = 0; i < 3; ++i) { ConvJob J{inptr(F, 15) + ((size_t)l * 3 + i) * 512 * DM, DM, 512, (bf16*)(F.ws + WS_WB) + (size_t)i * DM * 512, DM, nullptr, 0, 0, nullptr}; conv_job(F, J); }
        { ConvJob J{inptr(F, 16) + (size_t)l * DM * DM, DM, DM, (bf16*)(F.ws + WS_WO), DM, nullptr, 0, 0, nullptr}; conv_job(F, J); }
    }
}

__device__ __forceinline__ void p0_rows(Frame& F) {
    const int gw = F.vcu * NWAVES + F.wave, NGW = F.G * NWAVES;
    const float* x = inptr(F, 0); const int* pos = (const int*)inptr(F, 1);
    bf16* XB = (bf16*)(F.ws + WS_XB); float* ssq = (float*)(F.ws + WS_SSQ); float* cosT = (float*)(F.ws + WS_COS); float* sinT = (float*)(F.ws + WS_SIN);
    for (int m = gw; m < M; m += NGW) {
        const GAS f32x4* xr = (const GAS f32x4*)(x + (size_t)m * DM) + F.lane; GAS f32x4* xo = (GAS f32x4*)(F.X + (size_t)m * DM) + F.lane;
        GAS v2u* o8 = (GAS v2u*)(XB + (size_t)m * DM) + F.lane; float s = 0.f;
#pragma unroll
        for (int j = 0; j < 4; ++j) { const f32x4 v = xr[64 * j]; xo[64 * j] = v; s += (v.x * v.x + v.y * v.y) + (v.z * v.z + v.w * v.w);
            v2u w; w.x = pk2(v.x, v.y); w.y = pk2(v.z, v.w); o8[64 * j] = w; }
        s = wave_sum(s);
        if (F.lane < 16) ssq[(size_t)m * 16 + F.lane] = (F.lane == 0) ? s : 0.f;
        if (F.lane < 32) { const float ang = (float)pos[m] * ROPE_INV[F.lane];
            const double rev = (double)ang * 0.15915494309189535; const float fr = (float)(rev - __builtin_rint(rev));
            cosT[(size_t)m * 32 + F.lane] = __builtin_amdgcn_cosf(fr); sinT[(size_t)m * 32 + F.lane] = __builtin_amdgcn_sinf(fr); }
    }
}

__device__ __forceinline__ void load_q64(const bf16* q, float (&qf)[64]) {
#pragma unroll
    for (int i = 0; i < 8; ++i) { const v4u w = *(const v4u*)(q + 8 * i);
        qf[8 * i + 0] = bflo(w.x); qf[8 * i + 1] = bfhi(w.x); qf[8 * i + 2] = bflo(w.y); qf[8 * i + 3] = bfhi(w.y);
        qf[8 * i + 4] = bflo(w.z); qf[8 * i + 5] = bfhi(w.z); qf[8 * i + 6] = bflo(w.w); qf[8 * i + 7] = bfhi(w.w); }
}
__device__ __forceinline__ float dot64(const float (&qf)[64], const bf16* k) {
    float s0 = 0.f, s1 = 0.f;
#pragma unroll
    for (int i = 0; i < 8; ++i) { const v4u w = *(const v4u*)(k + 8 * i);
        s0 += qf[8 * i + 0] * bflo(w.x); s1 += qf[8 * i + 1] * bfhi(w.x); s0 += qf[8 * i + 2] * bflo(w.y); s1 += qf[8 * i + 3] * bfhi(w.y);
        s0 += qf[8 * i + 4] * bflo(w.z); s1 += qf[8 * i + 5] * bfhi(w.z); s0 += qf[8 * i + 6] * bflo(w.w); s1 += qf[8 * i + 7] * bfhi(w.w); }
    return s0 + s1;
}
__device__ __forceinline__ void band_item(const bf16* Q, const bf16* Kb, const bf16* Vb, int pitch, int t, int d, int nk, float sink2, int lane, float& o_out, float& lse2) {
    float qf[64]; load_q64(Q, qf);
    float s0 = -INFINITY, s1 = -INFINITY, s2 = -INFINITY;
    { const int j = lane; if (t - j * d >= 0) s0 = dot64(qf, Kb - (size_t)j * d * pitch); }
    { const int j = lane + 64; if (t - j * d >= 0) s1 = dot64(qf, Kb - (size_t)j * d * pitch); }
    if (nk > 128 && lane == 0 && t - 128 * d >= 0) s2 = dot64(qf, Kb - (size_t)128 * d * pitch);
    float mx = wave_max(fmaxf(fmaxf(s0, s1), s2)); mx = fmaxf(mx, sink2);
    const float p0 = fexp2(s0 - mx), p1 = fexp2(s1 - mx), p2 = fexp2(s2 - mx);
    float l = wave_sum(p0 + p1 + p2) + fexp2(sink2 - mx);
    float o = 0.f;
    for (int j = 0; j < 64; ++j) { if (t - j * d < 0) break; o += __shfl(p0, j) * bf2f(Vb[-(ptrdiff_t)j * d * pitch + lane]); }
    for (int j = 64; j < 128; ++j) { if (t - j * d < 0) break; o += __shfl(p1, j - 64) * bf2f(Vb[-(ptrdiff_t)j * d * pitch + lane]); }
    if (nk > 128 && t - 128 * d >= 0) o += __shfl(p2, 0) * bf2f(Vb[-(ptrdiff_t)128 * d * pitch + lane]);
    o_out = o / l; lse2 = mx + __log2f(l);
}
__device__ __forceinline__ void attn_phase_simple(Frame& F, int l) {
    const int gw = F.vcu * NWAVES + F.wave, NGW = F.G * NWAVES, lane = F.lane;
    const float* sinks = inptr(F, 11) + l * 8;
    for (int it = gw; it < M * 8; it += NGW) {
        const int row = it >> 3, h = it & 7, t = row & (SEQ - 1);
        float y = 0.f, wsum = 0.f, mrun = -INFINITY;
#pragma unroll 1
        for (int g = 0; g < 3; ++g) {
            const int d = (g == 0) ? 1 : (g == 1 ? 4 : 16);
            const bf16* Qb = (const bf16*)(F.ws + (g == 0 ? WS_AQ0 : (g == 1 ? WS_AQ1 : WS_AQ2))) + (size_t)row * 512 + h * 64;
            const bf16* Kb = (const bf16*)(F.ws + WS_AK0 + (size_t)g * 4 * UU) + (size_t)row * 512 + h * 64;
            const bf16* Vb = (const bf16*)(F.ws + WS_AV0 + (size_t)g * 4 * UU) + (size_t)row * 512 + h * 64;
            float o, lse; band_item(Qb, Kb, Vb, 512, t, d, 129, -INFINITY, lane, o, lse);
            const float mn = fmaxf(mrun, lse), fa = fexp2(mrun - mn), fb = fexp2(lse - mn);
            y = y * fa + o * fb; wsum = wsum * fa + fb; mrun = mn;
        }
        ((bf16*)(F.ws + WS_AQ0))[(size_t)row * 512 + h * 64 + lane] = (bf16)f2bf(y / wsum);
    }
    for (int it = gw; it < M * 8; it += NGW) {
        const int row = it >> 3, hq = it & 7, t = row & (SEQ - 1), kv = hq >> 2;
        const bf16* Qb = (const bf16*)(F.ws + WS_BQ) + (size_t)row * 512 + hq * 64;
        const bf16* Kb = (const bf16*)(F.ws + WS_BK) + (size_t)row * 128 + kv * 64;
        const bf16* Vb = (const bf16*)(F.ws + WS_BV) + (size_t)row * 128 + kv * 64;
        float o, lse; band_item(Qb, Kb, Vb, 128, t, 1, 128, sinks[hq] * LOG2E, lane, o, lse);
        ((bf16*)(F.ws + WS_BQ))[(size_t)row * 512 + hq * 64 + lane] = (bf16)f2bf(o);
    }
}

__device__ __forceinline__ void gla1_phase(Frame& F) {
    LAS float* bc = (LAS float*)(F.lds);
    LAS float* kt = (LAS float*)(F.lds + 16384);
    LAS float* vv = (LAS float*)(F.lds + 32768);
    const int tid = F.tid;
    const bf16* CK = (const bf16*)(F.ws + WS_CK); const bf16* CV = (const bf16*)(F.ws + WS_CV); const _Float16* LG = (const _Float16*)(F.ws + WS_LOGG);
    bf16* ST = (bf16*)(F.ws + WS_STATE); float* DC = (float*)(F.ws + WS_DC);
    for (int item = blockIdx.x; item < 8 * 128; item += F.G) {
        const int bh = item >> 7, c = item & 127, b = bh >> 2, h = bh & 3; const size_t row0 = (size_t)b * SEQ + c * 64;
        { const int t = tid >> 3, d0 = (tid & 7) * 8;
            const v4u wl = *(const v4u*)(LG + (row0 + t) * 256 + h * 64 + d0); const v4u wk = *(const v4u*)(CK + (row0 + t) * 256 + h * 64 + d0);
            const unsigned wls[4] = {wl.x, wl.y, wl.z, wl.w}, wks[4] = {wk.x, wk.y, wk.z, wk.w};
#pragma unroll
            for (int i = 0; i < 4; ++i) { const h16x2 hh = __builtin_bit_cast(h16x2, wls[i]); bc[t * 64 + d0 + 2 * i] = (float)hh[0]; bc[t * 64 + d0 + 2 * i + 1] = (float)hh[1];
                kt[t * 64 + d0 + 2 * i] = bflo(wks[i]); kt[t * 64 + d0 + 2 * i + 1] = bfhi(wks[i]); }
            const int e0 = (tid & 7) * 16;
#pragma unroll
            for (int q = 0; q < 2; ++q) { const v4u wv = *(const v4u*)(CV + (row0 + t) * 512 + h * 128 + e0 + 8 * q); const unsigned wvs[4] = {wv.x, wv.y, wv.z, wv.w};
#pragma unroll
                for (int i = 0; i < 4; ++i) { vv[t * 128 + e0 + 8 * q + 2 * i] = bflo(wvs[i]); vv[t * 128 + e0 + 8 * q + 2 * i + 1] = bfhi(wvs[i]); } } }
        __syncthreads();
        if (tid < 64) { float run = 0.f; for (int t = 0; t < 64; ++t) { run += bc[t * 64 + tid]; bc[t * 64 + tid] = run; } DC[(size_t)item * 64 + tid] = fexp(run); }
        __syncthreads();
        for (int i = tid; i < 4096; i += 512) { const int d = i & 63; kt[i] *= fexp(bc[63 * 64 + d] - bc[i]); }
        __syncthreads();
        { const int d = tid >> 3, e0 = (tid & 7) * 16; float a[16];
#pragma unroll
            for (int j = 0; j < 16; ++j) a[j] = 0.f;
            for (int s = 0; s < 64; ++s) { const float kk = kt[s * 64 + d];
#pragma unroll
                for (int j = 0; j < 16; ++j) a[j] += kk * vv[s * 128 + e0 + j]; }
            v4u o0, o1; o0.x = pk2(a[0], a[1]); o0.y = pk2(a[2], a[3]); o0.z = pk2(a[4], a[5]); o0.w = pk2(a[6], a[7]);
            o1.x = pk2(a[8], a[9]); o1.y = pk2(a[10], a[11]); o1.z = pk2(a[12], a[13]); o1.w = pk2(a[14], a[15]);
            bf16* dst = ST + ((size_t)item * 64 + d) * 128 + e0; *(v4u*)dst = o0; *(v4u*)(dst + 8) = o1; }
        __syncthreads();
    }
}
__device__ __forceinline__ void gla2_phase(Frame& F) {
    bf16* ST = (bf16*)(F.ws + WS_STATE); const float* DC = (const float*)(F.ws + WS_DC);
    for (int gt = F.vcu * 512 + F.tid; gt < 8 * 64 * 128; gt += F.G * 512) {
        const int bh = gt >> 13, d = (gt >> 7) & 63, e = gt & 127; float S = 0.f;
        for (int c0 = 0; c0 < 128; c0 += 8) { float u[8], dc[8];
#pragma unroll
            for (int i = 0; i < 8; ++i) { const size_t ci = (size_t)bh * 128 + c0 + i; u[i] = bf2f(ST[(ci * 64 + d) * 128 + e]); dc[i] = DC[ci * 64 + d]; }
#pragma unroll
            for (int i = 0; i < 8; ++i) { const size_t ci = (size_t)bh * 128 + c0 + i; ST[(ci * 64 + d) * 128 + e] = (bf16)f2bf(S); S = dc[i] * S + u[i]; } }
    }
}
__device__ __forceinline__ void gla3_phase(Frame& F, int l) {
    LAS float* bc = (LAS float*)(F.lds);
    LAS float* qt = (LAS float*)(F.lds + 16384);
    LAS float* kt = (LAS float*)(F.lds + 32768);
    LAS float* vv = (LAS float*)(F.lds + 49408);
    LAS float* ss = (LAS float*)(F.lds + 82176);
    LAS float* at = bc;
    const int tid = F.tid;
    const bf16* CQ = (const bf16*)(F.ws + WS_CQ); const bf16* CK = (const bf16*)(F.ws + WS_CK); bf16* CV = (bf16*)(F.ws + WS_CV); const _Float16* LG = (const _Float16*)(F.ws + WS_LOGG);
    const bf16* CR = (const bf16*)(F.ws + WS_CR); const bf16* ST = (const bf16*)(F.ws + WS_STATE); const float* gain = inptr(F, 14) + l * 128;
    for (int item = blockIdx.x; item < 8 * 128; item += F.G) {
        const int bh = item >> 7, c = item & 127, b = bh >> 2, h = bh & 3; const size_t row0 = (size_t)b * SEQ + c * 64;
        { const int t = tid >> 3, d0 = (tid & 7) * 8;
            const v4u wl = *(const v4u*)(LG + (row0 + t) * 256 + h * 64 + d0); const v4u wk = *(const v4u*)(CK + (row0 + t) * 256 + h * 64 + d0); const v4u wq = *(const v4u*)(CQ + (row0 + t) * 256 + h * 64 + d0);
            const unsigned wls[4] = {wl.x, wl.y, wl.z, wl.w}, wks[4] = {wk.x, wk.y, wk.z, wk.w}, wqs[4] = {wq.x, wq.y, wq.z, wq.w};
#pragma unroll
            for (int i = 0; i < 4; ++i) { const h16x2 hh = __builtin_bit_cast(h16x2, wls[i]); bc[t * 64 + d0 + 2 * i] = (float)hh[0]; bc[t * 64 + d0 + 2 * i + 1] = (float)hh[1];
                kt[t * 65 + d0 + 2 * i] = bflo(wks[i]); kt[t * 65 + d0 + 2 * i + 1] = bfhi(wks[i]);
                qt[t * 64 + d0 + 2 * i] = bflo(wqs[i]); qt[t * 64 + d0 + 2 * i + 1] = bfhi(wqs[i]); }
            const int e0 = (tid & 7) * 16;
#pragma unroll
            for (int q = 0; q < 2; ++q) { const v4u wv = *(const v4u*)(CV + (row0 + t) * 512 + h * 128 + e0 + 8 * q); const unsigned wvs[4] = {wv.x, wv.y, wv.z, wv.w};
                const v4u wsv = *(const v4u*)(ST + ((size_t)item * 64 + t) * 128 + e0 + 8 * q); const unsigned wss[4] = {wsv.x, wsv.y, wsv.z, wsv.w};
#pragma unroll
                for (int i = 0; i < 4; ++i) { vv[t * 128 + e0 + 8 * q + 2 * i] = bflo(wvs[i]); vv[t * 128 + e0 + 8 * q + 2 * i + 1] = bfhi(wvs[i]);
                    ss[t * 128 + e0 + 8 * q + 2 * i] = bflo(wss[i]); ss[t * 128 + e0 + 8 * q + 2 * i + 1] = bfhi(wss[i]); } } }
        __syncthreads();
        if (tid < 64) { float run = 0.f; for (int t = 0; t < 64; ++t) { run += bc[t * 64 + tid]; bc[t * 64 + tid] = run; } }
        __syncthreads();
        for (int i = tid; i < 4096; i += 512) { const float bb = bc[i]; qt[i] *= fexp(bb); kt[(i >> 6) * 65 + (i & 63)] *= fexp(-bb); }
        __syncthreads();
        { const int t = tid >> 3, s0 = (tid & 7) * 8; float a[8];
#pragma unroll
            for (int j = 0; j < 8; ++j) a[j] = 0.f;
            for (int d = 0; d < 64; ++d) { const float qq = qt[t * 64 + d];
#pragma unroll
                for (int j = 0; j < 8; ++j) a[j] += qq * kt[(s0 + j) * 65 + d]; }
#pragma unroll
            for (int j = 0; j < 8; ++j) at[t * 64 + s0 + j] = (s0 + j <= t) ? a[j] : 0.f; }
        __syncthreads();
        { const int t = tid >> 3, e0 = (tid & 7) * 16; float a[16];
#pragma unroll
            for (int j = 0; j < 16; ++j) a[j] = 0.f;
            for (int d = 0; d < 64; ++d) { const float qq = qt[t * 64 + d];
#pragma unroll
                for (int j = 0; j < 16; ++j) a[j] += qq * ss[d * 128 + e0 + j]; }
            for (int s = 0; s <= t; ++s) { const float aa = at[t * 64 + s];
#pragma unroll
                for (int j = 0; j < 16; ++j) a[j] += aa * vv[s * 128 + e0 + j]; }
            float q2 = 0.f;
#pragma unroll
            for (int j = 0; j < 16; ++j) q2 += a[j] * a[j];
            q2 += __shfl_xor(q2, 1); q2 += __shfl_xor(q2, 2); q2 += __shfl_xor(q2, 4);
            const float rn = 1.0f / sqrtf(q2 * (1.0f / 128.0f) + NORM_EPS);
            const bf16* cr = CR + (row0 + t) * 512 + h * 128 + e0; const v4u c0 = *(const v4u*)cr, c1 = *(const v4u*)(cr + 8);
            const float cf[16] = {bflo(c0.x), bfhi(c0.x), bflo(c0.y), bfhi(c0.y), bflo(c0.z), bfhi(c0.z), bflo(c0.w), bfhi(c0.w), bflo(c1.x), bfhi(c1.x), bflo(c1.y), bfhi(c1.y), bflo(c1.z), bfhi(c1.z), bflo(c1.w), bfhi(c1.w)};
#pragma unroll
            for (int j = 0; j < 16; ++j) a[j] = a[j] * rn * gain[e0 + j] * cf[j];
            v4u o0, o1; o0.x = pk2(a[0], a[1]); o0.y = pk2(a[2], a[3]); o0.z = pk2(a[4], a[5]); o0.w = pk2(a[6], a[7]);
            o1.x = pk2(a[8], a[9]); o1.y = pk2(a[10], a[11]); o1.z = pk2(a[12], a[13]); o1.w = pk2(a[14], a[15]);
            bf16* dst = CV + (row0 + t) * 512 + h * 128 + e0; *(v4u*)dst = o0; *(v4u*)(dst + 8) = o1; }
        __syncthreads();
    }
}

template <class T> __device__ __forceinline__ T* launder(T* p) {
    unsigned long long v = (unsigned long long)p; unsigned lo = (unsigned)v, hi = (unsigned)(v >> 32);
    asm volatile("" : "+s"(lo), "+s"(hi));
    return (T*)(((unsigned long long)hi << 32) | lo);
}
constexpr int PH_PER_LAYER = 11, N_PHASES = 1 + NLAYER * PH_PER_LAYER;
struct Args { const void* in[20]; float* out; unsigned char* ws; int ph_lo, ph_hi, li, pad; };
__global__ void __launch_bounds__(NWAVES * 64, 2) mk_fwd(Args args) {
    extern __shared__ __attribute__((aligned(16))) unsigned char lds[];
    Frame F;
    F.lds = (LAS unsigned char*)lds;
    F.MISC = (volatile LAS unsigned*)(F.lds + MISC_OFF);
    F.tid = threadIdx.x; F.lane = F.tid & 63; F.wave = __builtin_amdgcn_readfirstlane(F.tid >> 6);
    F.G = gridDim.x; { const int bx = blockIdx.x; F.vcu = (F.G % 8 == 0) ? (bx % 8) * (F.G / 8) + bx / 8 : bx; }
    F.ws = args.ws; F.X = args.out;
    F.ctl = (gu32*)(args.ws + WS_CTL);
    for (int u = F.tid; u < (LDS_BYTES - LDSCTL_OFF) / 4; u += NWAVES * 64) ((LAS unsigned*)(F.lds + LDSCTL_OFF))[u] = 0u;
    __syncthreads();
    if (F.tid == 0) {
#pragma unroll
        for (int i = 0; i < 20; ++i) ((LAS unsigned long long*)(F.lds + INTAB_OFF))[i] = (unsigned long long)args.in[i];
    }
    __syncthreads();
    XcdBarrier bar; bar.bar = (unsigned*)(F.ctl + CW_BAR); bar.x = 0; bar.st = nullptr;
    if (!MK_PER_PHASE) bar = xcd_barrier_post((unsigned*)(F.ctl + CW_BAR), F.MISC + 8);
    for (int ph = args.ph_lo; ph < args.ph_hi; ++ph) {
        { int t_ = threadIdx.x; asm volatile("" : "+v"(t_)); t_ &= 511; F.tid = t_; F.lane = t_ & 63; F.wave = __builtin_amdgcn_readfirstlane(t_ >> 6); }
        F.ws = launder(args.ws); F.X = launder(args.out);
        const float* ssq = (const float*)(F.ws + WS_SSQ);
        pg8::bf16_t* XB = (pg8::bf16_t*)(F.ws + WS_XB);
        if (ph == 0) {
            p0_rows(F); conv_set(F, 0, 0); conv_set(F, 1, 0); conv_set(F, 2, 0); conv_set(F, 3, 0);
        } else {
            const int l = (ph - 1) / PH_PER_LAYER, k = (ph - 1) % PH_PER_LAYER;
            if (k == 0 || k == 9) {
                if (k == 0 && l > 0) { conv_set(F, 1, l); __syncthreads(); }
                if (k == 9 && l + 1 < NLAYER) { conv_set(F, 3, l + 1); conv_set(F, 2, l + 1); __syncthreads(); }
                pg8::Gemm g{XB, XB, XB, (const pg8::bf16_t*)(F.ws + WS_S1), nullptr, nullptr, M, 2 * DFF, DM};
                pg8::StaticOrder S; S.init(M, 2 * DFF, F.G, (int)blockIdx.x);
                pg8::EpiSwiglu E{(pg8::bf16_t*)(F.ws + WS_ACTH), ssq};
                pg8::gemm_phase<pg8::EpiSwiglu, pg8::StaticOrder, true>(F.lds + RING_OFF, g, S, E);
            } else if (k == 1 || k == 10) {
                if (k == 10 && l + 1 < NLAYER) { conv_set(F, 0, l + 1); __syncthreads(); }
                const pg8::bf16_t* A = (const pg8::bf16_t*)(F.ws + WS_ACTH);
                pg8::Gemm g{A, A, A, (const pg8::bf16_t*)(F.ws + WS_S2), nullptr, nullptr, M, DM, DFF};
                pg8::StaticOrder S; S.init(M, DM, F.G, (int)blockIdx.x);
                pg8::EpiResidual E{F.X, XB, (float*)(F.ws + WS_SSQ), 0.5f};
                pg8::gemm_phase<pg8::EpiResidual, pg8::StaticOrder, false>(F.lds + RING_OFF, g, S, E);
            } else if (k == 2) {
                conv_set(F, 4, l); conv_set(F, 5, l); __syncthreads();
                pg8::Gemm g{XB, XB, XB, (const pg8::bf16_t*)(F.ws + WS_STATE), nullptr, nullptr, M, 7168, DM};
                pg8::StaticOrder S; S.init(M, 7168, F.G, (int)blockIdx.x);
                pg8::EpiInProj E{F.ws, ssq, (const float*)(F.ws + WS_COS), (const float*)(F.ws + WS_SIN), inptr(F, 7) + l * 64, inptr(F, 8) + l * 64, inptr(F, 9) + l * 64, inptr(F, 10) + l * 64, inptr(F, 13) + l * 256};
                pg8::gemm_phase<pg8::EpiInProj, pg8::StaticOrder, true>(F.lds + RING_OFF, g, S, E);
            } else if (k == 3) {
                gla1_phase(F); attn_phase_simple(F, l);
            } else if (k == 4) { gla2_phase(F);
            } else if (k == 5) { gla3_phase(F, l);
            } else if (k == 6) {
                pg8::Gemm g{XB, XB, XB, (const pg8::bf16_t*)(F.ws + WS_WG), nullptr, nullptr, M, 3 * DM, DM};
                pg8::StaticOrder S; S.init(M, 3 * DM, F.G, (int)blockIdx.x);
                pg8::EpiSigmoid E{(pg8::bf16_t*)(F.ws + WS_GATES), ssq};
                pg8::gemm_phase<pg8::EpiSigmoid, pg8::StaticOrder, true>(F.lds + RING_OFF, g, S, E);
            } else if (k == 7) {
                const pg8::bf16_t* WB = (const pg8::bf16_t*)(F.ws + WS_WB);
                pg8::Gemm g{(const pg8::bf16_t*)(F.ws + WS_AQ0), (const pg8::bf16_t*)(F.ws + WS_BQ), (const pg8::bf16_t*)(F.ws + WS_CV), WB, WB + (size_t)DM * 512, WB + (size_t)2 * DM * 512, M, DM, 512};
                pg8::Seg3Order S; S.b.init(M, DM, F.G, (int)blockIdx.x);
                pg8::EpiMerge E{(const pg8::bf16_t*)(F.ws + WS_GATES), (pg8::bf16_t*)(F.ws + WS_MERGED)};
                pg8::gemm_phase<pg8::EpiMerge, pg8::Seg3Order, false>(F.lds + RING_OFF, g, S, E);
            } else {
                const pg8::bf16_t* A = (const pg8::bf16_t*)(F.ws + WS_MERGED);
                pg8::Gemm g{A, A, A, (const pg8::bf16_t*)(F.ws + WS_WO), nullptr, nullptr, M, DM, DM};
                pg8::StaticOrder S; S.init(M, DM, F.G, (int)blockIdx.x);
                pg8::EpiResidual E{F.X, XB, (float*)(F.ws + WS_SSQ), 1.0f};
                pg8::gemm_phase<pg8::EpiResidual, pg8::StaticOrder, false>(F.lds + RING_OFF, g, S, E);
            }
        }
        if (ph + 1 < args.ph_hi) xcd_barrier(bar);
    }
}

extern "C" void kernel_launch(void* const* d_in, const int* in_sizes, int n_in, void* d_out, int out_size, void* d_ws, size_t ws_size, hipStream_t stream) {
    static int grid = 0;
    if (grid == 0) {
        if (n_in != 20 || out_size != M * DM || ws_size < WS_END) { fprintf(stderr, "kernel_launch: unexpected problem (n_in %d, out %d, ws %zu < %zu); nothing launched\n", n_in, out_size, ws_size, (size_t)WS_END); grid = -1; return; }
        int dev = 0, cus = 0, per_cu = 0;
        if (hipGetDevice(&dev) != hipSuccess || hipDeviceGetAttribute(&cus, hipDeviceAttributeMultiprocessorCount, dev) != hipSuccess) { grid = -1; return; }
        if (hipFuncSetAttribute((const void*)mk_fwd, hipFuncAttributeMaxDynamicSharedMemorySize, LDS_BYTES) != hipSuccess) { fprintf(stderr, "kernel_launch: hipFuncSetAttribute failed\n"); grid = -1; return; }
        if (hipOccupancyMaxActiveBlocksPerMultiprocessor(&per_cu, (const void*)mk_fwd, NWAVES * 64, LDS_BYTES) != hipSuccess || per_cu < 1)
            fprintf(stderr, "kernel_launch: note: occupancy query reports %d workgroups per CU\n", per_cu);
        (void)hipGetLastError();
        grid = cus;
    }
    if (grid < 0) return;
    if (hipMemsetAsync((char*)d_ws + WS_CTL, 0, CTL_ZERO_BYTES, stream) != hipSuccess) return;
    Args a{};
    for (int i = 0; i < 20; ++i) a.in[i] = d_in[i];
    a.out = (float*)d_out; a.ws = (unsigned char*)d_ws;
#if MK_PER_PHASE
    for (int p = 0; p < N_PHASES; ++p) { a.ph_lo = p; a.ph_hi = p + 1; a.li = p; hipLaunchKernelGGL(mk_fwd, dim3(grid), dim3(NWAVES * 64), LDS_BYTES, stream, a); }
#else
    a.ph_lo = 0; a.ph_hi = N_PHASES; a.li = 0;
    hipLaunchKernelGGL(mk_fwd, dim3(grid), dim3(NWAVES * 64), LDS_BYTES, stream, a);
#endif
}
```

```cpp
#include <hip/hip_runtime.h>
#include <cstdio>
#include <cstdint>

#ifndef MK_PER_PHASE
#define MK_PER_PHASE 0
#endif

namespace pg8 {
#define PG8_LAS __attribute__((address_space(3)))
typedef unsigned short bf16_t;
typedef short bf16x8 __attribute__((ext_vector_type(8)));
typedef float f32x4 __attribute__((ext_vector_type(4)));
typedef unsigned u32x4 __attribute__((ext_vector_type(4)));
constexpr int BM = 256, BK = 64, HALF = 128, HTB = HALF * BK * 2  , STAGE_BYTES = 8 * HTB, NXCD = 8, WGM = 8;

__host__ __device__ __forceinline__ int lds_byte(int r, int c) { const int st = (r >> 4) * 2 + (c >> 5), rr = r & 15, cc = c & 31, ob = rr * 64 + cc * 2; return st * 1024 + (ob ^ (((ob >> 9) & 1) << 5)); }
__host__ __device__ __forceinline__ void stage_rc(int b, int& R, int& C) { const int st = b / 1024, sb = b % 1024, swz = sb ^ (((sb >> 9) & 1) << 5); R = (st >> 1) * 16 + swz / 64; C = (st & 1) * 32 + (swz % 64) / 2; }
__host__ __device__ __forceinline__ int perm32(int rho) { const int n = rho >> 4, i = rho & 15; return 8 * (i >> 2) + 4 * n + (i & 3); }

struct Unit { int pm, pn, seg; };
struct Gemm { const bf16_t* A0; const bf16_t* A1; const bf16_t* A2; const bf16_t* B0; const bf16_t* B1; const bf16_t* B2; int M, N, K; };

struct StaticOrder {
    int nM, nN, nwg, G, c;
    __host__ __device__ void init(int M, int N, int G_, int c_) { nM = M / BM; nN = N / BM; nwg = nM * nN; G = G_; c = c_; }
    __host__ __device__ bool next(int i, Unit& u) const {
        const long L = (long)i * G + c; if (L >= nwg) return false;
        int wgid = (int)L; { const int q = nwg / NXCD, r = nwg % NXCD, xcd = wgid % NXCD, off = wgid / NXCD; wgid = (xcd < r ? xcd * (q + 1) : r * (q + 1) + (xcd - r) * q) + off; }
        const int nig = WGM * nN, gid = wgid / nig, fm = gid * WGM, gsz = (nM - fm) < WGM ? (nM - fm) : WGM;
        u.pm = fm + ((wgid % nig) % gsz); u.pn = (wgid % nig) / gsz; u.seg = 0; return true;
    }
};
struct Seg3Order {
    StaticOrder b;
    __host__ __device__ bool next(int i, Unit& u) const { if (!b.next(i / 3, u)) return false; u.seg = i % 3; return true; }
};

typedef float f32x2_t __attribute__((ext_vector_type(2))); typedef __bf16 bf16x2_t __attribute__((ext_vector_type(2)));
__device__ __forceinline__ unsigned cvt_pk_bf16(float lo, float hi) { f32x2_t v = {lo, hi}; bf16x2_t b = __builtin_convertvector(v, bf16x2_t); return __builtin_bit_cast(unsigned, b); }

template <class Epi, class Sched, bool ALIGN_EPI = false>
__device__ __forceinline__ void gemm_phase(PG8_LAS unsigned char* lds, const Gemm g, const Sched& S, const Epi& E) {
    int tid_ = threadIdx.x; asm volatile("" : "+v"(tid_));
    const int tid = tid_ & 511, wid = __builtin_amdgcn_readfirstlane(tid >> 6), lane = tid & 63, wr = wid >> 2, wc = wid & 3, fr = lane & 15, fq = lane >> 4;
    const int K = g.K, nt = K / BK;
    unsigned voffA[2], voffB[2];
#pragma unroll
    for (int i = 0; i < 2; ++i) { int R, C; stage_rc(tid * 16 + i * 8192, R, C); const int Rb = Epi::PERM ? ((R & ~31) + perm32(R & 31)) : R;
        voffA[i] = (unsigned)(R * K + C) * 2u; voffB[i] = (unsigned)(Rb * K + C) * 2u; }
    const size_t kstep = (size_t)(BK * 2);
    const size_t hstep = (size_t)HALF * K * 2;
    const size_t tstep = 2 * hstep;
    const unsigned ldsw = (unsigned)wid * 1024u;
    const int aoff = lds_byte(wr * 64 + fr, fq * 8), boff = lds_byte(wc * 32 + fr, fq * 8);
#define PG8_SA(b, h) (((b) * 2 + (h)) * HTB)
#define PG8_SB(b, h) ((4 + (b) * 2 + (h)) * HTB)
#define PG8_STAGE(bufoff, gbase, voff) do { _Pragma("unroll") for (int _i = 0; _i < 2; ++_i) \
        __builtin_amdgcn_global_load_lds((const unsigned*)((const char*)(gbase) + (voff)[_i]), (PG8_LAS unsigned*)(lds + (bufoff) + ldsw + _i * 8192), 16, 0, 0); } while (0)
#define PG8_LDA(dst, b, h) do { _Pragma("unroll") for (int m = 0; m < 4; ++m) _Pragma("unroll") for (int k = 0; k < 2; ++k) dst[m][k] = *(const PG8_LAS bf16x8*)(lds + PG8_SA(b, h) + aoff + m * 2048 + k * 1024); } while (0)
#define PG8_LDB(dst, b, h) do { _Pragma("unroll") for (int n = 0; n < 2; ++n) _Pragma("unroll") for (int k = 0; k < 2; ++k) dst[n][k] = *(const PG8_LAS bf16x8*)(lds + PG8_SB(b, h) + boff + n * 2048 + k * 1024); } while (0)
#define PG8_MMA(ai, bj, At, Bt) do { __builtin_amdgcn_s_setprio(1); _Pragma("unroll") for (int m = 0; m < 4; ++m) _Pragma("unroll") for (int n = 0; n < 2; ++n) _Pragma("unroll") for (int k = 0; k < 2; ++k) \
        acc[ai][bj][m][n] = __builtin_amdgcn_mfma_f32_16x16x32_bf16(Bt[n][k], At[m][k], acc[ai][bj][m][n], 0, 0, 0); __builtin_amdgcn_s_setprio(0); } while (0)
#define PG8_WAIT_V(n) asm volatile("s_waitcnt vmcnt(" #n ")" ::: "memory")
#define PG8_WAIT_L(n) asm volatile("s_waitcnt lgkmcnt(" #n ")" ::: "memory")
#define PG8_BAR __builtin_amdgcn_s_barrier()
#define PG8_SCHED __builtin_amdgcn_sched_barrier(0)
#define PG8_ASEL(u) ((u).seg == 0 ? g.A0 : ((u).seg == 1 ? g.A1 : g.A2))
#define PG8_BSEL(u) ((u).seg == 0 ? g.B0 : ((u).seg == 1 ? g.B1 : g.B2))
    Unit cur, nxt; int ui = 0;
    if (!S.next(0, cur)) return;
    f32x4 acc[2][2][4][2];
#pragma unroll
    for (int a = 0; a < 2; ++a)
#pragma unroll
        for (int b = 0; b < 2; ++b)
#pragma unroll
            for (int m = 0; m < 4; ++m)
#pragma unroll
                for (int n = 0; n < 2; ++n) acc[a][b][m][n] = (f32x4){0.f, 0.f, 0.f, 0.f};
    bf16x8 At[4][2], B0[2][2], B1[2][2];
    const char* cA = (const char*)PG8_ASEL(cur) + (size_t)cur.pm * tstep; const char* cB = (const char*)PG8_BSEL(cur) + (size_t)cur.pn * tstep;
    PG8_STAGE(PG8_SB(0, 0), cB, voffB); PG8_STAGE(PG8_SB(0, 1), cB + hstep, voffB); PG8_STAGE(PG8_SA(0, 0), cA, voffA); PG8_STAGE(PG8_SA(0, 1), cA + hstep, voffA);
    if (wr == 1) PG8_BAR;
    PG8_WAIT_V(2); PG8_BAR;
    PG8_STAGE(PG8_SB(1, 0), cB + kstep, voffB); PG8_STAGE(PG8_SA(1, 0), cA + kstep, voffA); PG8_STAGE(PG8_SB(1, 1), cB + hstep + kstep, voffB);
    PG8_WAIT_V(6); PG8_BAR;
    for (;;) {
        const bool has_next = S.next(ui + 1, nxt);
        const char* nA = has_next ? (const char*)PG8_ASEL(nxt) + (size_t)nxt.pm * tstep : cA; const char* nB = has_next ? (const char*)PG8_BSEL(nxt) + (size_t)nxt.pn * tstep : cB;
        for (int t = 0; t < nt; t += 2) {
            const bool last = (t == nt - 2);
            const char* a1 = cA + (size_t)(t + 1) * kstep;
            const char* a2 = last ? nA : cA + (size_t)(t + 2) * kstep; const char* b2 = last ? nB : cB + (size_t)(t + 2) * kstep;
            const char* a3 = a2 + kstep; const char* b3 = b2 + kstep;
            PG8_LDB(B0, 0, 0); PG8_LDB(B1, 0, 1); PG8_SCHED; PG8_LDA(At, 0, 0); PG8_STAGE(PG8_SA(1, 1), a1 + hstep, voffA);
            PG8_WAIT_V(8); PG8_WAIT_L(0); PG8_BAR; PG8_MMA(0, 0, At, B0); PG8_MMA(0, 1, At, B1); PG8_BAR; PG8_SCHED;
            PG8_LDA(At, 0, 1); PG8_STAGE(PG8_SB(0, 0), b2, voffB); PG8_STAGE(PG8_SB(0, 1), b2 + hstep, voffB); PG8_STAGE(PG8_SA(0, 0), a2, voffA);
            PG8_WAIT_V(8); PG8_WAIT_L(0); PG8_BAR; PG8_MMA(1, 0, At, B0); PG8_MMA(1, 1, At, B1); PG8_BAR; PG8_SCHED;
            PG8_LDB(B0, 1, 0); PG8_LDB(B1, 1, 1); PG8_SCHED; PG8_LDA(At, 1, 0); PG8_STAGE(PG8_SA(0, 1), a2 + hstep, voffA);
            PG8_WAIT_V(8); PG8_WAIT_L(0); PG8_BAR; PG8_MMA(0, 0, At, B0); PG8_MMA(0, 1, At, B1); PG8_BAR; PG8_SCHED;
            PG8_LDA(At, 1, 1); PG8_STAGE(PG8_SB(1, 0), b3, voffB); PG8_STAGE(PG8_SB(1, 1), b3 + hstep, voffB); PG8_STAGE(PG8_SA(1, 0), a3, voffA);
            PG8_WAIT_V(8); PG8_WAIT_L(0); PG8_BAR; PG8_MMA(1, 0, At, B0); PG8_MMA(1, 1, At, B1); PG8_BAR; PG8_SCHED;
        }
        if constexpr (ALIGN_EPI) { if (wr == 0) PG8_BAR; }
        const bool keep = E(acc, cur, wr, wc, fr, fq, lane);
        if (!has_next) break;
        if (!keep) {
#pragma unroll
        for (int a = 0; a < 2; ++a)
#pragma unroll
            for (int b = 0; b < 2; ++b)
#pragma unroll
                for (int m = 0; m < 4; ++m)
#pragma unroll
                    for (int n = 0; n < 2; ++n) acc[a][b][m][n] = (f32x4){0.f, 0.f, 0.f, 0.f};
        }
        cur = nxt; cA = nA; cB = nB; ++ui;
        if constexpr (ALIGN_EPI) { if (wr == 1) PG8_BAR; }
    }
    PG8_WAIT_V(0);
    if constexpr (!ALIGN_EPI) { if (wr == 0) PG8_BAR; }
    PG8_BAR;
#undef PG8_SA
#undef PG8_SB
#undef PG8_STAGE
#undef PG8_LDA
#undef PG8_LDB
#undef PG8_MMA
#undef PG8_WAIT_V
#undef PG8_WAIT_L
#undef PG8_BAR
#undef PG8_SCHED
#undef PG8_ASEL
#undef PG8_BSEL
}
}

constexpr int NWAVES = 8;
constexpr int BATCH = 2, SEQ = 8192, DM = 1024, M = BATCH * SEQ, DFF = 2816, NLAYER = 2, INW = 10000;
constexpr float NORM_EPS = 1e-6f;
constexpr float LOG2E = 1.4426950408889634f;
constexpr float QSCALE = 0.125f * LOG2E;

constexpr size_t MiB = 1u << 20;
constexpr size_t WS_CTL = 0, CTL_ZERO_BYTES = 1 * MiB;
constexpr size_t WS_SSQ = 1 * MiB;
constexpr size_t WS_COS = 2 * MiB, WS_SIN = 4 * MiB;
constexpr size_t WS_S1 = 6 * MiB;
constexpr size_t WS_S2 = 17 * MiB;
constexpr size_t WS_DC = 22 * MiB + 512 * 1024;
constexpr size_t WS_WG = 23 * MiB;
constexpr size_t WS_WB = 29 * MiB;
constexpr size_t WS_WO = 32 * MiB;
constexpr size_t WS_ACT = 34 * MiB;
constexpr size_t UU = 4 * MiB;
constexpr size_t WS_AQ0 = WS_ACT + 0 * UU, WS_AQ1 = WS_ACT + 4 * UU, WS_AQ2 = WS_ACT + 8 * UU;
constexpr size_t WS_AK0 = WS_ACT + 12 * UU, WS_AV0 = WS_ACT + 24 * UU;
constexpr size_t WS_GATES = WS_ACT + 4 * UU;
constexpr size_t WS_MERGED = WS_ACT + 28 * UU;
constexpr size_t WS_BQ = WS_ACT + 36 * UU, WS_BK = WS_ACT + 40 * UU, WS_BV = WS_ACT + 41 * UU;
constexpr size_t WS_CQ = WS_ACT + 42 * UU, WS_CK = WS_ACT + 44 * UU, WS_CV = WS_ACT + 46 * UU;
constexpr size_t WS_LOGG = WS_ACT + 50 * UU;
constexpr size_t WS_CR = WS_ACT + 52 * UU;
constexpr size_t WS_STATE = WS_ACT + 56 * UU;
constexpr size_t WS_XB = WS_ACT + 60 * UU;
constexpr size_t WS_ACTH = WS_ACT;
constexpr size_t WS_END = WS_ACT + 68 * UU;
static_assert(WS_S1 + (size_t)2 * DFF * DM * 2 <= WS_S2 && WS_S2 + (size_t)DM * DFF * 2 <= WS_DC && WS_DC + 8 * 128 * 64 * 4 <= WS_WG, "ws map");
static_assert((size_t)M * DFF * 2 <= 22 * UU && (size_t)7168 * 1024 * 2 <= 4 * UU, "ws map 2");
constexpr int CW_TMO = 0, CW_CODE = 1;
constexpr int CW_BAR = 4096;

constexpr int RING_OFF = 0, RING_BYTES = 131072;
constexpr int LDSCTL_OFF = RING_BYTES, MISC_OFF = LDSCTL_OFF + 320;
constexpr int LDS_BYTES = 147456;
constexpr int INTAB_OFF = MISC_OFF + 256;

#define GAS __attribute__((address_space(1)))
#define LAS __attribute__((address_space(3)))
typedef unsigned short bf16;
typedef unsigned v4u __attribute__((ext_vector_type(4)));
typedef unsigned v2u __attribute__((ext_vector_type(2)));
typedef float f32x4 __attribute__((ext_vector_type(4)));
typedef short bf16x8 __attribute__((ext_vector_type(8)));
typedef _Float16 h16x2 __attribute__((ext_vector_type(2)));
typedef GAS unsigned gu32;
#define RLX_AGENT __ATOMIC_RELAXED, __HIP_MEMORY_SCOPE_AGENT
#define LDS_WAIT() asm volatile("s_waitcnt lgkmcnt(0)" ::: "memory")
#define VM_WAIT() asm volatile("s_waitcnt vmcnt(0)" ::: "memory")
__device__ __forceinline__ unsigned f2bf(float f) { unsigned u = __builtin_bit_cast(unsigned, f); return (u + 0x7fffu + ((u >> 16) & 1u)) >> 16; }
__device__ __forceinline__ unsigned pk2(float lo, float hi) { return f2bf(lo) | (f2bf(hi) << 16); }
__device__ __forceinline__ float bflo(unsigned w) { return __builtin_bit_cast(float, w << 16); }
__device__ __forceinline__ float bfhi(unsigned w) { return __builtin_bit_cast(float, w & 0xffff0000u); }
__device__ __forceinline__ float bf2f(bf16 h) { return __builtin_bit_cast(float, (unsigned)h << 16); }
__device__ __forceinline__ float fexp2(float x) { return __builtin_amdgcn_exp2f(x); }
__device__ __forceinline__ float fexp(float x) { return __builtin_amdgcn_exp2f(x * LOG2E); }
__device__ __forceinline__ float frcp(float x) { return __builtin_amdgcn_rcpf(x); }
__device__ __forceinline__ float sigmoidf_(float x) { return frcp(1.0f + fexp(-x)); }
__device__ __forceinline__ float siluf_(float x) { return x * sigmoidf_(x); }

#define XB_TMO      128
#define XB_XCNT(j)  (256  + 64 * (j))
#define XB_XSUB(j)  (1280 + 64 * (j))
#define XB_XGEN(j)  (2304 + 64 * (j))
#define XB_TOP      3328
#define XB_TOPGEN   3392
#define XCD_BAR_WORDS 3456
#define XB_SPIN_CAP (1u << 18)
__device__ __forceinline__ unsigned xb_ld(unsigned* p)              { return __hip_atomic_load(p, __ATOMIC_RELAXED, __HIP_MEMORY_SCOPE_AGENT); }
__device__ __forceinline__ unsigned xb_add(unsigned* p, unsigned v) { return __hip_atomic_fetch_add(p, v, __ATOMIC_RELAXED, __HIP_MEMORY_SCOPE_AGENT); }
__device__ __forceinline__ unsigned xb_xcc_id() { return (unsigned)__builtin_amdgcn_s_getreg((3 << 11) | 20) & 0xFu; }
#define XB_SPIN(cond, bar) do { unsigned _sp = 0; while (cond) { __builtin_amdgcn_s_sleep(1); \
    if ((++_sp & 255u) == 0u) { if (xb_ld(&(bar)[XB_TMO])) break; if (_sp > XB_SPIN_CAP) { atomicAdd(&(bar)[XB_TMO], 1u); break; } } } } while (0)
struct XcdBarrier { unsigned* bar; unsigned x; volatile LAS unsigned* st; };
__device__ __forceinline__ XcdBarrier xcd_barrier_post(unsigned* bar, volatile LAS unsigned* st) {
    XcdBarrier b; b.bar = bar; b.x = xb_xcc_id(); b.st = st;
    if (threadIdx.x == 0) (void)xb_add(&bar[XB_XCNT(b.x)], 1u);
    return b;
}
__device__ __forceinline__ void xcd_barrier_complete(unsigned* bar, unsigned x, unsigned& nloc, unsigned& nx) {
    const unsigned G = gridDim.x * gridDim.y * gridDim.z;
    unsigned sum, cnt, mine, sp = 0u;
    for (;;) {
        sum = 0u; cnt = 0u; mine = 0u;
#pragma unroll
        for (unsigned j = 0; j < 16; ++j) { const unsigned c = xb_ld(&bar[XB_XCNT(j)]); sum += c; cnt += (c > 0u) ? 1u : 0u; mine = (j == x) ? c : mine; }
        if (sum == G) break;
        __builtin_amdgcn_s_sleep(1);
        if ((++sp & 255u) == 0u) { if (xb_ld(&bar[XB_TMO])) break; if (sp > XB_SPIN_CAP) { atomicAdd(&bar[XB_TMO], 1u); break; } }
    }
    nloc = mine > 0u ? mine : 1u; nx = cnt > 0u ? cnt : 1u;
}
__device__ __forceinline__ void xcd_barrier(const XcdBarrier& b) {
    asm volatile("s_waitcnt vmcnt(0)" ::: "memory");
    __syncthreads();
    if (threadIdx.x == 0) {
        unsigned* bar = b.bar;
        __builtin_amdgcn_s_waitcnt(0);
        unsigned nloc = b.st[0], nx = b.st[1];
        if (nloc == 0u) { xcd_barrier_complete(bar, b.x, nloc, nx); b.st[0] = nloc; b.st[1] = nx; }
        const unsigned old = xb_add(&bar[XB_XSUB(b.x)], 1u);
        const unsigned gen = old / nloc;
        if (old + 1u == (gen + 1u) * nloc) {
            __builtin_amdgcn_fence(__ATOMIC_RELEASE, "agent");
            asm volatile("s_waitcnt vmcnt(0)" ::: "memory");
            const unsigned og = xb_add(&bar[XB_TOP], 1u);
            const unsigned tg = og / nx;
            if (og + 1u == (tg + 1u) * nx) xb_add(&bar[XB_TOPGEN], 1u);
            else XB_SPIN(xb_ld(&bar[XB_TOPGEN]) == tg, bar);
            __builtin_amdgcn_fence(__ATOMIC_ACQUIRE, "agent");
            xb_add(&bar[XB_XGEN(b.x)], 1u);
            asm volatile("s_waitcnt vmcnt(0)" ::: "memory");
        } else {
            XB_SPIN(xb_ld(&bar[XB_XGEN(b.x)]) == gen, bar);
            __builtin_amdgcn_fence(__ATOMIC_ACQUIRE, "agent");
            asm volatile("s_waitcnt vmcnt(0)" ::: "memory");
        }
    }
    __syncthreads();
}

struct Frame {
    LAS unsigned char* lds;
    volatile LAS unsigned* MISC;
    gu32* ctl;
    int tid, lane, wave;
    int vcu, G;
    unsigned char* ws;
    float* X;
};
__device__ __forceinline__ const float* inptr(const Frame& F, int i) {
    const LAS unsigned* t = (const LAS unsigned*)(F.lds + INTAB_OFF); unsigned lo = t[2 * i], hi = t[2 * i + 1];
    lo = __builtin_amdgcn_readfirstlane(lo); hi = __builtin_amdgcn_readfirstlane(hi);
    return (const float*)(((unsigned long long)hi << 32) | lo);
}
__device__ __forceinline__ float wave_sum(float v) {
#pragma unroll
    for (int o = 1; o < 64; o <<= 1) v += __shfl_xor(v, o);
    return v;
}
__device__ __forceinline__ float wave_max(float v) {
#pragma unroll
    for (int o = 1; o < 64; o <<= 1) v = fmaxf(v, __shfl_xor(v, o));
    return v;
}

namespace pg8 {
__device__ __forceinline__ void load_rstd(const float* ssq, int pm, int wr, int lane, float (&rs)[2][4]) {
    float mine[2];
#pragma unroll
    for (int ai = 0; ai < 2; ++ai) { const f32x4* p = (const f32x4*)(ssq + (size_t)(pm * 256 + ai * 128 + wr * 64 + lane) * 16);
        const f32x4 a = p[0], b = p[1], c = p[2], d = p[3]; const f32x4 s = (a + b) + (c + d);
        mine[ai] = 1.0f / sqrtf(((s[0] + s[1]) + (s[2] + s[3])) * (1.0f / DM) + NORM_EPS); }
#pragma unroll
    for (int ai = 0; ai < 2; ++ai)
#pragma unroll
        for (int m = 0; m < 4; ++m) rs[ai][m] = __shfl(mine[ai], 16 * m + (lane & 15));
}
__device__ __forceinline__ u32x4 pack8(const f32x4& a, const f32x4& b) { u32x4 w; w.x = cvt_pk_bf16(a[0], a[1]); w.y = cvt_pk_bf16(a[2], a[3]); w.z = cvt_pk_bf16(b[0], b[1]); w.w = cvt_pk_bf16(b[2], b[3]); return w; }

struct EpiSwiglu {
    static constexpr bool PERM = true;
    bf16_t* O; const float* ssq;
    __device__ __forceinline__ bool operator()(f32x4 (&acc)[2][2][4][2], const Unit& u, int wr, int wc, int fr, int fq, int lane) const {
        float rs[2][4]; load_rstd(ssq, u.pm, wr, lane, rs);
        const int col0 = u.pn * 128 + wc * 32 + 8 * fq;
#pragma unroll
        for (int ai = 0; ai < 2; ++ai)
#pragma unroll
            for (int m = 0; m < 4; ++m) { const float r = rs[ai][m]; const size_t row = (size_t)(u.pm * BM + ai * HALF + wr * 64 + m * 16 + fr);
                f32x4 o[2];
#pragma unroll
                for (int n = 0; n < 2; ++n) { const f32x4 gg = acc[ai][0][m][n] * r, uu = acc[ai][1][m][n] * r;
#pragma unroll
                    for (int j = 0; j < 4; ++j) o[n][j] = siluf_(gg[j]) * uu[j]; }
                *(u32x4*)(O + row * DFF + col0) = pack8(o[0], o[1]); }
        return false;
    }
};
struct EpiResidual {
    static constexpr bool PERM = true;
    float* X; bf16_t* XB; float* ssq; float scale;
    __device__ __forceinline__ bool operator()(f32x4 (&acc)[2][2][4][2], const Unit& u, int wr, int wc, int fr, int fq, int lane) const {
        const int col0 = u.pn * BM + wc * 32 + 8 * fq;
#pragma unroll
        for (int ai = 0; ai < 2; ++ai)
#pragma unroll
            for (int m = 0; m < 4; ++m) { const size_t row = (size_t)(u.pm * BM + ai * HALF + wr * 64 + m * 16 + fr); float q = 0.f;
#pragma unroll
                for (int bj = 0; bj < 2; ++bj) { float* xp = X + row * DM + col0 + bj * HALF;
                    f32x4 x0 = *(const f32x4*)xp, x1 = *(const f32x4*)(xp + 4);
                    x0 = x0 + acc[ai][bj][m][0] * scale; x1 = x1 + acc[ai][bj][m][1] * scale;
                    *(f32x4*)xp = x0; *(f32x4*)(xp + 4) = x1;
                    q += (x0[0] * x0[0] + x0[1] * x0[1]) + (x0[2] * x0[2] + x0[3] * x0[3]) + (x1[0] * x1[0] + x1[1] * x1[1]) + (x1[2] * x1[2] + x1[3] * x1[3]);
                    *(u32x4*)(XB + row * DM + col0 + bj * HALF) = pack8(x0, x1); }
                q += __shfl_xor(q, 16); q += __shfl_xor(q, 32);
                if (fq == 0) ssq[row * 16 + u.pn * 4 + wc] = q; }
        return false;
    }
};
struct EpiSigmoid {
    static constexpr bool PERM = true;
    bf16_t* O; const float* ssq;
    __device__ __forceinline__ bool operator()(f32x4 (&acc)[2][2][4][2], const Unit& u, int wr, int wc, int fr, int fq, int lane) const {
        float rs[2][4]; load_rstd(ssq, u.pm, wr, lane, rs);
        bf16_t* base = O + (size_t)(u.pn >> 2) * M * DM + (u.pn & 3) * 256 + wc * 32 + 8 * fq;
#pragma unroll
        for (int ai = 0; ai < 2; ++ai)
#pragma unroll
            for (int m = 0; m < 4; ++m) { const float r = rs[ai][m]; const size_t row = (size_t)(u.pm * BM + ai * HALF + wr * 64 + m * 16 + fr);
#pragma unroll
                for (int bj = 0; bj < 2; ++bj) { f32x4 o[2];
#pragma unroll
                    for (int n = 0; n < 2; ++n)
#pragma unroll
                        for (int j = 0; j < 4; ++j) o[n][j] = sigmoidf_(acc[ai][bj][m][n][j] * r);
                    *(u32x4*)(base + row * DM + bj * HALF) = pack8(o[0], o[1]); } }
        return false;
    }
};
struct EpiMerge {
    static constexpr bool PERM = true;
    const bf16_t* GT; bf16_t* O;
    __device__ __forceinline__ bool operator()(f32x4 (&acc)[2][2][4][2], const Unit& u, int wr, int wc, int fr, int fq, int lane) const {
        const int col0 = u.pn * BM + wc * 32 + 8 * fq; const int s = u.seg;
        const bf16_t* g0 = GT + (size_t)s * M * DM; const bf16_t* g1 = GT + (size_t)(s + 1) * M * DM;
#pragma unroll
        for (int ai = 0; ai < 2; ++ai)
#pragma unroll
            for (int m = 0; m < 4; ++m) { const size_t row = (size_t)(u.pm * BM + ai * HALF + wr * 64 + m * 16 + fr);
#pragma unroll
                for (int bj = 0; bj < 2; ++bj) { const size_t off = row * DM + col0 + bj * HALF;
                    const u32x4 a = *(const u32x4*)(g0 + off);
                    float ga[8] = {bflo(a.x), bfhi(a.x), bflo(a.y), bfhi(a.y), bflo(a.z), bfhi(a.z), bflo(a.w), bfhi(a.w)};
                    if (s < 2) { const u32x4 b = *(const u32x4*)(g1 + off);
                        float gb[8] = {bflo(b.x), bfhi(b.x), bflo(b.y), bfhi(b.y), bflo(b.z), bfhi(b.z), bflo(b.w), bfhi(b.w)};
#pragma unroll
                        for (int e = 0; e < 8; ++e) acc[ai][bj][m][e >> 2][e & 3] *= fmaxf(ga[e], 1e-30f) / fmaxf(gb[e], 1e-30f);
                    } else { f32x4 o[2];
#pragma unroll
                        for (int e = 0; e < 8; ++e) o[e >> 2][e & 3] = acc[ai][bj][m][e >> 2][e & 3] * fmaxf(ga[e], 1e-30f);
                        *(u32x4*)(O + off) = pack8(o[0], o[1]); } } }
        return s < 2;
    }
};
struct EpiInProj {
    static constexpr bool PERM = true;
    unsigned char* ws; const float* ssq; const float* cosT; const float* sinT;
    const float* aq_n; const float* ak_n; const float* bq_n; const float* bk_n; const float* gbias;
    __device__ __forceinline__ bool operator()(f32x4 (&acc)[2][2][4][2], const Unit& u, int wr, int wc, int fr, int fq, int lane) const {
        float rs[2][4]; load_rstd(ssq, u.pm, wr, lane, rs);
        const int t = u.pn;
        int mode, pitch, colA, colB; bf16_t* dst; const float* gain = nullptr; float sc = 1.f; bool act = false;
        if (t < 18) { const int w = t / 6, tt = t % 6, g = tt >> 1, hd = ((tt & 1) * 4 + wc) * 64 + 8 * fq;
            dst = (bf16_t*)(ws + (w == 0 ? (g == 0 ? WS_AQ0 : (g == 1 ? WS_AQ1 : WS_AQ2)) : (w == 1 ? WS_AK0 + (size_t)g * 4 * UU : WS_AV0 + (size_t)g * 4 * UU)));
            pitch = 512; colA = hd; colB = hd + 32; mode = (w == 2) ? 1 : 0; gain = (w == 0) ? aq_n : ak_n; sc = (w == 0) ? QSCALE : 1.f; }
        else if (t < 20) { dst = (bf16_t*)(ws + WS_BQ); pitch = 512; colA = ((t - 18) * 4 + wc) * 64 + 8 * fq; colB = colA + 32; mode = 0; gain = bq_n; sc = QSCALE; }
        else if (t == 20) { pitch = 128; colA = (wc & 1) * 64 + 8 * fq; colB = colA + 32;
            if (wc < 2) { dst = (bf16_t*)(ws + WS_BK); mode = 0; gain = bk_n; } else { dst = (bf16_t*)(ws + WS_BV); mode = 1; } }
        else { colA = wc * 32 + 8 * fq; colB = colA + 128; mode = 2;
            if (t == 21) { dst = (bf16_t*)(ws + WS_CQ); pitch = 256; sc = 0.125f; }
            else if (t == 22) { dst = (bf16_t*)(ws + WS_CK); pitch = 256; }
            else if (t < 25) { dst = (bf16_t*)(ws + WS_CV); pitch = 512; colA += (t - 23) * 256; colB += (t - 23) * 256; }
            else if (t == 25) { dst = (bf16_t*)(ws + WS_LOGG); pitch = 256; mode = 3; }
            else { dst = (bf16_t*)(ws + WS_CR); pitch = 512; colA += (t - 26) * 256; colB += (t - 26) * 256; act = true; } }
        if (mode == 0) {
            f32x4 gA[2], gB[2];
#pragma unroll
            for (int n = 0; n < 2; ++n) { gA[n] = *(const f32x4*)(gain + 8 * fq + 4 * n); gB[n] = *(const f32x4*)(gain + 32 + 8 * fq + 4 * n); }
#pragma unroll
            for (int ai = 0; ai < 2; ++ai)
#pragma unroll
                for (int m = 0; m < 4; ++m) { const float r = rs[ai][m]; const size_t row = (size_t)(u.pm * BM + ai * HALF + wr * 64 + m * 16 + fr);
                    f32x4 a[2], b[2]; float ss = 0.f;
#pragma unroll
                    for (int n = 0; n < 2; ++n) { a[n] = acc[ai][0][m][n] * r; b[n] = acc[ai][1][m][n] * r;
                        ss += (a[n][0] * a[n][0] + a[n][1] * a[n][1]) + (a[n][2] * a[n][2] + a[n][3] * a[n][3]) + (b[n][0] * b[n][0] + b[n][1] * b[n][1]) + (b[n][2] * b[n][2] + b[n][3] * b[n][3]); }
                    ss += __shfl_xor(ss, 16); ss += __shfl_xor(ss, 32);
                    const float rn = 1.0f / sqrtf(ss * (1.0f / 64.0f) + NORM_EPS);
                    f32x4 oa[2], ob[2];
#pragma unroll
                    for (int n = 0; n < 2; ++n) { const f32x4 c = *(const f32x4*)(cosT + row * 32 + 8 * fq + 4 * n), s = *(const f32x4*)(sinT + row * 32 + 8 * fq + 4 * n);
                        const f32x4 y1 = a[n] * rn * gA[n], y2 = b[n] * rn * gB[n];
                        oa[n] = (y1 * c - y2 * s) * sc; ob[n] = (y2 * c + y1 * s) * sc; }
                    *(u32x4*)(dst + row * pitch + colA) = pack8(oa[0], oa[1]); *(u32x4*)(dst + row * pitch + colB) = pack8(ob[0], ob[1]); }
        } else if (mode == 3) {
            f32x4 bA[2], bB[2];
#pragma unroll
            for (int n = 0; n < 2; ++n) { bA[n] = *(const f32x4*)(gbias + colA + 4 * n); bB[n] = *(const f32x4*)(gbias + colB + 4 * n); }
#pragma unroll
            for (int ai = 0; ai < 2; ++ai)
#pragma unroll
                for (int m = 0; m < 4; ++m) { const float r = rs[ai][m]; const size_t row = (size_t)(u.pm * BM + ai * HALF + wr * 64 + m * 16 + fr);
#pragma unroll
                    for (int bj = 0; bj < 2; ++bj) { float v[8];
#pragma unroll
                        for (int e = 0; e < 8; ++e) { const float x = acc[ai][bj][m][e >> 2][e & 3] * r + (bj == 0 ? bA[e >> 2][e & 3] : bB[e >> 2][e & 3]);
                            v[e] = (fminf(x, 0.f) - __logf(1.0f + fexp(-fabsf(x)))) * (1.0f / 16.0f); }
                        u32x4 w; { h16x2 p0 = {(_Float16)v[0], (_Float16)v[1]}, p1 = {(_Float16)v[2], (_Float16)v[3]}, p2 = {(_Float16)v[4], (_Float16)v[5]}, p3 = {(_Float16)v[6], (_Float16)v[7]};
                            w.x = __builtin_bit_cast(unsigned, p0); w.y = __builtin_bit_cast(unsigned, p1); w.z = __builtin_bit_cast(unsigned, p2); w.w = __builtin_bit_cast(unsigned, p3); }
                        *(u32x4*)(dst + row * pitch + (bj == 0 ? colA : colB)) = w; } }
        } else {
#pragma unroll
            for (int ai = 0; ai < 2; ++ai)
#pragma unroll
                for (int m = 0; m < 4; ++m) { const float r = rs[ai][m] * sc; const size_t row = (size_t)(u.pm * BM + ai * HALF + wr * 64 + m * 16 + fr);
#pragma unroll
                    for (int bj = 0; bj < 2; ++bj) { f32x4 o[2];
#pragma unroll
                        for (int n = 0; n < 2; ++n) { o[n] = acc[ai][bj][m][n] * r;
                            if (act) {
#pragma unroll
                                for (int j = 0; j < 4; ++j) o[n][j] = siluf_(o[n][j]); } }
                        *(u32x4*)(dst + row * pitch + (bj == 0 ? colA : colB)) = pack8(o[0], o[1]); } }
        }
        return false;
    }
};
}

__constant__ float ROPE_INV[32] = {
    1.000000000e+00f, 7.498942614e-01f, 5.623413324e-01f, 4.216965139e-01f, 3.162277639e-01f, 2.371373773e-01f, 1.778279394e-01f, 1.333521307e-01f,
    1.000000015e-01f, 7.498941571e-02f, 5.623413250e-02f, 4.216965288e-02f, 3.162277490e-02f, 2.371373773e-02f, 1.778279431e-02f, 1.333521493e-02f,
    9.999999776e-03f, 7.498941850e-03f, 5.623413250e-03f, 4.216964822e-03f, 3.162277630e-03f, 2.371373586e-03f, 1.778279431e-03f, 1.333521446e-03f,
    1.000000047e-03f, 7.498942432e-04f, 5.623413017e-04f, 4.216965172e-04f, 3.162277571e-04f, 2.371373703e-04f, 1.778279402e-04f, 1.333521504e-04f};

struct ConvJob { const float* W; int ldw; int K; bf16* WT; int nrows; const float* gain; int mode; int base; const float* gate_up; };
__device__ __forceinline__ int conv_src0(int mode, int base, int n0) {
    if (mode == 0) return base + n0;
    const int t = n0 >> 8, c = n0 & 255;
    if (mode == 1) return c < 128 ? t * 128 + c : DFF + t * 128 + (c - 128);
    const int bj = c >> 7, wc = (c >> 5) & 3;
    if (t < 18) return (t / 6) * 1536 + (4 * (t % 6) + wc) * 64 + 32 * bj;
    if (t < 20) return 4608 + (4 * (t - 18) + wc) * 64 + 32 * bj;
    if (t == 20) return 5120 + wc * 64 + 32 * bj;
    if (t == 21) return 5376 + c;
    if (t == 22) return 5632 + c;
    if (t < 25) return 5888 + 256 * (t - 23) + c;
    if (t == 25) return -1;
    return 6416 + 256 * (t - 26) + c;
}
__device__ __forceinline__ void conv_item(const ConvJob& J, LAS float* scr, int item, int lane) {
    const int nblk = J.nrows / 32, kb = item / nblk, nb = item % nblk, k0 = 64 * kb, n0 = 32 * nb;
    const int src0 = conv_src0(J.mode, J.base, n0);
    if (src0 >= 0) {
#pragma unroll 8
        for (int i = 0; i < 32; ++i) { const int kk = 2 * i + (lane >> 5); float w = J.W[(size_t)(k0 + kk) * J.ldw + src0 + (lane & 31)];
            if (J.gain) w *= J.gain[k0 + kk];
            scr[kk * 33 + (lane & 31)] = w; }
    } else {
        float ug[16];
#pragma unroll
        for (int r = 0; r < 16; ++r) ug[r] = J.gate_up[r * 256 + (n0 & 255) + (lane & 31)];
#pragma unroll 4
        for (int i = 0; i < 32; ++i) { const int kk = 2 * i + (lane >> 5); const float* wrow = J.W + (size_t)(k0 + kk) * J.ldw + 6400; float s = 0.f;
#pragma unroll
            for (int r = 0; r < 16; ++r) s += wrow[r] * ug[r];
            scr[kk * 33 + (lane & 31)] = s * J.gain[k0 + kk]; }
    }
    LDS_WAIT(); asm volatile("" ::: "memory");
    const int c = lane & 7;
#pragma unroll
    for (int j = 0; j < 4; ++j) { const int n = (lane >> 3) + 8 * j; const LAS float* s = scr + (8 * c) * 33 + n;
        v4u o; o.x = pk2(s[0 * 33], s[1 * 33]); o.y = pk2(s[2 * 33], s[3 * 33]); o.z = pk2(s[4 * 33], s[5 * 33]); o.w = pk2(s[6 * 33], s[7 * 33]);
        *(GAS v4u*)(J.WT + (size_t)(n0 + n) * J.K + k0 + 8 * c) = o; }
    LDS_WAIT(); asm volatile("" ::: "memory");
}
__device__ __forceinline__ void conv_job(Frame& F, const ConvJob& J) {
    LAS float* scr = (LAS float*)(F.lds + RING_OFF + F.wave * 16384);
    const int gw = F.vcu * NWAVES + F.wave, NGW = F.G * NWAVES, nitems = (J.nrows / 32) * (J.K / 64);
    for (int it = gw; it < nitems; it += NGW) conv_item(J, scr, it, F.lane);
}
__device__ __forceinline__ void conv_set(Frame& F, int set, int l) {
    if (set == 0 || set == 4) { ConvJob J{inptr(F, set == 0 ? 3 : 18) + (size_t)l * DM * 2 * DFF, 2 * DFF, DM, (bf16*)(F.ws + WS_S1), 2 * DFF, inptr(F, set == 0 ? 2 : 17) + (size_t)l * DM, 1, 0, nullptr}; conv_job(F, J); }
    else if (set == 1 || set == 5) { ConvJob J{inptr(F, set == 1 ? 4 : 19) + (size_t)l * DFF * DM, DM, DFF, (bf16*)(F.ws + WS_S2), DM, nullptr, 0, 0, nullptr}; conv_job(F, J); }
    else if (set == 2) { ConvJob J{inptr(F, 6) + (size_t)l * DM * INW, INW, DM, (bf16*)(F.ws + WS_STATE), 7168, inptr(F, 5) + (size_t)l * DM, 2, 0, inptr(F, 12) + (size_t)l * 16 * 256}; conv_job(F, J); }
    else {
        { ConvJob J{inptr(F, 6) + (size_t)l * DM * INW, INW, DM, (bf16*)(F.ws + WS_WG), 3072, inptr(F, 5) + (size_t)l * DM, 0, 6928, nullptr}; conv_job(F, J); }
        for (int i = 0; i < 3; ++i) { ConvJob J{inptr(F, 15) + ((size_t)l * 3 + i) * 512 * DM, DM, 512, (bf16*)(F.ws + WS_WB) + (size_t)i * DM * 512, DM, nullptr, 0, 0, nullptr}; conv_job(F, J); }
        { ConvJob J{inptr(F, 16) + (size_t)l * DM * DM, DM, DM, (bf16*)(F.ws + WS_WO), DM, nullptr, 0, 0, nullptr}; conv_job(F, J); }
    }
}

__device__ __forceinline__ void p0_rows(Frame& F) {
    const int gw = F.vcu * NWAVES + F.wave, NGW = F.G * NWAVES;
    const float* x = inptr(F, 0); const int* pos = (const int*)inptr(F, 1);
    bf16* XB = (bf16*)(F.ws + WS_XB); float* ssq = (float*)(F.ws + WS_SSQ); float* cosT = (float*)(F.ws + WS_COS); float* sinT = (float*)(F.ws + WS_SIN);
    for (int m = gw; m < M; m += NGW) {
        const GAS f32x4* xr = (const GAS f32x4*)(x + (size_t)m * DM) + F.lane; GAS f32x4* xo = (GAS f32x4*)(F.X + (size_t)m * DM) + F.lane;
        GAS v2u* o8 = (GAS v2u*)(XB + (size_t)m * DM) + F.lane; float s = 0.f;
#pragma unroll
        for (int j = 0; j < 4; ++j) { const f32x4 v = xr[64 * j]; xo[64 * j] = v; s += (v.x * v.x + v.y * v.y) + (v.z * v.z + v.w * v.w);
            v2u w; w.x = pk2(v.x, v.y); w.y = pk2(v.z, v.w); o8[64 * j] = w; }
        s = wave_sum(s);
        if (F.lane < 16) ssq[(size_t)m * 16 + F.lane] = (F.lane == 0) ? s : 0.f;
        if (F.lane < 32) { const float ang = (float)pos[m] * ROPE_INV[F.lane];
            const double rev = (double)ang * 0.15915494309189535; const float fr = (float)(rev - __builtin_rint(rev));
            cosT[(size_t)m * 32 + F.lane] = __builtin_amdgcn_cosf(fr); sinT[(size_t)m * 32 + F.lane] = __builtin_amdgcn_sinf(fr); }
    }
}

__device__ __forceinline__ void load_q64(const bf16* q, float (&qf)[64]) {
#pragma unroll
    for (int i = 0; i < 8; ++i) { const v4u w = *(const v4u*)(q + 8 * i);
        qf[8 * i + 0] = bflo(w.x); qf[8 * i + 1] = bfhi(w.x); qf[8 * i + 2] = bflo(w.y); qf[8 * i + 3] = bfhi(w.y);
        qf[8 * i + 4] = bflo(w.z); qf[8 * i + 5] = bfhi(w.z); qf[8 * i + 6] = bflo(w.w); qf[8 * i + 7] = bfhi(w.w); }
}
__device__ __forceinline__ float dot64(const float (&qf)[64], const bf16* k) {
    float s0 = 0.f, s1 = 0.f;
#pragma unroll
    for (int i = 0; i < 8; ++i) { const v4u w = *(const v4u*)(k + 8 * i);
        s0 += qf[8 * i + 0] * bflo(w.x); s1 += qf[8 * i + 1] * bfhi(w.x); s0 += qf[8 * i + 2] * bflo(w.y); s1 += qf[8 * i + 3] * bfhi(w.y);
        s0 += qf[8 * i + 4] * bflo(w.z); s1 += qf[8 * i + 5] * bfhi(w.z); s0 += qf[8 * i + 6] * bflo(w.w); s1 += qf[8 * i + 7] * bfhi(w.w); }
    return s0 + s1;
}
__device__ __forceinline__ void band_item(const bf16* Q, const bf16* Kb, const bf16* Vb, int pitch, int t, int d, int nk, float sink2, int lane, float& o_out, float& lse2) {
    float qf[64]; load_q64(Q, qf);
    float s0 = -INFINITY, s1 = -INFINITY, s2 = -INFINITY;
    { const int j = lane; if (t - j * d >= 0) s0 = dot64(qf, Kb - (size_t)j * d * pitch); }
    { const int j = lane + 64; if (t - j * d >= 0) s1 = dot64(qf, Kb - (size_t)j * d * pitch); }
    if (nk > 128 && lane == 0 && t - 128 * d >= 0) s2 = dot64(qf, Kb - (size_t)128 * d * pitch);
    float mx = wave_max(fmaxf(fmaxf(s0, s1), s2)); mx = fmaxf(mx, sink2);
    const float p0 = fexp2(s0 - mx), p1 = fexp2(s1 - mx), p2 = fexp2(s2 - mx);
    float l = wave_sum(p0 + p1 + p2) + fexp2(sink2 - mx);
    float o = 0.f;
    for (int j = 0; j < 64; ++j) { if (t - j * d < 0) break; o += __shfl(p0, j) * bf2f(Vb[-(ptrdiff_t)j * d * pitch + lane]); }
    for (int j = 64; j < 128; ++j) { if (t - j * d < 0) break; o += __shfl(p1, j - 64) * bf2f(Vb[-(ptrdiff_t)j * d * pitch + lane]); }
    if (nk > 128 && t - 128 * d >= 0) o += __shfl(p2, 0) * bf2f(Vb[-(ptrdiff_t)128 * d * pitch + lane]);
    o_out = o / l; lse2 = mx + __log2f(l);
}
__device__ __forceinline__ void attn_phase_simple(Frame& F, int l) {
    const int gw = F.vcu * NWAVES + F.wave, NGW = F.G * NWAVES, lane = F.lane;
    const float* sinks = inptr(F, 11) + l * 8;
    for (int it = gw; it < M * 8; it += NGW) {
        const int row = it >> 3, h = it & 7, t = row & (SEQ - 1);
        float y = 0.f, wsum = 0.f, mrun = -INFINITY;
#pragma unroll 1
        for (int g = 0; g < 3; ++g) {
            const int d = (g == 0) ? 1 : (g == 1 ? 4 : 16);
            const bf16* Qb = (const bf16*)(F.ws + (g == 0 ? WS_AQ0 : (g == 1 ? WS_AQ1 : WS_AQ2))) + (size_t)row * 512 + h * 64;
            const bf16* Kb = (const bf16*)(F.ws + WS_AK0 + (size_t)g * 4 * UU) + (size_t)row * 512 + h * 64;
            const bf16* Vb = (const bf16*)(F.ws + WS_AV0 + (size_t)g * 4 * UU) + (size_t)row * 512 + h * 64;
            float o, lse; band_item(Qb, Kb, Vb, 512, t, d, 129, -INFINITY, lane, o, lse);
            const float mn = fmaxf(mrun, lse), fa = fexp2(mrun - mn), fb = fexp2(lse - mn);
            y = y * fa + o * fb; wsum = wsum * fa + fb; mrun = mn;
        }
        ((bf16*)(F.ws + WS_AQ0))[(size_t)row * 512 + h * 64 + lane] = (bf16)f2bf(y / wsum);
    }
    for (int it = gw; it < M * 8; it += NGW) {
        const int row = it >> 3, hq = it & 7, t = row & (SEQ - 1), kv = hq >> 2;
        const bf16* Qb = (const bf16*)(F.ws + WS_BQ) + (size_t)row * 512 + hq * 64;
        const bf16* Kb = (const bf16*)(F.ws + WS_BK) + (size_t)row * 128 + kv * 64;
        const bf16* Vb = (const bf16*)(F.ws + WS_BV) + (size_t)row * 128 + kv * 64;
        float o, lse; band_item(Qb, Kb, Vb, 128, t, 1, 128, sinks[hq] * LOG2E, lane, o, lse);
        ((bf16*)(F.ws + WS_BQ))[(size_t)row * 512 + hq * 64 + lane] = (bf16)f2bf(o);
    }
}

__device__ __forceinline__ void gla1_phase(Frame& F) {
    LAS float* bc = (LAS float*)(F.lds);
    LAS float* kt = (LAS float*)(F.lds + 16384);
    LAS float* vv = (LAS float*)(F.lds + 32768);
    const int tid = F.tid;
    const bf16* CK = (const bf16*)(F.ws + WS_CK); const bf16* CV = (const bf16*)(F.ws + WS_CV); const _Float16* LG = (const _Float16*)(F.ws + WS_LOGG);
    bf16* ST = (bf16*)(F.ws + WS_STATE); float* DC = (float*)(F.ws + WS_DC);
    for (int item = blockIdx.x; item < 8 * 128; item += F.G) {
        const int bh = item >> 7, c = item & 127, b = bh >> 2, h = bh & 3; const size_t row0 = (size_t)b * SEQ + c * 64;
        { const int t = tid >> 3, d0 = (tid & 7) * 8;
            const v4u wl = *(const v4u*)(LG + (row0 + t) * 256 + h * 64 + d0); const v4u wk = *(const v4u*)(CK + (row0 + t) * 256 + h * 64 + d0);
            const unsigned wls[4] = {wl.x, wl.y, wl.z, wl.w}, wks[4] = {wk.x, wk.y, wk.z, wk.w};
#pragma unroll
            for (int i = 0; i < 4; ++i) { const h16x2 hh = __builtin_bit_cast(h16x2, wls[i]); bc[t * 64 + d0 + 2 * i] = (float)hh[0]; bc[t * 64 + d0 + 2 * i + 1] = (float)hh[1];
                kt[t * 64 + d0 + 2 * i] = bflo(wks[i]); kt[t * 64 + d0 + 2 * i + 1] = bfhi(wks[i]); }
            const int e0 = (tid & 7) * 16;
#pragma unroll
            for (int q = 0; q < 2; ++q) { const v4u wv = *(const v4u*)(CV + (row0 + t) * 512 + h * 128 + e0 + 8 * q); const unsigned wvs[4] = {wv.x, wv.y, wv.z, wv.w};
#pragma unroll
                for (int i = 0; i < 4; ++i) { vv[t * 128 + e0 + 8 * q + 2 * i] = bflo(wvs[i]); vv[t * 128 + e0 + 8 * q + 2 * i + 1] = bfhi(wvs[i]); } } }
        __syncthreads();
        if (tid < 64) { float run = 0.f; for (int t = 0; t < 64; ++t) { run += bc[t * 64 + tid]; bc[t * 64 + tid] = run; } DC[(size_t)item * 64 + tid] = fexp(run); }
        __syncthreads();
        for (int i = tid; i < 4096; i += 512) { const int d = i & 63; kt[i] *= fexp(bc[63 * 64 + d] - bc[i]); }
        __syncthreads();
        { const int d = tid >> 3, e0 = (tid & 7) * 16; float a[16];
#pragma unroll
            for (int j = 0; j < 16; ++j) a[j] = 0.f;
            for (int s = 0; s < 64; ++s) { const float kk = kt[s * 64 + d];
#pragma unroll
                for (int j = 0; j < 16; ++j) a[j] += kk * vv[s * 128 + e0 + j]; }
            v4u o0, o1; o0.x = pk2(a[0], a[1]); o0.y = pk2(a[2], a[3]); o0.z = pk2(a[4], a[5]); o0.w = pk2(a[6], a[7]);
            o1.x = pk2(a[8], a[9]); o1.y = pk2(a[10], a[11]); o1.z = pk2(a[12], a[13]); o1.w = pk2(a[14], a[15]);
            bf16* dst = ST + ((size_t)item * 64 + d) * 128 + e0; *(v4u*)dst = o0; *(v4u*)(dst + 8) = o1; }
        __syncthreads();
    }
}
__device__ __forceinline__ void gla2_phase(Frame& F) {
    bf16* ST = (bf16*)(F.ws + WS_STATE); const float* DC = (const float*)(F.ws + WS_DC);
    for (int gt = F.vcu * 512 + F.tid; gt < 8 * 64 * 128; gt += F.G * 512) {
        const int bh = gt >> 13, d = (gt >> 7) & 63, e = gt & 127; float S = 0.f;
        for (int c0 = 0; c0 < 128; c0 += 8) { float u[8], dc[8];
#pragma unroll
            for (int i = 0; i < 8; ++i) { const size_t ci = (size_t)bh * 128 + c0 + i; u[i] = bf2f(ST[(ci * 64 + d) * 128 + e]); dc[i] = DC[ci * 64 + d]; }
#pragma unroll
            for (int i = 0; i < 8; ++i) { const size_t ci = (size_t)bh * 128 + c0 + i; ST[(ci * 64 + d) * 128 + e] = (bf16)f2bf(S); S = dc[i] * S + u[i]; } }
    }
}
__device__ __forceinline__ void gla3_phase(Frame& F, int l) {
    LAS float* bc = (LAS float*)(F.lds);
    LAS float* qt = (LAS float*)(F.lds + 16384);
    LAS float* kt = (LAS float*)(F.lds + 32768);
    LAS float* vv = (LAS float*)(F.lds + 49408);
    LAS float* ss = (LAS float*)(F.lds + 82176);
    LAS float* at = bc;
    const int tid = F.tid;
    const bf16* CQ = (const bf16*)(F.ws + WS_CQ); const bf16* CK = (const bf16*)(F.ws + WS_CK); bf16* CV = (bf16*)(F.ws + WS_CV); const _Float16* LG = (const _Float16*)(F.ws + WS_LOGG);
    const bf16* CR = (const bf16*)(F.ws + WS_CR); const bf16* ST = (const bf16*)(F.ws + WS_STATE); const float* gain = inptr(F, 14) + l * 128;
    for (int item = blockIdx.x; item < 8 * 128; item += F.G) {
        const int bh = item >> 7, c = item & 127, b = bh >> 2, h = bh & 3; const size_t row0 = (size_t)b * SEQ + c * 64;
        { const int t = tid >> 3, d0 = (tid & 7) * 8;
            const v4u wl = *(const v4u*)(LG + (row0 + t) * 256 + h * 64 + d0); const v4u wk = *(const v4u*)(CK + (row0 + t) * 256 + h * 64 + d0); const v4u wq = *(const v4u*)(CQ + (row0 + t) * 256 + h * 64 + d0);
            const unsigned wls[4] = {wl.x, wl.y, wl.z, wl.w}, wks[4] = {wk.x, wk.y, wk.z, wk.w}, wqs[4] = {wq.x, wq.y, wq.z, wq.w};
#pragma unroll
            for (int i = 0; i < 4; ++i) { const h16x2 hh = __builtin_bit_cast(h16x2, wls[i]); bc[t * 64 + d0 + 2 * i] = (float)hh[0]; bc[t * 64 + d0 + 2 * i + 1] = (float)hh[1];
                kt[t * 65 + d0 + 2 * i] = bflo(wks[i]); kt[t * 65 + d0 + 2 * i + 1] = bfhi(wks[i]);
                qt[t * 64 + d0 + 2 * i] = bflo(wqs[i]); qt[t * 64 + d0 + 2 * i + 1] = bfhi(wqs[i]); }
            const int e0 = (tid & 7) * 16;
#pragma unroll
            for (int q = 0; q < 2; ++q) { const v4u wv = *(const v4u*)(CV + (row0 + t) * 512 + h * 128 + e0 + 8 * q); const unsigned wvs[4] = {wv.x, wv.y, wv.z, wv.w};
                const v4u wsv = *(const v4u*)(ST + ((size_t)item * 64 + t) * 128 + e0 + 8 * q); const unsigned wss[4] = {wsv.x, wsv.y, wsv.z, wsv.w};
#pragma unroll
                for (int i = 0; i < 4; ++i) { vv[t * 128 + e0 + 8 * q + 2 * i] = bflo(wvs[i]); vv[t * 128 + e0 + 8 * q + 2 * i + 1] = bfhi(wvs[i]);
                    ss[t * 128 + e0 + 8 * q + 2 * i] = bflo(wss[i]); ss[t * 128 + e0 + 8 * q + 2 * i + 1] = bfhi(wss[i]); } } }
        __syncthreads();
        if (tid < 64) { float run = 0.f; for (int t = 0; t < 64; ++t) { run += bc[t * 64 + tid]; bc[t * 64 + tid] = run; } }
        __syncthreads();
        for (int i = tid; i < 4096; i += 512) { const float bb = bc[i]; qt[i] *= fexp(bb); kt[(i >> 6) * 65 + (i & 63)] *= fexp(-bb); }
        __syncthreads();
        { const int t = tid >> 3, s0 = (tid & 7) * 8; float a[8];
#pragma unroll
            for (int j = 0; j < 8; ++j) a[j] = 0.f;
            for (int d = 0; d < 64; ++d) { const float qq = qt[t * 64 + d];
#pragma unroll
                for (int j = 0; j < 8; ++j) a[j] += qq * kt[(s0 + j) * 65 + d]; }
#pragma unroll
            for (int j = 0; j < 8; ++j) at[t * 64 + s0 + j] = (s0 + j <= t) ? a[j] : 0.f; }
        __syncthreads();
        { const int t = tid >> 3, e0 = (tid & 7) * 16; float a[16];
#pragma unroll
            for (int j = 0; j < 16; ++j) a[j] = 0.f;
            for (int d = 0; d < 64; ++d) { const float qq = qt[t * 64 + d];
#pragma unroll
                for (int j = 0; j < 16; ++j) a[j] += qq * ss[d * 128 + e0 + j]; }
            for (int s = 0; s <= t; ++s) { const float aa = at[t * 64 + s];
#pragma unroll
                for (int j = 0; j < 16; ++j) a[j] += aa * vv[s * 128 + e0 + j]; }
            float q2 = 0.f;
#pragma unroll
            for (int j = 0; j < 16; ++j) q2 += a[j] * a[j];
            q2 += __shfl_xor(q2, 1); q2 += __shfl_xor(q2, 2); q2 += __shfl_xor(q2, 4);
            const float rn = 1.0f / sqrtf(q2 * (1.0f / 128.0f) + NORM_EPS);
            const bf16* cr = CR + (row0 + t) * 512 + h * 128 + e0; const v4u c0 = *(const v4u*)cr, c1 = *(const v4u*)(cr + 8);
            const float cf[16] = {bflo(c0.x), bfhi(c0.x), bflo(c0.y), bfhi(c0.y), bflo(c0.z), bfhi(c0.z), bflo(c0.w), bfhi(c0.w), bflo(c1.x), bfhi(c1.x), bflo(c1.y), bfhi(c1.y), bflo(c1.z), bfhi(c1.z), bflo(c1.w), bfhi(c1.w)};
#pragma unroll
            for (int j = 0; j < 16; ++j) a[j] = a[j] * rn * gain[e0 + j] * cf[j];
            v4u o0, o1; o0.x = pk2(a[0], a[1]); o0.y = pk2(a[2], a[3]); o0.z = pk2(a[4], a[5]); o0.w = pk2(a[6], a[7]);
            o1.x = pk2(a[8], a[9]); o1.y = pk2(a[10], a[11]); o1.z = pk2(a[12], a[13]); o1.w = pk2(a[14], a[15]);
            bf16* dst = CV + (row0 + t) * 512 + h * 128 + e0; *(v4u*)dst = o0; *(v4u*)(dst + 8) = o1; }
        __syncthreads();
    }
}

template <class T> __device__ __forceinline__ T* launder(T* p) {
    unsigned long long v = (unsigned long long)p; unsigned lo = (unsigned)v, hi = (unsigned)(v >> 32);
    asm volatile("" : "+s"(lo), "+s"(hi));
    return (T*)(((unsigned long long)hi << 32) | lo);
}
constexpr int PH_PER_LAYER = 11, N_PHASES = 1 + NLAYER * PH_PER_LAYER;
struct Args { const void* in[20]; float* out; unsigned char* ws; int ph_lo, ph_hi, li, pad; };
__global__ void __launch_bounds__(NWAVES * 64, 2) mk_fwd(Args args) {
    extern __shared__ __attribute__((aligned(16))) unsigned char lds[];
    Frame F;
    F.lds = (LAS unsigned char*)lds;
    F.MISC = (volatile LAS unsigned*)(F.lds + MISC_OFF);
    F.tid = threadIdx.x; F.lane = F.tid & 63; F.wave = __builtin_amdgcn_readfirstlane(F.tid >> 6);
    F.G = gridDim.x; { const int bx = blockIdx.x; F.vcu = (F.G % 8 == 0) ? (bx % 8) * (F.G / 8) + bx / 8 : bx; }
    F.ws = args.ws; F.X = args.out;
    F.ctl = (gu32*)(args.ws + WS_CTL);
    for (int u = F.tid; u < (LDS_BYTES - LDSCTL_OFF) / 4; u += NWAVES * 64) ((LAS unsigned*)(F.lds + LDSCTL_OFF))[u] = 0u;
    __syncthreads();
    if (F.tid == 0) {
#pragma unroll
        for (int i = 0; i < 20; ++i) ((LAS unsigned long long*)(F.lds + INTAB_OFF))[i] = (unsigned long long)args.in[i];
    }
    __syncthreads();
    XcdBarrier bar; bar.bar = (unsigned*)(F.ctl + CW_BAR); bar.x = 0; bar.st = nullptr;
    if (!MK_PER_PHASE) bar = xcd_barrier_post((unsigned*)(F.ctl + CW_BAR), F.MISC + 8);
    for (int ph = args.ph_lo; ph < args.ph_hi; ++ph) {
        { int t_ = threadIdx.x; asm volatile("" : "+v"(t_)); t_ &= 511; F.tid = t_; F.lane = t_ & 63; F.wave = __builtin_amdgcn_readfirstlane(t_ >> 6); }
        F.ws = launder(args.ws); F.X = launder(args.out);
        const float* ssq = (const float*)(F.ws + WS_SSQ);
        pg8::bf16_t* XB = (pg8::bf16_t*)(F.ws + WS_XB);
        if (ph == 0) {
            p0_rows(F); conv_set(F, 0, 0); conv_set(F, 1, 0); conv_set(F, 2, 0); conv_set(F, 3, 0);
        } else {
            const int l = (ph - 1) / PH_PER_LAYER, k = (ph - 1) % PH_PER_LAYER;
            if (k == 0 || k == 9) {
                if (k == 0 && l > 0) { conv_set(F, 1, l); __syncthreads(); }
                if (k == 9 && l + 1 < NLAYER) { conv_set(F, 3, l + 1); conv_set(F, 2, l + 1); __syncthreads(); }
                pg8::Gemm g{XB, XB, XB, (const pg8::bf16_t*)(F.ws + WS_S1), nullptr, nullptr, M, 2 * DFF, DM};
                pg8::StaticOrder S; S.init(M, 2 * DFF, F.G, (int)blockIdx.x);
                pg8::EpiSwiglu E{(pg8::bf16_t*)(F.ws + WS_ACTH), ssq};
                pg8::gemm_phase<pg8::EpiSwiglu, pg8::StaticOrder, true>(F.lds + RING_OFF, g, S, E);
            } else if (k == 1 || k == 10) {
                if (k == 10 && l + 1 < NLAYER) { conv_set(F, 0, l + 1); __syncthreads(); }
                const pg8::bf16_t* A = (const pg8::bf16_t*)(F.ws + WS_ACTH);
                pg8::Gemm g{A, A, A, (const pg8::bf16_t*)(F.ws + WS_S2), nullptr, nullptr, M, DM, DFF};
                pg8::StaticOrder S; S.init(M, DM, F.G, (int)blockIdx.x);
                pg8::EpiResidual E{F.X, XB, (float*)(F.ws + WS_SSQ), 0.5f};
                pg8::gemm_phase<pg8::EpiResidual, pg8::StaticOrder, false>(F.lds + RING_OFF, g, S, E);
            } else if (k == 2) {
                conv_set(F, 4, l); conv_set(F, 5, l); __syncthreads();
                pg8::Gemm g{XB, XB, XB, (const pg8::bf16_t*)(F.ws + WS_STATE), nullptr, nullptr, M, 7168, DM};
                pg8::StaticOrder S; S.init(M, 7168, F.G, (int)blockIdx.x);
                pg8::EpiInProj E{F.ws, ssq, (const float*)(F.ws + WS_COS), (const float*)(F.ws + WS_SIN), inptr(F, 7) + l * 64, inptr(F, 8) + l * 64, inptr(F, 9) + l * 64, inptr(F, 10) + l * 64, inptr(F, 13) + l * 256};
                pg8::gemm_phase<pg8::EpiInProj, pg8::StaticOrder, true>(F.lds + RING_OFF, g, S, E);
            } else if (k == 3) {
                gla1_phase(F); attn_phase_simple(F, l);
            } else if (k == 4) { gla2_phase(F);
            } else if (k == 5) { gla3_phase(F, l);
            } else if (k == 6) {
                pg8::Gemm g{XB, XB, XB, (const pg8::bf16_t*)(F.ws + WS_WG), nullptr, nullptr, M, 3 * DM, DM};
                pg8::StaticOrder S; S.init(M, 3 * DM, F.G, (int)blockIdx.x);
                pg8::EpiSigmoid E{(pg8::bf16_t*)(F.ws + WS_GATES), ssq};
                pg8::gemm_phase<pg8::EpiSigmoid, pg8::StaticOrder, true>(F.lds + RING_OFF, g, S, E);
            } else if (k == 7) {
                const pg8::bf16_t* WB = (const pg8::bf16_t*)(F.ws + WS_WB);
                pg8::Gemm g{(const pg8::bf16_t*)(F.ws + WS_AQ0), (const pg8::bf16_t*)(F.ws + WS_BQ), (const pg8::bf16_t*)(F.ws + WS_CV), WB, WB + (size_t)DM * 512, WB + (size_t)2 * DM * 512, M, DM, 512};
                pg8::Seg3Order S; S.b.init(M, DM, F.G, (int)blockIdx.x);
                pg8::EpiMerge E{(const pg8::bf16_t*)(F.ws + WS_GATES), (pg8::bf16_t*)(F.ws + WS_MERGED)};
                pg8::gemm_phase<pg8::EpiMerge, pg8::Seg3Order, false>(F.lds + RING_OFF, g, S, E);
            } else {
                const pg8::bf16_t* A = (const pg8::bf16_t*)(F.ws + WS_MERGED);
                pg8::Gemm g{A, A, A, (const pg8::bf16_t*)(F.ws + WS_WO), nullptr, nullptr, M, DM, DM};
                pg8::StaticOrder S; S.init(M, DM, F.G, (int)blockIdx.x);
                pg8::EpiResidual E{F.X, XB, (float*)(F.ws + WS_SSQ), 1.0f};
                pg8::gemm_phase<pg8::EpiResidual, pg8::StaticOrder, false>(F.lds + RING_OFF, g, S, E);
            }
        }
        if (ph + 1 < args.ph_hi) xcd_barrier(bar);
    }
}

extern "C" void kernel_launch(void* const* d_in, const int* in_sizes, int n_in, void* d_out, int out_size, void* d_ws, size_t ws_size, hipStream_t stream) {
    static int grid = 0;
    if (grid == 0) {
        if (n_in != 20 || out_size != M * DM || ws_size < WS_END) { fprintf(stderr, "kernel_launch: unexpected problem (n_in %d, out %d, ws %zu < %zu); nothing launched\n", n_in, out_size, ws_size, (size_t)WS_END); grid = -1; return; }
        int dev = 0, cus = 0, per_cu = 0;
        if (hipGetDevice(&dev) != hipSuccess || hipDeviceGetAttribute(&cus, hipDeviceAttributeMultiprocessorCount, dev) != hipSuccess) { grid = -1; return; }
        if (hipFuncSetAttribute((const void*)mk_fwd, hipFuncAttributeMaxDynamicSharedMemorySize, LDS_BYTES) != hipSuccess) { fprintf(stderr, "kernel_launch: hipFuncSetAttribute failed\n"); grid = -1; return; }
        if (hipOccupancyMaxActiveBlocksPerMultiprocessor(&per_cu, (const void*)mk_fwd, NWAVES * 64, LDS_BYTES) != hipSuccess || per_cu < 1)
            fprintf(stderr, "kernel_launch: note: occupancy query reports %d workgroups per CU\n", per_cu);
        (void)hipGetLastError();
        grid = cus;
    }
    if (grid < 0) return;
    if (hipMemsetAsync((char*)d_ws + WS_CTL, 0, CTL_ZERO_BYTES, stream) != hipSuccess) return;
    Args a{};
    for (int i = 0; i < 20; ++i) a.in[i] = d_in[i];
    a.out = (float*)d_out; a.ws = (unsigned char*)d_ws;
#if MK_PER_PHASE
    for (int p = 0; p < N_PHASES; ++p) { a.ph_lo = p; a.ph_hi = p + 1; a.li = p; hipLaunchKernelGGL(mk_fwd, dim3(grid), dim3(NWAVES * 64), LDS_BYTES, stream, a); }
#else
    a.ph_lo = 0; a.ph_hi = N_PHASES; a.li = 0;
    hipLaunchKernelGGL(mk_fwd, dim3(grid), dim3(NWAVES * 64), LDS_BYTES, stream, a);
#endif
}
```

```cpp
#include <hip/hip_runtime.h>
#include <cstdio>
#include <cstdint>

#ifndef MK_PER_PHASE
#define MK_PER_PHASE 0
#endif

namespace pg8 {
#define PG8_LAS __attribute__((address_space(3)))
typedef unsigned short bf16_t;
typedef short bf16x8 __attribute__((ext_vector_type(8)));
typedef float f32x4 __attribute__((ext_vector_type(4)));
typedef unsigned u32x4 __attribute__((ext_vector_type(4)));
constexpr int BM = 256, BK = 64, HALF = 128, HTB = HALF * BK * 2  , STAGE_BYTES = 8 * HTB, NXCD = 8, WGM = 8;

__host__ __device__ __forceinline__ int lds_byte(int r, int c) { const int st = (r >> 4) * 2 + (c >> 5), rr = r & 15, cc = c & 31, ob = rr * 64 + cc * 2; return st * 1024 + (ob ^ (((ob >> 9) & 1) << 5)); }
__host__ __device__ __forceinline__ void stage_rc(int b, int& R, int& C) { const int st = b / 1024, sb = b % 1024, swz = sb ^ (((sb >> 9) & 1) << 5); R = (st >> 1) * 16 + swz / 64; C = (st & 1) * 32 + (swz % 64) / 2; }
__host__ __device__ __forceinline__ int perm32(int rho) { const int n = rho >> 4, i = rho & 15; return 8 * (i >> 2) + 4 * n + (i & 3); }

struct Unit { int pm, pn, seg; };
struct Gemm { const bf16_t* A0; const bf16_t* A1; const bf16_t* A2; const bf16_t* B0; const bf16_t* B1; const bf16_t* B2; int M, N, K; };

struct StaticOrder {
    int nM, nN, nwg, G, c;
    __host__ __device__ void init(int M, int N, int G_, int c_) { nM = M / BM; nN = N / BM; nwg = nM * nN; G = G_; c = c_; }
    __host__ __device__ bool next(int i, Unit& u) const {
        const long L = (long)i * G + c; if (L >= nwg) return false;
        int wgid = (int)L; { const int q = nwg / NXCD, r = nwg % NXCD, xcd = wgid % NXCD, off = wgid / NXCD; wgid = (xcd < r ? xcd * (q + 1) : r * (q + 1) + (xcd - r) * q) + off; }
        const int nig = WGM * nN, gid = wgid / nig, fm = gid * WGM, gsz = (nM - fm) < WGM ? (nM - fm) : WGM;
        u.pm = fm + ((wgid % nig) % gsz); u.pn = (wgid % nig) / gsz; u.seg = 0; return true;
    }
};
struct Seg3Order {
    StaticOrder b;
    __host__ __device__ bool next(int i, Unit& u) const { if (!b.next(i / 3, u)) return false; u.seg = i % 3; return true; }
};

typedef float f32x2_t __attribute__((ext_vector_type(2))); typedef __bf16 bf16x2_t __attribute__((ext_vector_type(2)));
__device__ __forceinline__ unsigned cvt_pk_bf16(float lo, float hi) { f32x2_t v = {lo, hi}; bf16x2_t b = __builtin_convertvector(v, bf16x2_t); return __builtin_bit_cast(unsigned, b); }

template <class Epi, class Sched, bool ALIGN_EPI = false>
__device__ __forceinline__ void gemm_phase(PG8_LAS unsigned char* lds, const Gemm g, const Sched& S, const Epi& E) {
    int tid_ = threadIdx.x; asm volatile("" : "+v"(tid_));
    const int tid = tid_ & 511, wid = __builtin_amdgcn_readfirstlane(tid >> 6), lane = tid & 63, wr = wid >> 2, wc = wid & 3, fr = lane & 15, fq = lane >> 4;
    const int K = g.K, nt = K / BK;
    unsigned voffA[2], voffB[2];
#pragma unroll
    for (int i = 0; i < 2; ++i) { int R, C; stage_rc(tid * 16 + i * 8192, R, C); const int Rb = Epi::PERM ? ((R & ~31) + perm32(R & 31)) : R;
        voffA[i] = (unsigned)(R * K + C) * 2u; voffB[i] = (unsigned)(Rb * K + C) * 2u; }
    const size_t kstep = (size_t)(BK * 2);
    const size_t hstep = (size_t)HALF * K * 2;
    const size_t tstep = 2 * hstep;
    const unsigned ldsw = (unsigned)wid * 1024u;
    const int aoff = lds_byte(wr * 64 + fr, fq * 8), boff = lds_byte(wc * 32 + fr, fq * 8);
#define PG8_SA(b, h) (((b) * 2 + (h)) * HTB)
#define PG8_SB(b, h) ((4 + (b) * 2 + (h)) * HTB)
#define PG8_STAGE(bufoff, gbase, voff) do { _Pragma("unroll") for (int _i = 0; _i < 2; ++_i) \
        __builtin_amdgcn_global_load_lds((const unsigned*)((const char*)(gbase) + (voff)[_i]), (PG8_LAS unsigned*)(lds + (bufoff) + ldsw + _i * 8192), 16, 0, 0); } while (0)
#define PG8_LDA(dst, b, h) do { _Pragma("unroll") for (int m = 0; m < 4; ++m) _Pragma("unroll") for (int k = 0; k < 2; ++k) dst[m][k] = *(const PG8_LAS bf16x8*)(lds + PG8_SA(b, h) + aoff + m * 2048 + k * 1024); } while (0)
#define PG8_LDB(dst, b, h) do { _Pragma("unroll") for (int n = 0; n < 2; ++n) _Pragma("unroll") for (int k = 0; k < 2; ++k) dst[n][k] = *(const PG8_LAS bf16x8*)(lds + PG8_SB(b, h) + boff + n * 2048 + k * 1024); } while (0)
#define PG8_MMA(ai, bj, At, Bt) do { __builtin_amdgcn_s_setprio(1); _Pragma("unroll") for (int m = 0; m < 4; ++m) _Pragma("unroll") for (int n = 0; n < 2; ++n) _Pragma("unroll") for (int k = 0; k < 2; ++k) \
        acc[ai][bj][m][n] = __builtin_amdgcn_mfma_f32_16x16x32_bf16(Bt[n][k], At[m][k], acc[ai][bj][m][n], 0, 0, 0); __builtin_amdgcn_s_setprio(0); } while (0)
#define PG8_WAIT_V(n) asm volatile("s_waitcnt vmcnt(" #n ")" ::: "memory")
#define PG8_WAIT_L(n) asm volatile("s_waitcnt lgkmcnt(" #n ")" ::: "memory")
#define PG8_BAR __builtin_amdgcn_s_barrier()
#define PG8_SCHED __builtin_amdgcn_sched_barrier(0)
#define PG8_ASEL(u) ((u).seg == 0 ? g.A0 : ((u).seg == 1 ? g.A1 : g.A2))
#define PG8_BSEL(u) ((u).seg == 0 ? g.B0 : ((u).seg == 1 ? g.B1 : g.B2))
    Unit cur, nxt; int ui = 0;
    if (!S.next(0, cur)) return;
    f32x4 acc[2][2][4][2];
#pragma unroll
    for (int a = 0; a < 2; ++a)
#pragma unroll
        for (int b = 0; b < 2; ++b)
#pragma unroll
            for (int m = 0; m < 4; ++m)
#pragma unroll
                for (int n = 0; n < 2; ++n) acc[a][b][m][n] = (f32x4){0.f, 0.f, 0.f, 0.f};
    bf16x8 At[4][2], B0[2][2], B1[2][2];
    const char* cA = (const char*)PG8_ASEL(cur) + (size_t)cur.pm * tstep; const char* cB = (const char*)PG8_BSEL(cur) + (size_t)cur.pn * tstep;
    PG8_STAGE(PG8_SB(0, 0), cB, voffB); PG8_STAGE(PG8_SB(0, 1), cB + hstep, voffB); PG8_STAGE(PG8_SA(0, 0), cA, voffA); PG8_STAGE(PG8_SA(0, 1), cA + hstep, voffA);
    if (wr == 1) PG8_BAR;
    PG8_WAIT_V(2); PG8_BAR;
    PG8_STAGE(PG8_SB(1, 0), cB + kstep, voffB); PG8_STAGE(PG8_SA(1, 0), cA + kstep, voffA); PG8_STAGE(PG8_SB(1, 1), cB + hstep + kstep, voffB);
    PG8_WAIT_V(6); PG8_BAR;
    for (;;) {
        const bool has_next = S.next(ui + 1, nxt);
        const char* nA = has_next ? (const char*)PG8_ASEL(nxt) + (size_t)nxt.pm * tstep : cA; const char* nB = has_next ? (const char*)PG8_BSEL(nxt) + (size_t)nxt.pn * tstep : cB;
        for (int t = 0; t < nt; t += 2) {
            const bool last = (t == nt - 2);
            const char* a1 = cA + (size_t)(t + 1) * kstep;
            const char* a2 = last ? nA : cA + (size_t)(t + 2) * kstep; const char* b2 = last ? nB : cB + (size_t)(t + 2) * kstep;
            const char* a3 = a2 + kstep; const char* b3 = b2 + kstep;
            PG8_LDB(B0, 0, 0); PG8_LDB(B1, 0, 1); PG8_SCHED; PG8_LDA(At, 0, 0); PG8_STAGE(PG8_SA(1, 1), a1 + hstep, voffA);
            PG8_WAIT_V(8); PG8_WAIT_L(0); PG8_BAR; PG8_MMA(0, 0, At, B0); PG8_MMA(0, 1, At, B1); PG8_BAR; PG8_SCHED;
            PG8_LDA(At, 0, 1); PG8_STAGE(PG8_SB(0, 0), b2, voffB); PG8_STAGE(PG8_SB(0, 1), b2 + hstep, voffB); PG8_STAGE(PG8_SA(0, 0), a2, voffA);
            PG8_WAIT_V(8); PG8_WAIT_L(0); PG8_BAR; PG8_MMA(1, 0, At, B0); PG8_MMA(1, 1, At, B1); PG8_BAR; PG8_SCHED;
            PG8_LDB(B0, 1, 0); PG8_LDB(B1, 1, 1); PG8_SCHED; PG8_LDA(At, 1, 0); PG8_STAGE(PG8_SA(0, 1), a2 + hstep, voffA);
            PG8_WAIT_V(8); PG8_WAIT_L(0); PG8_BAR; PG8_MMA(0, 0, At, B0); PG8_MMA(0, 1, At, B1); PG8_BAR; PG8_SCHED;
            PG8_LDA(At, 1, 1); PG8_STAGE(PG8_SB(1, 0), b3, voffB); PG8_STAGE(PG8_SB(1, 1), b3 + hstep, voffB); PG8_STAGE(PG8_SA(1, 0), a3, voffA);
            PG8_WAIT_V(8); PG8_WAIT_L(0); PG8_BAR; PG8_MMA(1, 0, At, B0); PG8_MMA(1, 1, At, B1); PG8_BAR; PG8_SCHED;
        }
        if constexpr (ALIGN_EPI) { if (wr == 0) PG8_BAR; }
        const bool keep = E(acc, cur, wr, wc, fr, fq, lane);
        if (!has_next) break;
        if (!keep) {
#pragma unroll
        for (int a = 0; a < 2; ++a)
#pragma unroll
            for (int b = 0; b < 2; ++b)
#pragma unroll
                for (int m = 0; m < 4; ++m)
#pragma unroll
                    for (int n = 0; n < 2; ++n) acc[a][b][m][n] = (f32x4){0.f, 0.f, 0.f, 0.f};
        }
        cur = nxt; cA = nA; cB = nB; ++ui;
        if constexpr (ALIGN_EPI) { if (wr == 1) PG8_BAR; }
    }
    PG8_WAIT_V(0);
    if constexpr (!ALIGN_EPI) { if (wr == 0) PG8_BAR; }
    PG8_BAR;
#undef PG8_SA
#undef PG8_SB
#undef PG8_STAGE
#undef PG8_LDA
#undef PG8_LDB
#undef PG8_MMA
#undef PG8_WAIT_V
#undef PG8_WAIT_L
#undef PG8_BAR
#undef PG8_SCHED
#undef PG8_ASEL
#undef PG8_BSEL
}
}

constexpr int NWAVES = 8;
constexpr int BATCH = 2, SEQ = 8192, DM = 1024, M = BATCH * SEQ, DFF = 2816, NLAYER = 2, INW = 10000;
constexpr float NORM_EPS = 1e-6f;
constexpr float LOG2E = 1.4426950408889634f;
constexpr float QSCALE = 0.125f * LOG2E;

constexpr size_t MiB = 1u << 20;
constexpr size_t WS_CTL = 0, CTL_ZERO_BYTES = 1 * MiB;
constexpr size_t WS_SSQ = 1 * MiB;
constexpr size_t WS_COS = 2 * MiB, WS_SIN = 4 * MiB;
constexpr size_t WS_S1 = 6 * MiB;
constexpr size_t WS_S2 = 17 * MiB;
constexpr size_t WS_DC = 22 * MiB + 512 * 1024;
constexpr size_t WS_WG = 23 * MiB;
constexpr size_t WS_WB = 29 * MiB;
constexpr size_t WS_WO = 32 * MiB;
constexpr size_t WS_ACT = 34 * MiB;
constexpr size_t UU = 4 * MiB;
constexpr size_t WS_AQ0 = WS_ACT + 0 * UU, WS_AQ1 = WS_ACT + 4 * UU, WS_AQ2 = WS_ACT + 8 * UU;
constexpr size_t WS_AK0 = WS_ACT + 12 * UU, WS_AV0 = WS_ACT + 24 * UU;
constexpr size_t WS_GATES = WS_ACT + 12 * UU;
constexpr size_t WS_MERGED = WS_ACT + 50 * UU;
constexpr size_t WS_BQ = WS_ACT + 36 * UU, WS_BK = WS_ACT + 40 * UU, WS_BV = WS_ACT + 41 * UU;
constexpr size_t WS_CQ = WS_ACT + 42 * UU, WS_CK = WS_ACT + 44 * UU, WS_CV = WS_ACT + 46 * UU;
constexpr size_t WS_LOGG = WS_ACT + 50 * UU;
constexpr size_t WS_CR = WS_ACT + 52 * UU;
constexpr size_t WS_STATE = WS_ACT + 56 * UU;
constexpr size_t WS_XB = WS_ACT + 60 * UU;
constexpr size_t WS_ACTH = WS_ACT;
constexpr size_t WS_LSE = WS_ACT + 68 * UU;
constexpr size_t WS_END = WS_LSE + 3 * (size_t)M * 8 * 4;
static_assert(WS_S1 + (size_t)2 * DFF * DM * 2 <= WS_S2 && WS_S2 + (size_t)DM * DFF * 2 <= WS_DC && WS_DC + 8 * 128 * 64 * 4 <= WS_WG, "ws map");
static_assert((size_t)M * DFF * 2 <= 22 * UU && (size_t)7168 * 1024 * 2 <= 4 * UU, "ws map 2");
constexpr int CW_TMO = 0, CW_CODE = 1;
constexpr int CW_BAR = 4096;

constexpr int RING_OFF = 0, RING_BYTES = 131072;
constexpr int LDSCTL_OFF = RING_BYTES, MISC_OFF = LDSCTL_OFF + 320;
constexpr int LDS_BYTES = 147456;
constexpr int INTAB_OFF = MISC_OFF + 256;

#define GAS __attribute__((address_space(1)))
#define LAS __attribute__((address_space(3)))
typedef unsigned short bf16;
typedef unsigned v4u __attribute__((ext_vector_type(4)));
typedef unsigned v2u __attribute__((ext_vector_type(2)));
typedef float f32x4 __attribute__((ext_vector_type(4)));
typedef short bf16x8 __attribute__((ext_vector_type(8)));
typedef _Float16 h16x2 __attribute__((ext_vector_type(2)));
typedef GAS unsigned gu32;
#define RLX_AGENT __ATOMIC_RELAXED, __HIP_MEMORY_SCOPE_AGENT
#define LDS_WAIT() asm volatile("s_waitcnt lgkmcnt(0)" ::: "memory")
#define VM_WAIT() asm volatile("s_waitcnt vmcnt(0)" ::: "memory")
__device__ __forceinline__ unsigned f2bf(float f) { unsigned u = __builtin_bit_cast(unsigned, f); return (u + 0x7fffu + ((u >> 16) & 1u)) >> 16; }
__device__ __forceinline__ unsigned pk2(float lo, float hi) { return f2bf(lo) | (f2bf(hi) << 16); }
__device__ __forceinline__ float bflo(unsigned w) { return __builtin_bit_cast(float, w << 16); }
__device__ __forceinline__ float bfhi(unsigned w) { return __builtin_bit_cast(float, w & 0xffff0000u); }
__device__ __forceinline__ float bf2f(bf16 h) { return __builtin_bit_cast(float, (unsigned)h << 16); }
__device__ __forceinline__ float fexp2(float x) { return __builtin_amdgcn_exp2f(x); }
__device__ __forceinline__ float fexp(float x) { return __builtin_amdgcn_exp2f(x * LOG2E); }
__device__ __forceinline__ float frcp(float x) { return __builtin_amdgcn_rcpf(x); }
__device__ __forceinline__ float sigmoidf_(float x) { return frcp(1.0f + fexp(-x)); }
__device__ __forceinline__ float siluf_(float x) { return x * sigmoidf_(x); }

#define XB_TMO      128
#define XB_XCNT(j)  (256  + 64 * (j))
#define XB_XSUB(j)  (1280 + 64 * (j))
#define XB_XGEN(j)  (2304 + 64 * (j))
#define XB_TOP      3328
#define XB_TOPGEN   3392
#define XCD_BAR_WORDS 3456
#define XB_SPIN_CAP (1u << 18)
__device__ __forceinline__ unsigned xb_ld(unsigned* p)              { return __hip_atomic_load(p, __ATOMIC_RELAXED, __HIP_MEMORY_SCOPE_AGENT); }
__device__ __forceinline__ unsigned xb_add(unsigned* p, unsigned v) { return __hip_atomic_fetch_add(p, v, __ATOMIC_RELAXED, __HIP_MEMORY_SCOPE_AGENT); }
__device__ __forceinline__ unsigned xb_xcc_id() { return (unsigned)__builtin_amdgcn_s_getreg((3 << 11) | 20) & 0xFu; }
#define XB_SPIN(cond, bar) do { unsigned _sp = 0; while (cond) { __builtin_amdgcn_s_sleep(1); \
    if ((++_sp & 255u) == 0u) { if (xb_ld(&(bar)[XB_TMO])) break; if (_sp > XB_SPIN_CAP) { atomicAdd(&(bar)[XB_TMO], 1u); break; } } } } while (0)
struct XcdBarrier { unsigned* bar; unsigned x; volatile LAS unsigned* st; };
__device__ __forceinline__ XcdBarrier xcd_barrier_post(unsigned* bar, volatile LAS unsigned* st) {
    XcdBarrier b; b.bar = bar; b.x = xb_xcc_id(); b.st = st;
    if (threadIdx.x == 0) (void)xb_add(&bar[XB_XCNT(b.x)], 1u);
    return b;
}
__device__ __forceinline__ void xcd_barrier_complete(unsigned* bar, unsigned x, unsigned& nloc, unsigned& nx) {
    const unsigned G = gridDim.x * gridDim.y * gridDim.z;
    unsigned sum, cnt, mine, sp = 0u;
    for (;;) {
        sum = 0u; cnt = 0u; mine = 0u;
#pragma unroll
        for (unsigned j = 0; j < 16; ++j) { const unsigned c = xb_ld(&bar[XB_XCNT(j)]); sum += c; cnt += (c > 0u) ? 1u : 0u; mine = (j == x) ? c : mine; }
        if (sum == G) break;
        __builtin_amdgcn_s_sleep(1);
        if ((++sp & 255u) == 0u) { if (xb_ld(&bar[XB_TMO])) break; if (sp > XB_SPIN_CAP) { atomicAdd(&bar[XB_TMO], 1u); break; } }
    }
    nloc = mine > 0u ? mine : 1u; nx = cnt > 0u ? cnt : 1u;
}
__device__ __forceinline__ void xcd_barrier(const XcdBarrier& b) {
    asm volatile("s_waitcnt vmcnt(0)" ::: "memory");
    __syncthreads();
    if (threadIdx.x == 0) {
        unsigned* bar = b.bar;
        __builtin_amdgcn_s_waitcnt(0);
        unsigned nloc = b.st[0], nx = b.st[1];
        if (nloc == 0u) { xcd_barrier_complete(bar, b.x, nloc, nx); b.st[0] = nloc; b.st[1] = nx; }
        const unsigned old = xb_add(&bar[XB_XSUB(b.x)], 1u);
        const unsigned gen = old / nloc;
        if (old + 1u == (gen + 1u) * nloc) {
            __builtin_amdgcn_fence(__ATOMIC_RELEASE, "agent");
            asm volatile("s_waitcnt vmcnt(0)" ::: "memory");
            const unsigned og = xb_add(&bar[XB_TOP], 1u);
            const unsigned tg = og / nx;
            if (og + 1u == (tg + 1u) * nx) xb_add(&bar[XB_TOPGEN], 1u);
            else XB_SPIN(xb_ld(&bar[XB_TOPGEN]) == tg, bar);
            __builtin_amdgcn_fence(__ATOMIC_ACQUIRE, "agent");
            xb_add(&bar[XB_XGEN(b.x)], 1u);
            asm volatile("s_waitcnt vmcnt(0)" ::: "memory");
        } else {
            XB_SPIN(xb_ld(&bar[XB_XGEN(b.x)]) == gen, bar);
            __builtin_amdgcn_fence(__ATOMIC_ACQUIRE, "agent");
            asm volatile("s_waitcnt vmcnt(0)" ::: "memory");
        }
    }
    __syncthreads();
}

struct Frame {
    LAS unsigned char* lds;
    volatile LAS unsigned* MISC;
    gu32* ctl;
    int tid, lane, wave;
    int vcu, G, bx;
    unsigned char* ws;
    float* X;
};
__device__ __forceinline__ const float* inptr(const Frame& F, int i) {
    const LAS unsigned* t = (const LAS unsigned*)(F.lds + INTAB_OFF); unsigned lo = t[2 * i], hi = t[2 * i + 1];
    lo = __builtin_amdgcn_readfirstlane(lo); hi = __builtin_amdgcn_readfirstlane(hi);
    return (const float*)(((unsigned long long)hi << 32) | lo);
}
__device__ __forceinline__ float wave_sum(float v) {
#pragma unroll
    for (int o = 1; o < 64; o <<= 1) v += __shfl_xor(v, o);
    return v;
}
__device__ __forceinline__ float wave_max(float v) {
#pragma unroll
    for (int o = 1; o < 64; o <<= 1) v = fmaxf(v, __shfl_xor(v, o));
    return v;
}

namespace pg8 {
__device__ __forceinline__ void load_rstd(const float* ssq, int pm, int wr, int lane, float (&rs)[2][4]) {
    float mine[2];
#pragma unroll
    for (int ai = 0; ai < 2; ++ai) { const f32x4* p = (const f32x4*)(ssq + (size_t)(pm * 256 + ai * 128 + wr * 64 + lane) * 16);
        const f32x4 a = p[0], b = p[1], c = p[2], d = p[3]; const f32x4 s = (a + b) + (c + d);
        mine[ai] = 1.0f / sqrtf(((s[0] + s[1]) + (s[2] + s[3])) * (1.0f / DM) + NORM_EPS); }
#pragma unroll
    for (int ai = 0; ai < 2; ++ai)
#pragma unroll
        for (int m = 0; m < 4; ++m) rs[ai][m] = __shfl(mine[ai], 16 * m + (lane & 15));
}
__device__ __forceinline__ u32x4 pack8(const f32x4& a, const f32x4& b) { u32x4 w; w.x = cvt_pk_bf16(a[0], a[1]); w.y = cvt_pk_bf16(a[2], a[3]); w.z = cvt_pk_bf16(b[0], b[1]); w.w = cvt_pk_bf16(b[2], b[3]); return w; }

struct EpiSwiglu {
    static constexpr bool PERM = true;
    bf16_t* O; const float* ssq;
    __device__ __forceinline__ bool operator()(f32x4 (&acc)[2][2][4][2], const Unit& u, int wr, int wc, int fr_, int fq_, int lane_) const {
        int lane = lane_; asm volatile("" : "+v"(lane)); lane &= 63; const int fr = lane & 15, fq = lane >> 4;
        float rs[2][4]; load_rstd(ssq, u.pm, wr, lane, rs);
        const int col0 = u.pn * 128 + wc * 32 + 8 * fq;
#pragma unroll
        for (int ai = 0; ai < 2; ++ai)
#pragma unroll
            for (int m = 0; m < 4; ++m) { const float r = rs[ai][m]; const size_t row = (size_t)(u.pm * BM + ai * HALF + wr * 64 + m * 16 + fr);
                f32x4 o[2];
#pragma unroll
                for (int n = 0; n < 2; ++n) { const f32x4 gg = acc[ai][0][m][n] * r, uu = acc[ai][1][m][n] * r;
#pragma unroll
                    for (int j = 0; j < 4; ++j) o[n][j] = siluf_(gg[j]) * uu[j]; }
                *(u32x4*)(O + row * DFF + col0) = pack8(o[0], o[1]); }
        return false;
    }
};
struct EpiResidual {
    static constexpr bool PERM = true;
    float* X; bf16_t* XB; float* ssq; float scale;
    __device__ __forceinline__ bool operator()(f32x4 (&acc)[2][2][4][2], const Unit& u, int wr, int wc, int fr_, int fq_, int lane_) const {
        int lane = lane_; asm volatile("" : "+v"(lane)); lane &= 63; const int fr = lane & 15, fq = lane >> 4;
        const int col0 = u.pn * BM + wc * 32 + 8 * fq;
#pragma unroll
        for (int ai = 0; ai < 2; ++ai)
#pragma unroll
            for (int m = 0; m < 4; ++m) { const size_t row = (size_t)(u.pm * BM + ai * HALF + wr * 64 + m * 16 + fr); float q = 0.f;
#pragma unroll
                for (int bj = 0; bj < 2; ++bj) { float* xp = X + row * DM + col0 + bj * HALF;
                    f32x4 x0 = *(const f32x4*)xp, x1 = *(const f32x4*)(xp + 4);
                    x0 = x0 + acc[ai][bj][m][0] * scale; x1 = x1 + acc[ai][bj][m][1] * scale;
                    *(f32x4*)xp = x0; *(f32x4*)(xp + 4) = x1;
                    q += (x0[0] * x0[0] + x0[1] * x0[1]) + (x0[2] * x0[2] + x0[3] * x0[3]) + (x1[0] * x1[0] + x1[1] * x1[1]) + (x1[2] * x1[2] + x1[3] * x1[3]);
                    *(u32x4*)(XB + row * DM + col0 + bj * HALF) = pack8(x0, x1); }
                q += __shfl_xor(q, 16); q += __shfl_xor(q, 32);
                if (fq == 0) ssq[row * 16 + u.pn * 4 + wc] = q; }
        return false;
    }
};
struct EpiSigmoid {
    static constexpr bool PERM = true;
    bf16_t* O; const float* ssq;
    __device__ __forceinline__ bool operator()(f32x4 (&acc)[2][2][4][2], const Unit& u, int wr, int wc, int fr_, int fq_, int lane_) const {
        int lane = lane_; asm volatile("" : "+v"(lane)); lane &= 63; const int fr = lane & 15, fq = lane >> 4;
        float rs[2][4]; load_rstd(ssq, u.pm, wr, lane, rs);
        bf16_t* base = O + (size_t)(u.pn >> 2) * M * DM + (u.pn & 3) * 256 + wc * 32 + 8 * fq;
#pragma unroll
        for (int ai = 0; ai < 2; ++ai)
#pragma unroll
            for (int m = 0; m < 4; ++m) { const float r = rs[ai][m]; const size_t row = (size_t)(u.pm * BM + ai * HALF + wr * 64 + m * 16 + fr);
#pragma unroll
                for (int bj = 0; bj < 2; ++bj) { f32x4 o[2];
#pragma unroll
                    for (int n = 0; n < 2; ++n)
#pragma unroll
                        for (int j = 0; j < 4; ++j) o[n][j] = sigmoidf_(acc[ai][bj][m][n][j] * r);
                    *(u32x4*)(base + row * DM + bj * HALF) = pack8(o[0], o[1]); } }
        return false;
    }
};
struct EpiMerge {
    static constexpr bool PERM = true;
    const bf16_t* GT; bf16_t* O;
    __device__ __forceinline__ bool operator()(f32x4 (&acc)[2][2][4][2], const Unit& u, int wr, int wc, int fr_, int fq_, int lane_) const {
        int lane = lane_; asm volatile("" : "+v"(lane)); lane &= 63; const int fr = lane & 15, fq = lane >> 4;
        const int col0 = u.pn * BM + wc * 32 + 8 * fq; const int s = u.seg;
        const bf16_t* g0 = GT + (size_t)s * M * DM; const bf16_t* g1 = GT + (size_t)(s + 1) * M * DM;
#pragma unroll
        for (int ai = 0; ai < 2; ++ai)
#pragma unroll
            for (int m = 0; m < 4; ++m) { const size_t row = (size_t)(u.pm * BM + ai * HALF + wr * 64 + m * 16 + fr);
#pragma unroll
                for (int bj = 0; bj < 2; ++bj) { const size_t off = row * DM + col0 + bj * HALF;
                    const u32x4 a = *(const u32x4*)(g0 + off);
                    float ga[8] = {bflo(a.x), bfhi(a.x), bflo(a.y), bfhi(a.y), bflo(a.z), bfhi(a.z), bflo(a.w), bfhi(a.w)};
                    if (s < 2) { const u32x4 b = *(const u32x4*)(g1 + off);
                        float gb[8] = {bflo(b.x), bfhi(b.x), bflo(b.y), bfhi(b.y), bflo(b.z), bfhi(b.z), bflo(b.w), bfhi(b.w)};
#pragma unroll
                        for (int e = 0; e < 8; ++e) acc[ai][bj][m][e >> 2][e & 3] *= fmaxf(ga[e], 1e-30f) / fmaxf(gb[e], 1e-30f);
                    } else { f32x4 o[2];
#pragma unroll
                        for (int e = 0; e < 8; ++e) o[e >> 2][e & 3] = acc[ai][bj][m][e >> 2][e & 3] * fmaxf(ga[e], 1e-30f);
                        *(u32x4*)(O + off) = pack8(o[0], o[1]); } } }
        return s < 2;
    }
};
struct EpiInProj {
    static constexpr bool PERM = true;
    unsigned char* ws; const float* ssq; const float* cosT; const float* sinT;
    const float* aq_n; const float* ak_n; const float* bq_n; const float* bk_n; const float* gbias;
    __device__ __forceinline__ bool operator()(f32x4 (&acc)[2][2][4][2], const Unit& u, int wr, int wc, int fr_, int fq_, int lane_) const {
        int lane = lane_; asm volatile("" : "+v"(lane)); lane &= 63; const int fr = lane & 15, fq = lane >> 4;
        float rs[2][4]; load_rstd(ssq, u.pm, wr, lane, rs);
        const int t = u.pn;
        int mode, pitch, colA, colB; bf16_t* dst; const float* gain = nullptr; float sc = 1.f; bool act = false;
        if (t < 18) { const int w = t / 6, tt = t % 6, g = tt >> 1, hd = ((tt & 1) * 4 + wc) * 64 + 8 * fq;
            dst = (bf16_t*)(ws + (w == 0 ? (g == 0 ? WS_AQ0 : (g == 1 ? WS_AQ1 : WS_AQ2)) : (w == 1 ? WS_AK0 + (size_t)g * 4 * UU : WS_AV0 + (size_t)g * 4 * UU)));
            pitch = 512; colA = hd; colB = hd + 32; mode = (w == 2) ? 1 : 0; gain = (w == 0) ? aq_n : ak_n; sc = (w == 0) ? QSCALE : 1.f; }
        else if (t < 20) { dst = (bf16_t*)(ws + WS_BQ); pitch = 512; colA = ((t - 18) * 4 + wc) * 64 + 8 * fq; colB = colA + 32; mode = 0; gain = bq_n; sc = QSCALE; }
        else if (t == 20) { pitch = 128; colA = (wc & 1) * 64 + 8 * fq; colB = colA + 32;
            if (wc < 2) { dst = (bf16_t*)(ws + WS_BK); mode = 0; gain = bk_n; } else { dst = (bf16_t*)(ws + WS_BV); mode = 1; } }
        else { colA = wc * 32 + 8 * fq; colB = colA + 128; mode = 2;
            if (t == 21) { dst = (bf16_t*)(ws + WS_CQ); pitch = 256; sc = 0.125f; }
            else if (t == 22) { dst = (bf16_t*)(ws + WS_CK); pitch = 256; }
            else if (t < 25) { dst = (bf16_t*)(ws + WS_CV); pitch = 512; colA += (t - 23) * 256; colB += (t - 23) * 256; }
            else if (t == 25) { dst = (bf16_t*)(ws + WS_LOGG); pitch = 256; mode = 3; }
            else { dst = (bf16_t*)(ws + WS_CR); pitch = 512; colA += (t - 26) * 256; colB += (t - 26) * 256; act = true; } }
        if (mode == 0) {
            f32x4 gA[2], gB[2];
#pragma unroll
            for (int n = 0; n < 2; ++n) { gA[n] = *(const f32x4*)(gain + 8 * fq + 4 * n); gB[n] = *(const f32x4*)(gain + 32 + 8 * fq + 4 * n); }
#pragma unroll
            for (int ai = 0; ai < 2; ++ai)
#pragma unroll
                for (int m = 0; m < 4; ++m) { const float r = rs[ai][m]; const size_t row = (size_t)(u.pm * BM + ai * HALF + wr * 64 + m * 16 + fr);
                    f32x4 a[2], b[2]; float ss = 0.f;
#pragma unroll
                    for (int n = 0; n < 2; ++n) { a[n] = acc[ai][0][m][n] * r; b[n] = acc[ai][1][m][n] * r;
                        ss += (a[n][0] * a[n][0] + a[n][1] * a[n][1]) + (a[n][2] * a[n][2] + a[n][3] * a[n][3]) + (b[n][0] * b[n][0] + b[n][1] * b[n][1]) + (b[n][2] * b[n][2] + b[n][3] * b[n][3]); }
                    ss += __shfl_xor(ss, 16); ss += __shfl_xor(ss, 32);
                    const float rn = 1.0f / sqrtf(ss * (1.0f / 64.0f) + NORM_EPS);
                    f32x4 oa[2], ob[2];
#pragma unroll
                    for (int n = 0; n < 2; ++n) { const f32x4 c = *(const f32x4*)(cosT + row * 32 + 8 * fq + 4 * n), s = *(const f32x4*)(sinT + row * 32 + 8 * fq + 4 * n);
                        const f32x4 y1 = a[n] * rn * gA[n], y2 = b[n] * rn * gB[n];
                        oa[n] = (y1 * c - y2 * s) * sc; ob[n] = (y2 * c + y1 * s) * sc; }
                    *(u32x4*)(dst + row * pitch + colA) = pack8(oa[0], oa[1]); *(u32x4*)(dst + row * pitch + colB) = pack8(ob[0], ob[1]); }
        } else if (mode == 3) {
            f32x4 bA[2], bB[2];
#pragma unroll
            for (int n = 0; n < 2; ++n) { bA[n] = *(const f32x4*)(gbias + colA + 4 * n); bB[n] = *(const f32x4*)(gbias + colB + 4 * n); }
#pragma unroll
            for (int ai = 0; ai < 2; ++ai)
#pragma unroll
                for (int m = 0; m < 4; ++m) { const float r = rs[ai][m]; const size_t row = (size_t)(u.pm * BM + ai * HALF + wr * 64 + m * 16 + fr);
#pragma unroll
                    for (int bj = 0; bj < 2; ++bj) { float v[8];
#pragma unroll
                        for (int e = 0; e < 8; ++e) { const float x = acc[ai][bj][m][e >> 2][e & 3] * r + (bj == 0 ? bA[e >> 2][e & 3] : bB[e >> 2][e & 3]);
                            v[e] = (fminf(x, 0.f) - __logf(1.0f + fexp(-fabsf(x)))) * (1.0f / 16.0f); }
                        u32x4 w; { h16x2 p0 = {(_Float16)v[0], (_Float16)v[1]}, p1 = {(_Float16)v[2], (_Float16)v[3]}, p2 = {(_Float16)v[4], (_Float16)v[5]}, p3 = {(_Float16)v[6], (_Float16)v[7]};
                            w.x = __builtin_bit_cast(unsigned, p0); w.y = __builtin_bit_cast(unsigned, p1); w.z = __builtin_bit_cast(unsigned, p2); w.w = __builtin_bit_cast(unsigned, p3); }
                        *(u32x4*)(dst + row * pitch + (bj == 0 ? colA : colB)) = w; } }
        } else {
#pragma unroll
            for (int ai = 0; ai < 2; ++ai)
#pragma unroll
                for (int m = 0; m < 4; ++m) { const float r = rs[ai][m] * sc; const size_t row = (size_t)(u.pm * BM + ai * HALF + wr * 64 + m * 16 + fr);
#pragma unroll
                    for (int bj = 0; bj < 2; ++bj) { f32x4 o[2];
#pragma unroll
                        for (int n = 0; n < 2; ++n) { o[n] = acc[ai][bj][m][n] * r;
                            if (act) {
#pragma unroll
                                for (int j = 0; j < 4; ++j) o[n][j] = siluf_(o[n][j]); } }
                        *(u32x4*)(dst + row * pitch + (bj == 0 ? colA : colB)) = pack8(o[0], o[1]); } }
        }
        return false;
    }
};
}

__constant__ float ROPE_INV[32] = {
    1.000000000e+00f, 7.498942614e-01f, 5.623413324e-01f, 4.216965139e-01f, 3.162277639e-01f, 2.371373773e-01f, 1.778279394e-01f, 1.333521307e-01f,
    1.000000015e-01f, 7.498941571e-02f, 5.623413250e-02f, 4.216965288e-02f, 3.162277490e-02f, 2.371373773e-02f, 1.778279431e-02f, 1.333521493e-02f,
    9.999999776e-03f, 7.498941850e-03f, 5.623413250e-03f, 4.216964822e-03f, 3.162277630e-03f, 2.371373586e-03f, 1.778279431e-03f, 1.333521446e-03f,
    1.000000047e-03f, 7.498942432e-04f, 5.623413017e-04f, 4.216965172e-04f, 3.162277571e-04f, 2.371373703e-04f, 1.778279402e-04f, 1.333521504e-04f};

struct ConvJob { const float* W; int ldw; int K; bf16* WT; int nrows; const float* gain; int mode; int base; const float* gate_up; };
__device__ __forceinline__ int conv_src0(int mode, int base, int n0) {
    if (mode == 0) return base + n0;
    const int t = n0 >> 8, c = n0 & 255;
    if (mode == 1) return c < 128 ? t * 128 + c : DFF + t * 128 + (c - 128);
    const int bj = c >> 7, wc = (c >> 5) & 3;
    if (t < 18) return (t / 6) * 1536 + (4 * (t % 6) + wc) * 64 + 32 * bj;
    if (t < 20) return 4608 + (4 * (t - 18) + wc) * 64 + 32 * bj;
    if (t == 20) return 5120 + wc * 64 + 32 * bj;
    if (t == 21) return 5376 + c;
    if (t == 22) return 5632 + c;
    if (t < 25) return 5888 + 256 * (t - 23) + c;
    if (t == 25) return -1;
    return 6416 + 256 * (t - 26) + c;
}
__device__ __forceinline__ void conv_item(const ConvJob& J, LAS float* scr, int item, int lane) {
    const int nblk = J.nrows / 32, kb = item / nblk, nb = item % nblk, k0 = 64 * kb, n0 = 32 * nb;
    const int src0 = conv_src0(J.mode, J.base, n0);
    if (src0 >= 0) {
#pragma unroll 8
        for (int i = 0; i < 32; ++i) { const int kk = 2 * i + (lane >> 5); float w = J.W[(size_t)(k0 + kk) * J.ldw + src0 + (lane & 31)];
            if (J.gain) w *= J.gain[k0 + kk];
            scr[kk * 33 + (lane & 31)] = w; }
    } else {
        float ug[16];
#pragma unroll
        for (int r = 0; r < 16; ++r) ug[r] = J.gate_up[r * 256 + (n0 & 255) + (lane & 31)];
#pragma unroll 4
        for (int i = 0; i < 32; ++i) { const int kk = 2 * i + (lane >> 5); const float* wrow = J.W + (size_t)(k0 + kk) * J.ldw + 6400; float s = 0.f;
#pragma unroll
            for (int r = 0; r < 16; ++r) s += wrow[r] * ug[r];
            scr[kk * 33 + (lane & 31)] = s * J.gain[k0 + kk]; }
    }
    LDS_WAIT(); asm volatile("" ::: "memory");
    const int c = lane & 7;
#pragma unroll
    for (int j = 0; j < 4; ++j) { const int n = (lane >> 3) + 8 * j; const LAS float* s = scr + (8 * c) * 33 + n;
        v4u o; o.x = pk2(s[0 * 33], s[1 * 33]); o.y = pk2(s[2 * 33], s[3 * 33]); o.z = pk2(s[4 * 33], s[5 * 33]); o.w = pk2(s[6 * 33], s[7 * 33]);
        *(GAS v4u*)(J.WT + (size_t)(n0 + n) * J.K + k0 + 8 * c) = o; }
    LDS_WAIT(); asm volatile("" ::: "memory");
}
__device__ __forceinline__ void conv_job(Frame& F, const ConvJob& J) {
    LAS float* scr = (LAS float*)(F.lds + RING_OFF + F.wave * 16384);
    const int gw = F.vcu * NWAVES + F.wave, NGW = F.G * NWAVES, nitems = (J.nrows / 32) * (J.K / 64);
    for (int it = gw; it < nitems; it += NGW) conv_item(J, scr, it, F.lane);
}
__device__ __forceinline__ void conv_set(Frame& F, int set, int l) {
    if (set == 0 || set == 4) { ConvJob J{inptr(F, set == 0 ? 3 : 18) + (size_t)l * DM * 2 * DFF, 2 * DFF, DM, (bf16*)(F.ws + WS_S1), 2 * DFF, inptr(F, set == 0 ? 2 : 17) + (size_t)l * DM, 1, 0, nullptr}; conv_job(F, J); }
    else if (set == 1 || set == 5) { ConvJob J{inptr(F, set == 1 ? 4 : 19) + (size_t)l * DFF * DM, DM, DFF, (bf16*)(F.ws + WS_S2), DM, nullptr, 0, 0, nullptr}; conv_job(F, J); }
    else if (set == 2) { ConvJob J{inptr(F, 6) + (size_t)l * DM * INW, INW, DM, (bf16*)(F.ws + WS_STATE), 7168, inptr(F, 5) + (size_t)l * DM, 2, 0, inptr(F, 12) + (size_t)l * 16 * 256}; conv_job(F, J); }
    else {
        { ConvJob J{inptr(F, 6) + (size_t)l * DM * INW, INW, DM, (bf16*)(F.ws + WS_WG), 3072, inptr(F, 5) + (size_t)l * DM, 0, 6928, nullptr}; conv_job(F, J); }
        for (int i = 0; i < 3; ++i) { ConvJob J{inptr(F, 15) + ((size_t)l * 3 + i) * 512 * DM, DM, 512, (bf16*)(F.ws + WS_WB) + (size_t)i * DM * 512, DM, nullptr, 0, 0, nullptr}; conv_job(F, J); }
        { ConvJob J{inptr(F, 16) + (size_t)l * DM * DM, DM, DM, (bf16*)(F.ws + WS_WO), DM, nullptr, 0, 0, nullptr}; conv_job(F, J); }
    }
}

__device__ __forceinline__ void p0_rows(Frame& F) {
    const int gw = F.vcu * NWAVES + F.wave, NGW = F.G * NWAVES;
    const float* x = inptr(F, 0); const int* pos = (const int*)inptr(F, 1);
    bf16* XB = (bf16*)(F.ws + WS_XB); float* ssq = (float*)(F.ws + WS_SSQ); float* cosT = (float*)(F.ws + WS_COS); float* sinT = (float*)(F.ws + WS_SIN);
    for (int m = gw; m < M; m += NGW) {
        const GAS f32x4* xr = (const GAS f32x4*)(x + (size_t)m * DM) + F.lane; GAS f32x4* xo = (GAS f32x4*)(F.X + (size_t)m * DM) + F.lane;
        GAS v2u* o8 = (GAS v2u*)(XB + (size_t)m * DM) + F.lane; float s = 0.f;
#pragma unroll
        for (int j = 0; j < 4; ++j) { const f32x4 v = xr[64 * j]; xo[64 * j] = v; s += (v.x * v.x + v.y * v.y) + (v.z * v.z + v.w * v.w);
            v2u w; w.x = pk2(v.x, v.y); w.y = pk2(v.z, v.w); o8[64 * j] = w; }
        s = wave_sum(s);
        if (F.lane < 16) ssq[(size_t)m * 16 + F.lane] = (F.lane == 0) ? s : 0.f;
        if (F.lane < 32) { const float ang = (float)pos[m] * ROPE_INV[F.lane];
            const double rev = (double)ang * 0.15915494309189535; const float fr = (float)(rev - __builtin_rint(rev));
            cosT[(size_t)m * 32 + F.lane] = __builtin_amdgcn_cosf(fr); sinT[(size_t)m * 32 + F.lane] = __builtin_amdgcn_sinf(fr); }
    }
}

typedef float f32x16 __attribute__((ext_vector_type(16)));
typedef short v4i16_t __attribute__((ext_vector_type(4)));
constexpr int ATT_K_OFF = 0, ATT_V_OFF = 49152, ATT_SCR_OFF = 98304;
struct BandUnit { const bf16* Q; const bf16* K; const bf16* V; bf16* O; float* LSE; int pq, pk, d, q0, win; size_t row0; float sink2; };
__device__ __forceinline__ int crow16(int r, int hi) { return (r & 3) + 8 * (r >> 2) + 4 * hi; }
__device__ __forceinline__ void band_unit(Frame& F, const BandUnit& U) {
    const int tid = F.tid, lane = F.lane, w = F.wave, i32 = lane & 31, hi = lane >> 5;
    LAS unsigned char* lds = F.lds;
    { const int c = tid & 7; v4u kr[6], vr[6];
#pragma unroll
        for (int i = 0; i < 6; ++i) { const int rr = (tid >> 3) + 64 * i, ci = U.q0 - 128 + rr;
            if (ci >= 0) { const size_t off = (U.row0 + (size_t)ci * U.d) * U.pk + c * 8; kr[i] = *(const v4u*)(U.K + off); vr[i] = *(const v4u*)(U.V + off); }
            else { kr[i] = (v4u){0u, 0u, 0u, 0u}; vr[i] = (v4u){0u, 0u, 0u, 0u}; } }
#pragma unroll
        for (int i = 0; i < 6; ++i) { const int rr = (tid >> 3) + 64 * i;
            *(LAS v4u*)(lds + ATT_K_OFF + rr * 128 + ((c ^ (rr & 7)) << 4)) = kr[i];
            *(LAS v4u*)(lds + ATT_V_OFF + rr * 128 + ((((c >> 1) ^ (((rr >> 1) & 1) << 1)) << 5) | ((c & 1) << 4))) = vr[i]; } }
    const size_t qtok = U.row0 + (size_t)(U.q0 + 32 * w + i32) * U.d;
    bf16x8 qr[4];
#pragma unroll
    for (int ks = 0; ks < 4; ++ks) qr[ks] = *(const bf16x8*)(U.Q + qtok * U.pq + 16 * ks + 8 * hi);
    __syncthreads();
    f32x16 p[5];
#pragma unroll
    for (int kt = 0; kt < 5; ++kt) { const int row = 32 * w + 32 * kt + i32;
#pragma unroll
        for (int r = 0; r < 16; ++r) p[kt][r] = 0.f;
#pragma unroll
        for (int ks = 0; ks < 4; ++ks) { const bf16x8 kf = *(const LAS bf16x8*)(lds + ATT_K_OFF + row * 128 + (((2 * ks + hi) ^ (row & 7)) << 4));
            p[kt] = __builtin_amdgcn_mfma_f32_32x32x16_bf16(kf, qr[ks], p[kt], 0, 0, 0); } }
    const int jlo = i32 + 128 - U.win;
#pragma unroll
    for (int r = 0; r < 16; ++r) { const int j = crow16(r, hi); if (j < jlo) p[0][r] = -INFINITY; if (j > i32) p[4][r] = -INFINITY; }
    if (U.q0 == 0 && w < 4) {
#pragma unroll
        for (int kt = 0; kt < 4; ++kt)
#pragma unroll
            for (int r = 0; r < 16; ++r) if (32 * w - 128 + 32 * kt + crow16(r, hi) < 0) p[kt][r] = -INFINITY; }
    float mx = U.sink2;
#pragma unroll
    for (int kt = 0; kt < 5; ++kt)
#pragma unroll
        for (int r = 0; r < 16; ++r) mx = fmaxf(mx, p[kt][r]);
    mx = fmaxf(mx, __shfl_xor(mx, 32));
    float ls = 0.f;
#pragma unroll
    for (int kt = 0; kt < 5; ++kt)
#pragma unroll
        for (int r = 0; r < 16; ++r) { p[kt][r] = fexp2(p[kt][r] - mx); ls += p[kt][r]; }
    ls += __shfl_xor(ls, 32);
    ls += fexp2(U.sink2 - mx);
    f32x16 o[2];
#pragma unroll
    for (int r = 0; r < 16; ++r) { o[0][r] = 0.f; o[1][r] = 0.f; }
    const int q_ = (lane & 15) >> 2;
    const int vbase = ATT_V_OFF + (32 * w + 4 * hi + q_) * 128 + 8 * (lane & 3);
    const int gsw = ((q_ >> 1) & 1) << 1, dh = (lane >> 4) & 1;
#pragma unroll
    for (int kt = 0; kt < 5; ++kt)
#pragma unroll
        for (int s = 0; s < 2; ++s) {
            v4u pw; pw.x = pg8::cvt_pk_bf16(p[kt][8 * s + 0], p[kt][8 * s + 1]); pw.y = pg8::cvt_pk_bf16(p[kt][8 * s + 2], p[kt][8 * s + 3]);
            pw.z = pg8::cvt_pk_bf16(p[kt][8 * s + 4], p[kt][8 * s + 5]); pw.w = pg8::cvt_pk_bf16(p[kt][8 * s + 6], p[kt][8 * s + 7]);
            const bf16x8 pf = __builtin_bit_cast(bf16x8, pw);
#pragma unroll
            for (int db = 0; db < 2; ++db) { const int a = vbase + (32 * kt + 16 * s) * 128 + ((((2 * db + dh) ^ gsw)) << 5);
                const v4i16_t lo = __builtin_amdgcn_ds_read_tr16_b64_v4i16((LAS v4i16_t*)(lds + a)), hv = __builtin_amdgcn_ds_read_tr16_b64_v4i16((LAS v4i16_t*)(lds + a + 8 * 128));
                const bf16x8 vf = {lo[0], lo[1], lo[2], lo[3], hv[0], hv[1], hv[2], hv[3]};
                o[db] = __builtin_amdgcn_mfma_f32_32x32x16_bf16(pf, vf, o[db], 0, 0, 0); } }
    LAS float* scr = (LAS float*)(lds + ATT_SCR_OFF) + w * 64;
    if (hi == 0) { scr[i32] = 1.0f / ls; if (U.LSE) U.LSE[qtok * 8] = mx + __log2f(ls); }
    LDS_WAIT();
#pragma unroll
    for (int r = 0; r < 16; ++r) { const int qi = crow16(r, hi); const float li = scr[qi];
        bf16* orow = U.O + (U.row0 + (size_t)(U.q0 + 32 * w + qi) * U.d) * U.pq + i32;
        orow[0] = (bf16)f2bf(o[0][r] * li); orow[32] = (bf16)f2bf(o[1][r] * li); }
    __syncthreads();
}
__device__ __forceinline__ void attn_phase(Frame& F, int l) {
    const float* sinks = inptr(F, 11) + l * 8;
    for (int u = F.vcu; u < 2048; u += F.G) {
        BandUnit U;
        if (u < 1536) { const int t32 = u & 31, h = (u >> 5) & 7, g = (u >> 8) % 3, b = u / 768, d = (g == 0) ? 1 : (g == 1 ? 4 : 16), tpc = 32 / d, cls = t32 / tpc;
            bf16* q = (bf16*)(F.ws + (g == 0 ? WS_AQ0 : (g == 1 ? WS_AQ1 : WS_AQ2))) + h * 64;
            U.Q = q; U.O = q; U.K = (const bf16*)(F.ws + WS_AK0 + (size_t)g * 4 * UU) + h * 64; U.V = (const bf16*)(F.ws + WS_AV0 + (size_t)g * 4 * UU) + h * 64;
            U.LSE = (float*)(F.ws + WS_LSE) + (size_t)g * M * 8 + h; U.pq = 512; U.pk = 512; U.d = d; U.q0 = (t32 % tpc) * 256; U.win = 128; U.row0 = (size_t)b * SEQ + cls; U.sink2 = -INFINITY;
        } else { const int ub = u - 1536, t32 = ub & 31, hq = (ub >> 5) & 7, b = ub >> 8;
            bf16* q = (bf16*)(F.ws + WS_BQ) + hq * 64;
            U.Q = q; U.O = q; U.K = (const bf16*)(F.ws + WS_BK) + (hq >> 2) * 64; U.V = (const bf16*)(F.ws + WS_BV) + (hq >> 2) * 64;
            U.LSE = nullptr; U.pq = 512; U.pk = 128; U.d = 1; U.q0 = t32 * 256; U.win = 127; U.row0 = (size_t)b * SEQ; U.sink2 = sinks[hq] * LOG2E; }
        band_unit(F, U);
    }
}
__device__ __forceinline__ void amerge_phase(Frame& F) {
    const float* LSE = (const float*)(F.ws + WS_LSE);
    for (int it = F.vcu * 512 + F.tid; it < M * 64; it += F.G * 512) {
        const int row = it >> 6, h = (it >> 3) & 7, c = it & 7; const size_t off = (size_t)row * 512 + h * 64 + c * 8;
        const float l0 = LSE[(size_t)row * 8 + h], l1 = LSE[(size_t)M * 8 + (size_t)row * 8 + h], l2 = LSE[(size_t)2 * M * 8 + (size_t)row * 8 + h];
        const float mx = fmaxf(l0, fmaxf(l1, l2)); float w0 = fexp2(l0 - mx), w1 = fexp2(l1 - mx), w2 = fexp2(l2 - mx); const float inv = 1.0f / (w0 + w1 + w2); w0 *= inv; w1 *= inv; w2 *= inv;
        const v4u a = *(const v4u*)((const bf16*)(F.ws + WS_AQ0) + off), b = *(const v4u*)((const bf16*)(F.ws + WS_AQ1) + off), cc = *(const v4u*)((const bf16*)(F.ws + WS_AQ2) + off);
        v4u o;
        o.x = pk2(w0 * bflo(a.x) + w1 * bflo(b.x) + w2 * bflo(cc.x), w0 * bfhi(a.x) + w1 * bfhi(b.x) + w2 * bfhi(cc.x));
        o.y = pk2(w0 * bflo(a.y) + w1 * bflo(b.y) + w2 * bflo(cc.y), w0 * bfhi(a.y) + w1 * bfhi(b.y) + w2 * bfhi(cc.y));
        o.z = pk2(w0 * bflo(a.z) + w1 * bflo(b.z) + w2 * bflo(cc.z), w0 * bfhi(a.z) + w1 * bfhi(b.z) + w2 * bfhi(cc.z));
        o.w = pk2(w0 * bflo(a.w) + w1 * bflo(b.w) + w2 * bflo(cc.w), w0 * bfhi(a.w) + w1 * bfhi(b.w) + w2 * bfhi(cc.w));
        *(v4u*)((bf16*)(F.ws + WS_AQ0) + off) = o;
    }
}

__device__ __forceinline__ void gla1_phase(Frame& F) {
    LAS float* bc = (LAS float*)(F.lds);
    LAS float* kt = (LAS float*)(F.lds + 16384);
    LAS float* vv = (LAS float*)(F.lds + 32768);
    const int tid = F.tid;
    const bf16* CK = (const bf16*)(F.ws + WS_CK); const bf16* CV = (const bf16*)(F.ws + WS_CV); const _Float16* LG = (const _Float16*)(F.ws + WS_LOGG);
    bf16* ST = (bf16*)(F.ws + WS_STATE); float* DC = (float*)(F.ws + WS_DC);
    for (int item = F.bx; item < 8 * 128; item += F.G) {
        const int bh = item >> 7, c = item & 127, b = bh >> 2, h = bh & 3; const size_t row0 = (size_t)b * SEQ + c * 64;
        { const int t = tid >> 3, d0 = (tid & 7) * 8;
            const v4u wl = *(const v4u*)(LG + (row0 + t) * 256 + h * 64 + d0); const v4u wk = *(const v4u*)(CK + (row0 + t) * 256 + h * 64 + d0);
            const unsigned wls[4] = {wl.x, wl.y, wl.z, wl.w}, wks[4] = {wk.x, wk.y, wk.z, wk.w};
#pragma unroll
            for (int i = 0; i < 4; ++i) { const h16x2 hh = __builtin_bit_cast(h16x2, wls[i]); bc[t * 64 + d0 + 2 * i] = (float)hh[0]; bc[t * 64 + d0 + 2 * i + 1] = (float)hh[1];
                kt[t * 64 + d0 + 2 * i] = bflo(wks[i]); kt[t * 64 + d0 + 2 * i + 1] = bfhi(wks[i]); }
            const int e0 = (tid & 7) * 16;
#pragma unroll
            for (int q = 0; q < 2; ++q) { const v4u wv = *(const v4u*)(CV + (row0 + t) * 512 + h * 128 + e0 + 8 * q); const unsigned wvs[4] = {wv.x, wv.y, wv.z, wv.w};
#pragma unroll
                for (int i = 0; i < 4; ++i) { vv[t * 128 + e0 + 8 * q + 2 * i] = bflo(wvs[i]); vv[t * 128 + e0 + 8 * q + 2 * i + 1] = bfhi(wvs[i]); } } }
        __syncthreads();
        if (tid < 64) { float run = 0.f; for (int t = 0; t < 64; ++t) { run += bc[t * 64 + tid]; bc[t * 64 + tid] = run; } DC[(size_t)item * 64 + tid] = fexp(run); }
        __syncthreads();
        for (int i = tid; i < 4096; i += 512) { const int d = i & 63; kt[i] *= fexp(bc[63 * 64 + d] - bc[i]); }
        __syncthreads();
        { const int d = tid >> 3, e0 = (tid & 7) * 16; float a[16];
#pragma unroll
            for (int j = 0; j < 16; ++j) a[j] = 0.f;
            for (int s = 0; s < 64; ++s) { const float kk = kt[s * 64 + d];
#pragma unroll
                for (int j = 0; j < 16; ++j) a[j] += kk * vv[s * 128 + e0 + j]; }
            v4u o0, o1; o0.x = pk2(a[0], a[1]); o0.y = pk2(a[2], a[3]); o0.z = pk2(a[4], a[5]); o0.w = pk2(a[6], a[7]);
            o1.x = pk2(a[8], a[9]); o1.y = pk2(a[10], a[11]); o1.z = pk2(a[12], a[13]); o1.w = pk2(a[14], a[15]);
            bf16* dst = ST + ((size_t)item * 64 + d) * 128 + e0; *(v4u*)dst = o0; *(v4u*)(dst + 8) = o1; }
        __syncthreads();
    }
}
__device__ __forceinline__ void gla2_phase(Frame& F) {
    bf16* ST = (bf16*)(F.ws + WS_STATE); const float* DC = (const float*)(F.ws + WS_DC);
    for (int gt = F.vcu * 512 + F.tid; gt < 8 * 64 * 128; gt += F.G * 512) {
        const int bh = gt >> 13, d = (gt >> 7) & 63, e = gt & 127; float S = 0.f;
        for (int c0 = 0; c0 < 128; c0 += 8) { float u[8], dc[8];
#pragma unroll
            for (int i = 0; i < 8; ++i) { const size_t ci = (size_t)bh * 128 + c0 + i; u[i] = bf2f(ST[(ci * 64 + d) * 128 + e]); dc[i] = DC[ci * 64 + d]; }
#pragma unroll
            for (int i = 0; i < 8; ++i) { const size_t ci = (size_t)bh * 128 + c0 + i; ST[(ci * 64 + d) * 128 + e] = (bf16)f2bf(S); S = dc[i] * S + u[i]; } }
    }
}
__device__ __forceinline__ void gla3_phase(Frame& F, int l) {
    LAS float* bc = (LAS float*)(F.lds);
    LAS float* qt = (LAS float*)(F.lds + 16384);
    LAS float* kt = (LAS float*)(F.lds + 32768);
    LAS float* vv = (LAS float*)(F.lds + 49408);
    LAS float* ss = (LAS float*)(F.lds + 82176);
    LAS float* at = bc;
    const int tid = F.tid;
    const bf16* CQ = (const bf16*)(F.ws + WS_CQ); const bf16* CK = (const bf16*)(F.ws + WS_CK); bf16* CV = (bf16*)(F.ws + WS_CV); const _Float16* LG = (const _Float16*)(F.ws + WS_LOGG);
    const bf16* CR = (const bf16*)(F.ws + WS_CR); const bf16* ST = (const bf16*)(F.ws + WS_STATE); const float* gain = inptr(F, 14) + l * 128;
    for (int item = F.bx; item < 8 * 128; item += F.G) {
        const int bh = item >> 7, c = item & 127, b = bh >> 2, h = bh & 3; const size_t row0 = (size_t)b * SEQ + c * 64;
        { const int t = tid >> 3, d0 = (tid & 7) * 8;
            const v4u wl = *(const v4u*)(LG + (row0 + t) * 256 + h * 64 + d0); const v4u wk = *(const v4u*)(CK + (row0 + t) * 256 + h * 64 + d0); const v4u wq = *(const v4u*)(CQ + (row0 + t) * 256 + h * 64 + d0);
            const unsigned wls[4] = {wl.x, wl.y, wl.z, wl.w}, wks[4] = {wk.x, wk.y, wk.z, wk.w}, wqs[4] = {wq.x, wq.y, wq.z, wq.w};
#pragma unroll
            for (int i = 0; i < 4; ++i) { const h16x2 hh = __builtin_bit_cast(h16x2, wls[i]); bc[t * 64 + d0 + 2 * i] = (float)hh[0]; bc[t * 64 + d0 + 2 * i + 1] = (float)hh[1];
                kt[t * 65 + d0 + 2 * i] = bflo(wks[i]); kt[t * 65 + d0 + 2 * i + 1] = bfhi(wks[i]);
                qt[t * 64 + d0 + 2 * i] = bflo(wqs[i]); qt[t * 64 + d0 + 2 * i + 1] = bfhi(wqs[i]); }
            const int e0 = (tid & 7) * 16;
#pragma unroll
            for (int q = 0; q < 2; ++q) { const v4u wv = *(const v4u*)(CV + (row0 + t) * 512 + h * 128 + e0 + 8 * q); const unsigned wvs[4] = {wv.x, wv.y, wv.z, wv.w};
                const v4u wsv = *(const v4u*)(ST + ((size_t)item * 64 + t) * 128 + e0 + 8 * q); const unsigned wss[4] = {wsv.x, wsv.y, wsv.z, wsv.w};
#pragma unroll
                for (int i = 0; i < 4; ++i) { vv[t * 128 + e0 + 8 * q + 2 * i] = bflo(wvs[i]); vv[t * 128 + e0 + 8 * q + 2 * i + 1] = bfhi(wvs[i]);
                    ss[t * 128 + e0 + 8 * q + 2 * i] = bflo(wss[i]); ss[t * 128 + e0 + 8 * q + 2 * i + 1] = bfhi(wss[i]); } } }
        __syncthreads();
        if (tid < 64) { float run = 0.f; for (int t = 0; t < 64; ++t) { run += bc[t * 64 + tid]; bc[t * 64 + tid] = run; } }
        __syncthreads();
        for (int i = tid; i < 4096; i += 512) { const float bb = bc[i]; qt[i] *= fexp(bb); kt[(i >> 6) * 65 + (i & 63)] *= fexp(-bb); }
        __syncthreads();
        { const int t = tid >> 3, s0 = (tid & 7) * 8; float a[8];
#pragma unroll
            for (int j = 0; j < 8; ++j) a[j] = 0.f;
            for (int d = 0; d < 64; ++d) { const float qq = qt[t * 64 + d];
#pragma unroll
                for (int j = 0; j < 8; ++j) a[j] += qq * kt[(s0 + j) * 65 + d]; }
#pragma unroll
            for (int j = 0; j < 8; ++j) at[t * 64 + s0 + j] = (s0 + j <= t) ? a[j] : 0.f; }
        __syncthreads();
        { const int t = tid >> 3, e0 = (tid & 7) * 16; float a[16];
#pragma unroll
            for (int j = 0; j < 16; ++j) a[j] = 0.f;
            for (int d = 0; d < 64; ++d) { const float qq = qt[t * 64 + d];
#pragma unroll
                for (int j = 0; j < 16; ++j) a[j] += qq * ss[d * 128 + e0 + j]; }
            for (int s = 0; s <= t; ++s) { const float aa = at[t * 64 + s];
#pragma unroll
                for (int j = 0; j < 16; ++j) a[j] += aa * vv[s * 128 + e0 + j]; }
            float q2 = 0.f;
#pragma unroll
            for (int j = 0; j < 16; ++j) q2 += a[j] * a[j];
            q2 += __shfl_xor(q2, 1); q2 += __shfl_xor(q2, 2); q2 += __shfl_xor(q2, 4);
            const float rn = 1.0f / sqrtf(q2 * (1.0f / 128.0f) + NORM_EPS);
            const bf16* cr = CR + (row0 + t) * 512 + h * 128 + e0; const v4u c0 = *(const v4u*)cr, c1 = *(const v4u*)(cr + 8);
            const float cf[16] = {bflo(c0.x), bfhi(c0.x), bflo(c0.y), bfhi(c0.y), bflo(c0.z), bfhi(c0.z), bflo(c0.w), bfhi(c0.w), bflo(c1.x), bfhi(c1.x), bflo(c1.y), bfhi(c1.y), bflo(c1.z), bfhi(c1.z), bflo(c1.w), bfhi(c1.w)};
#pragma unroll
            for (int j = 0; j < 16; ++j) a[j] = a[j] * rn * gain[e0 + j] * cf[j];
            v4u o0, o1; o0.x = pk2(a[0], a[1]); o0.y = pk2(a[2], a[3]); o0.z = pk2(a[4], a[5]); o0.w = pk2(a[6], a[7]);
            o1.x = pk2(a[8], a[9]); o1.y = pk2(a[10], a[11]); o1.z = pk2(a[12], a[13]); o1.w = pk2(a[14], a[15]);
            bf16* dst = CV + (row0 + t) * 512 + h * 128 + e0; *(v4u*)dst = o0; *(v4u*)(dst + 8) = o1; }
        __syncthreads();
    }
}

template <class T> __device__ __forceinline__ T* launder(T* p) {
    unsigned long long v = (unsigned long long)p; unsigned lo = (unsigned)v, hi = (unsigned)(v >> 32);
    asm volatile("" : "+s"(lo), "+s"(hi));
    return (T*)(((unsigned long long)hi << 32) | lo);
}
constexpr int PH_PER_LAYER = 11, N_PHASES = 1 + NLAYER * PH_PER_LAYER;
struct Args { const void* in[20]; float* out; unsigned char* ws; int ph_lo, ph_hi, li, pad; };
__global__ void __launch_bounds__(NWAVES * 64, 2) mk_fwd(Args args) {
    extern __shared__ __attribute__((aligned(16))) unsigned char lds[];
    Frame F;
    F.lds = (LAS unsigned char*)lds;
    F.MISC = (volatile LAS unsigned*)(F.lds + MISC_OFF);
    F.tid = threadIdx.x; F.lane = F.tid & 63; F.wave = __builtin_amdgcn_readfirstlane(F.tid >> 6);
    F.G = gridDim.x; F.bx = blockIdx.x; F.vcu = 0;
    F.ws = args.ws; F.X = args.out;
    F.ctl = (gu32*)(args.ws + WS_CTL);
    for (int u = F.tid; u < (LDS_BYTES - LDSCTL_OFF) / 4; u += NWAVES * 64) ((LAS unsigned*)(F.lds + LDSCTL_OFF))[u] = 0u;
    __syncthreads();
    if (F.tid == 0) {
#pragma unroll
        for (int i = 0; i < 20; ++i) ((LAS unsigned long long*)(F.lds + INTAB_OFF))[i] = (unsigned long long)args.in[i];
    }
    __syncthreads();
    XcdBarrier bar; bar.bar = (unsigned*)(F.ctl + CW_BAR); bar.x = 0; bar.st = nullptr;
    if (!MK_PER_PHASE) bar = xcd_barrier_post((unsigned*)(F.ctl + CW_BAR), F.MISC + 8);
    for (int ph = args.ph_lo; ph < args.ph_hi; ++ph) {
        { int t_ = threadIdx.x; asm volatile("" : "+v"(t_)); t_ &= 511; F.tid = t_; F.lane = t_ & 63; F.wave = __builtin_amdgcn_readfirstlane(t_ >> 6); }
        F.ws = launder(args.ws); F.X = launder(args.out);
        { int bx_ = blockIdx.x, g_ = gridDim.x; asm volatile("" : "+s"(bx_), "+s"(g_)); F.bx = bx_; F.G = g_; F.vcu = (g_ % 8 == 0) ? (bx_ % 8) * (g_ / 8) + bx_ / 8 : bx_; }
        const float* ssq = (const float*)(F.ws + WS_SSQ);
        pg8::bf16_t* XB = (pg8::bf16_t*)(F.ws + WS_XB);
        if (ph == 0) {
            p0_rows(F); conv_set(F, 0, 0); conv_set(F, 1, 0); conv_set(F, 2, 0); conv_set(F, 3, 0);
        } else {
            const int l = (ph - 1) / PH_PER_LAYER, k = (ph - 1) % PH_PER_LAYER;
            if (k == 0 || k == 9) {
                if (k == 0 && l > 0) { conv_set(F, 1, l); __syncthreads(); }
                if (k == 9 && l + 1 < NLAYER) { conv_set(F, 3, l + 1); conv_set(F, 2, l + 1); __syncthreads(); }
                pg8::Gemm g{XB, XB, XB, (const pg8::bf16_t*)(F.ws + WS_S1), nullptr, nullptr, M, 2 * DFF, DM};
                pg8::StaticOrder S; S.init(M, 2 * DFF, F.G, F.bx);
                pg8::EpiSwiglu E{(pg8::bf16_t*)(F.ws + WS_ACTH), ssq};
                pg8::gemm_phase<pg8::EpiSwiglu, pg8::StaticOrder, true>(F.lds + RING_OFF, g, S, E);
            } else if (k == 1 || k == 10) {
                if (k == 10 && l + 1 < NLAYER) { conv_set(F, 0, l + 1); __syncthreads(); }
                const pg8::bf16_t* A = (const pg8::bf16_t*)(F.ws + WS_ACTH);
                pg8::Gemm g{A, A, A, (const pg8::bf16_t*)(F.ws + WS_S2), nullptr, nullptr, M, DM, DFF};
                pg8::StaticOrder S; S.init(M, DM, F.G, F.bx);
                pg8::EpiResidual E{F.X, XB, (float*)(F.ws + WS_SSQ), 0.5f};
                pg8::gemm_phase<pg8::EpiResidual, pg8::StaticOrder, false>(F.lds + RING_OFF, g, S, E);
            } else if (k == 2) {
                conv_set(F, 4, l); conv_set(F, 5, l); __syncthreads();
                pg8::Gemm g{XB, XB, XB, (const pg8::bf16_t*)(F.ws + WS_STATE), nullptr, nullptr, M, 7168, DM};
                pg8::StaticOrder S; S.init(M, 7168, F.G, F.bx);
                pg8::EpiInProj E{F.ws, ssq, (const float*)(F.ws + WS_COS), (const float*)(F.ws + WS_SIN), inptr(F, 7) + l * 64, inptr(F, 8) + l * 64, inptr(F, 9) + l * 64, inptr(F, 10) + l * 64, inptr(F, 13) + l * 256};
                pg8::gemm_phase<pg8::EpiInProj, pg8::StaticOrder, true>(F.lds + RING_OFF, g, S, E);
            } else if (k == 3) {
                gla1_phase(F); __syncthreads(); attn_phase(F, l);
            } else if (k == 4) { gla2_phase(F);
            } else if (k == 5) { gla3_phase(F, l);
            } else if (k == 6) {
                amerge_phase(F);
                pg8::Gemm g{XB, XB, XB, (const pg8::bf16_t*)(F.ws + WS_WG), nullptr, nullptr, M, 3 * DM, DM};
                pg8::StaticOrder S; S.init(M, 3 * DM, F.G, F.bx);
                pg8::EpiSigmoid E{(pg8::bf16_t*)(F.ws + WS_GATES), ssq};
                pg8::gemm_phase<pg8::EpiSigmoid, pg8::StaticOrder, true>(F.lds + RING_OFF, g, S, E);
            } else if (k == 7) {
                const pg8::bf16_t* WB = (const pg8::bf16_t*)(F.ws + WS_WB);
                pg8::Gemm g{(const pg8::bf16_t*)(F.ws + WS_AQ0), (const pg8::bf16_t*)(F.ws + WS_BQ), (const pg8::bf16_t*)(F.ws + WS_CV), WB, WB + (size_t)DM * 512, WB + (size_t)2 * DM * 512, M, DM, 512};
                pg8::Seg3Order S; S.b.init(M, DM, F.G, F.bx);
                pg8::EpiMerge E{(const pg8::bf16_t*)(F.ws + WS_GATES), (pg8::bf16_t*)(F.ws + WS_MERGED)};
                pg8::gemm_phase<pg8::EpiMerge, pg8::Seg3Order, false>(F.lds + RING_OFF, g, S, E);
            } else {
                const pg8::bf16_t* A = (const pg8::bf16_t*)(F.ws + WS_MERGED);
                pg8::Gemm g{A, A, A, (const pg8::bf16_t*)(F.ws + WS_WO), nullptr, nullptr, M, DM, DM};
                pg8::StaticOrder S; S.init(M, DM, F.G, F.bx);
                pg8::EpiResidual E{F.X, XB, (float*)(F.ws + WS_SSQ), 1.0f};
                pg8::gemm_phase<pg8::EpiResidual, pg8::StaticOrder, false>(F.lds + RING_OFF, g, S, E);
            }
        }
        if (ph + 1 < args.ph_hi) xcd_barrier(bar);
    }
}

extern "C" void kernel_launch(void* const* d_in, const int* in_sizes, int n_in, void* d_out, int out_size, void* d_ws, size_t ws_size, hipStream_t stream) {
    static int grid = 0;
    if (grid == 0) {
        if (n_in != 20 || out_size != M * DM || ws_size < WS_END) { fprintf(stderr, "kernel_launch: unexpected problem (n_in %d, out %d, ws %zu < %zu); nothing launched\n", n_in, out_size, ws_size, (size_t)WS_END); grid = -1; return; }
        int dev = 0, cus = 0, per_cu = 0;
        if (hipGetDevice(&dev) != hipSuccess || hipDeviceGetAttribute(&cus, hipDeviceAttributeMultiprocessorCount, dev) != hipSuccess) { grid = -1; return; }
        if (hipFuncSetAttribute((const void*)mk_fwd, hipFuncAttributeMaxDynamicSharedMemorySize, LDS_BYTES) != hipSuccess) { fprintf(stderr, "kernel_launch: hipFuncSetAttribute failed\n"); grid = -1; return; }
        if (hipOccupancyMaxActiveBlocksPerMultiprocessor(&per_cu, (const void*)mk_fwd, NWAVES * 64, LDS_BYTES) != hipSuccess || per_cu < 1)
            fprintf(stderr, "kernel_launch: note: occupancy query reports %d workgroups per CU\n", per_cu);
        (void)hipGetLastError();
        grid = cus;
    }
    if (grid < 0) return;
    if (hipMemsetAsync((char*)d_ws + WS_CTL, 0, CTL_ZERO_BYTES, stream) != hipSuccess) return;
    Args a{};
    for (int i = 0; i < 20; ++i) a.in[i] = d_in[i];
    a.out = (float*)d_out; a.ws = (unsigned char*)d_ws;
#if MK_PER_PHASE
    for (int p = 0; p < N_PHASES; ++p) { a.ph_lo = p; a.ph_hi = p + 1; a.li = p; hipLaunchKernelGGL(mk_fwd, dim3(grid), dim3(NWAVES * 64), LDS_BYTES, stream, a); }
#else
    a.ph_lo = 0; a.ph_hi = N_PHASES; a.li = 0;
    hipLaunchKernelGGL(mk_fwd, dim3(grid), dim3(NWAVES * 64), LDS_BYTES, stream, a);
#endif
}
```

```cpp
#include <hip/hip_runtime.h>
#include <cstdio>
#include <cstdint>

#ifndef MK_BF16
#define MK_BF16 0
#endif
#ifndef MK_PER_PHASE
#define MK_PER_PHASE 0
#endif
static_assert(MK_PER_PHASE == 0, "one launch only");

namespace pg8 {
#define PG8_LAS __attribute__((address_space(3)))
typedef unsigned short bf16_t;
typedef short bf16x8 __attribute__((ext_vector_type(8)));
typedef _Float16 h16x8_t __attribute__((ext_vector_type(8)));
typedef float f32x4 __attribute__((ext_vector_type(4)));
typedef unsigned u32x4 __attribute__((ext_vector_type(4)));
constexpr int BM = 256, BK = 64, HALF = 128, HTB = HALF * BK * 2  , STAGE_BYTES = 8 * HTB, NXCD = 8, WGM = 8;

__host__ __device__ __forceinline__ int lds_byte(int r, int c) { const int st = (r >> 4) * 2 + (c >> 5), rr = r & 15, cc = c & 31, ob = rr * 64 + cc * 2; return st * 1024 + (ob ^ (((ob >> 9) & 1) << 5)); }
__host__ __device__ __forceinline__ void stage_rc(int b, int& R, int& C) { const int st = b / 1024, sb = b % 1024, swz = sb ^ (((sb >> 9) & 1) << 5); R = (st >> 1) * 16 + swz / 64; C = (st & 1) * 32 + (swz % 64) / 2; }
__host__ __device__ __forceinline__ int perm32(int rho) { const int n = rho >> 4, i = rho & 15; return 8 * (i >> 2) + 4 * n + (i & 3); }

struct Unit { int pm, pn, seg; };
struct Gemm { const bf16_t* A0; const bf16_t* A1; const bf16_t* A2; const bf16_t* B0; const bf16_t* B1; const bf16_t* B2; int M, N, K; };

struct StaticOrder {
    int nM, nN, nwg, G, c;
    __host__ __device__ void init(int M, int N, int G_, int c_) { nM = M / BM; nN = N / BM; nwg = nM * nN; G = G_; c = c_; }
    __host__ __device__ bool next(int i, Unit& u) const {
        const long L = (long)i * G + c; if (L >= nwg) return false;
        int wgid = (int)L; { const int q = nwg / NXCD, r = nwg % NXCD, xcd = wgid % NXCD, off = wgid / NXCD; wgid = (xcd < r ? xcd * (q + 1) : r * (q + 1) + (xcd - r) * q) + off; }
        const int nig = WGM * nN, gid = wgid / nig, fm = gid * WGM, gsz = (nM - fm) < WGM ? (nM - fm) : WGM;
        u.pm = fm + ((wgid % nig) % gsz); u.pn = (wgid % nig) / gsz; u.seg = 0; return true;
    }
};
struct Seg3Order {
    StaticOrder b;
    __host__ __device__ bool next(int i, Unit& u) const { if (!b.next(i / 3, u)) return false; u.seg = i % 3; return true; }
};

typedef float f32x2_t __attribute__((ext_vector_type(2))); typedef __bf16 bf16x2_t __attribute__((ext_vector_type(2))); typedef _Float16 h16x2_t __attribute__((ext_vector_type(2)));
__device__ __forceinline__ unsigned cvt_pk_bf(float lo, float hi) { f32x2_t v = {lo, hi}; bf16x2_t b = __builtin_convertvector(v, bf16x2_t); return __builtin_bit_cast(unsigned, b); }
__device__ __forceinline__ unsigned cvt_pk_h16(float lo, float hi) { h16x2_t b = {(_Float16)lo, (_Float16)hi}; return __builtin_bit_cast(unsigned, b); }
__device__ __forceinline__ unsigned cvt_pk_h(float lo, float hi) { return MK_BF16 ? cvt_pk_bf(lo, hi) : cvt_pk_h16(lo, hi); }

template <class Epi, class Sched, bool ALIGN_EPI = false>
__device__ __forceinline__ void gemm_phase(PG8_LAS unsigned char* lds, const Gemm g, const Sched& S, const Epi& E, int tid_in) {
    int tid_ = tid_in; asm volatile("" : "+v"(tid_));
    const int tid = tid_ & 511, wid = __builtin_amdgcn_readfirstlane(tid >> 6), lane = tid & 63, wr = wid >> 2, wc = wid & 3, fr = lane & 15, fq = lane >> 4;
    const int K = g.K, nt = K / BK;
    unsigned voffA[2], voffB[2];
#pragma unroll
    for (int i = 0; i < 2; ++i) { int R, C; stage_rc(tid * 16 + i * 8192, R, C); const int Rb = Epi::PERM ? ((R & ~31) + perm32(R & 31)) : R;
        voffA[i] = (unsigned)(R * K + C) * 2u; voffB[i] = (unsigned)(Rb * K + C) * 2u; }
    const size_t kstep = (size_t)(BK * 2);
    const size_t hstep = (size_t)HALF * K * 2;
    const size_t tstep = 2 * hstep;
    const unsigned ldsw = (unsigned)wid * 1024u;
    const int aoff = lds_byte(wr * 64 + fr, fq * 8), boff = lds_byte(wc * 32 + fr, fq * 8);
#define PG8_SA(b, h) (((b) * 2 + (h)) * HTB)
#define PG8_SB(b, h) ((4 + (b) * 2 + (h)) * HTB)
#define PG8_STAGE(bufoff, gbase, voff) do { _Pragma("unroll") for (int _i = 0; _i < 2; ++_i) \
        __builtin_amdgcn_global_load_lds((const unsigned*)((const char*)(gbase) + (voff)[_i]), (PG8_LAS unsigned*)(lds + (bufoff) + ldsw + _i * 8192), 16, 0, 0); } while (0)
#define PG8_LDA(dst, b, h) do { _Pragma("unroll") for (int m = 0; m < 4; ++m) _Pragma("unroll") for (int k = 0; k < 2; ++k) dst[m][k] = *(const PG8_LAS bf16x8*)(lds + PG8_SA(b, h) + aoff + m * 2048 + k * 1024); } while (0)
#define PG8_LDB(dst, b, h) do { _Pragma("unroll") for (int n = 0; n < 2; ++n) _Pragma("unroll") for (int k = 0; k < 2; ++k) dst[n][k] = *(const PG8_LAS bf16x8*)(lds + PG8_SB(b, h) + boff + n * 2048 + k * 1024); } while (0)
#define PG8_MMA(ai, bj, At, Bt) do { __builtin_amdgcn_s_setprio(1); _Pragma("unroll") for (int m = 0; m < 4; ++m) _Pragma("unroll") for (int n = 0; n < 2; ++n) _Pragma("unroll") for (int k = 0; k < 2; ++k) \
        acc[ai][bj][m][n] = MK_BF16 ? __builtin_amdgcn_mfma_f32_16x16x32_bf16(Bt[n][k], At[m][k], acc[ai][bj][m][n], 0, 0, 0) : __builtin_amdgcn_mfma_f32_16x16x32_f16(__builtin_bit_cast(h16x8_t, Bt[n][k]), __builtin_bit_cast(h16x8_t, At[m][k]), acc[ai][bj][m][n], 0, 0, 0); __builtin_amdgcn_s_setprio(0); } while (0)
#define PG8_WAIT_V(n) asm volatile("s_waitcnt vmcnt(" #n ")" ::: "memory")
#define PG8_WAIT_L(n) asm volatile("s_waitcnt lgkmcnt(" #n ")" ::: "memory")
#define PG8_BAR __builtin_amdgcn_s_barrier()
#define PG8_SCHED __builtin_amdgcn_sched_barrier(0)
#define PG8_ASEL(u) ((u).seg == 0 ? g.A0 : ((u).seg == 1 ? g.A1 : g.A2))
#define PG8_BSEL(u) ((u).seg == 0 ? g.B0 : ((u).seg == 1 ? g.B1 : g.B2))
    Unit cur, nxt; int ui = 0;
    if (!S.next(0, cur)) return;
    f32x4 acc[2][2][4][2];
#pragma unroll
    for (int a = 0; a < 2; ++a)
#pragma unroll
        for (int b = 0; b < 2; ++b)
#pragma unroll
            for (int m = 0; m < 4; ++m)
#pragma unroll
                for (int n = 0; n < 2; ++n) acc[a][b][m][n] = (f32x4){0.f, 0.f, 0.f, 0.f};
    E.init(acc, cur, wr, wc, lane);
    typename Epi::Pro pro; E.pro_load(pro, cur, tid);
    bf16x8 At[4][2], B0[2][2], B1[2][2];
    const char* cA = (const char*)PG8_ASEL(cur) + (size_t)cur.pm * tstep; const char* cB = (const char*)PG8_BSEL(cur) + (size_t)cur.pn * tstep;
    PG8_STAGE(PG8_SB(0, 0), cB, voffB); PG8_STAGE(PG8_SB(0, 1), cB + hstep, voffB); PG8_STAGE(PG8_SA(0, 0), cA, voffA); PG8_STAGE(PG8_SA(0, 1), cA + hstep, voffA);
    E.pro_store(pro, tid);
    if (wr == 1) PG8_BAR;
    PG8_WAIT_V(2); PG8_BAR;
    PG8_STAGE(PG8_SB(1, 0), cB + kstep, voffB); PG8_STAGE(PG8_SA(1, 0), cA + kstep, voffA); PG8_STAGE(PG8_SB(1, 1), cB + hstep + kstep, voffB);
    PG8_WAIT_V(6); PG8_BAR;
    for (;;) {
        const bool has_next = S.next(ui + 1, nxt);
        const char* nA = has_next ? (const char*)PG8_ASEL(nxt) + (size_t)nxt.pm * tstep : cA; const char* nB = has_next ? (const char*)PG8_BSEL(nxt) + (size_t)nxt.pn * tstep : cB;
        for (int t = 0; t < nt; t += 2) {
            const bool last = (t == nt - 2);
            const char* a1 = cA + (size_t)(t + 1) * kstep;
            const char* a2 = last ? nA : cA + (size_t)(t + 2) * kstep; const char* b2 = last ? nB : cB + (size_t)(t + 2) * kstep;
            const char* a3 = a2 + kstep; const char* b3 = b2 + kstep;
            PG8_LDB(B0, 0, 0); PG8_LDB(B1, 0, 1); PG8_SCHED; PG8_LDA(At, 0, 0); PG8_STAGE(PG8_SA(1, 1), a1 + hstep, voffA);
            PG8_WAIT_V(8); PG8_WAIT_L(0); PG8_BAR; PG8_MMA(0, 0, At, B0); PG8_MMA(0, 1, At, B1); PG8_BAR; PG8_SCHED;
            PG8_LDA(At, 0, 1); PG8_STAGE(PG8_SB(0, 0), b2, voffB); PG8_STAGE(PG8_SB(0, 1), b2 + hstep, voffB); PG8_STAGE(PG8_SA(0, 0), a2, voffA);
            PG8_WAIT_V(8); PG8_WAIT_L(0); PG8_BAR; PG8_MMA(1, 0, At, B0); PG8_MMA(1, 1, At, B1); PG8_BAR; PG8_SCHED;
            PG8_LDB(B0, 1, 0); PG8_LDB(B1, 1, 1); PG8_SCHED; PG8_LDA(At, 1, 0); PG8_STAGE(PG8_SA(0, 1), a2 + hstep, voffA);
            PG8_WAIT_V(8); PG8_WAIT_L(0); PG8_BAR; PG8_MMA(0, 0, At, B0); PG8_MMA(0, 1, At, B1); PG8_BAR; PG8_SCHED;
            PG8_LDA(At, 1, 1); PG8_STAGE(PG8_SB(1, 0), b3, voffB); PG8_STAGE(PG8_SB(1, 1), b3 + hstep, voffB); PG8_STAGE(PG8_SA(1, 0), a3, voffA);
            PG8_WAIT_V(8); PG8_WAIT_L(0); PG8_BAR; PG8_MMA(1, 0, At, B0); PG8_MMA(1, 1, At, B1); PG8_BAR; PG8_SCHED;
        }
        if constexpr (ALIGN_EPI) { if (wr == 0) PG8_BAR; }
        const bool keep = E(acc, cur, wr, wc, fr, fq, lane);
#ifdef PROBE_EPI2
        if constexpr (Epi::IDEMP) {
#pragma unroll
            for (int a = 0; a < 2; ++a)
#pragma unroll
                for (int b = 0; b < 2; ++b)
#pragma unroll
                    for (int m = 0; m < 4; ++m)
#pragma unroll
                        for (int n = 0; n < 2; ++n) asm volatile("" : "+v"(acc[a][b][m][n]));
            asm volatile("" ::: "memory");
            (void)E(acc, cur, wr, wc, fr, fq, lane);
        }
#endif
        if (!has_next) break;
        if (!keep) {
#pragma unroll
        for (int a = 0; a < 2; ++a)
#pragma unroll
            for (int b = 0; b < 2; ++b)
#pragma unroll
                for (int m = 0; m < 4; ++m)
#pragma unroll
                    for (int n = 0; n < 2; ++n) acc[a][b][m][n] = (f32x4){0.f, 0.f, 0.f, 0.f};
        E.init(acc, nxt, wr, wc, lane);
        }
        cur = nxt; cA = nA; cB = nB; ++ui;
        if constexpr (ALIGN_EPI) { if (wr == 1) PG8_BAR; }
    }
    PG8_WAIT_V(0);
    if constexpr (!ALIGN_EPI) { if (wr == 0) PG8_BAR; }
    PG8_BAR;
#undef PG8_SA
#undef PG8_SB
#undef PG8_STAGE
#undef PG8_LDA
#undef PG8_LDB
#undef PG8_MMA
#undef PG8_WAIT_V
#undef PG8_WAIT_L
#undef PG8_BAR
#undef PG8_SCHED
#undef PG8_ASEL
#undef PG8_BSEL
}
}

constexpr int NWAVES = 8;
constexpr int BATCH = 2, SEQ = 8192, DM = 1024, M = BATCH * SEQ, DFF = 2816, NLAYER = 2, INW = 10000;
constexpr float NORM_EPS = 1e-6f;
constexpr float LOG2E = 1.4426950408889634f;
constexpr float QSCALE = 0.125f * LOG2E;

constexpr size_t MiB = 1u << 20;
constexpr size_t WS_CTL = 0, CTL_ZERO_BYTES = 64 * 1024;
constexpr size_t WS_SSQ = 1 * MiB;
constexpr size_t WS_COS = 2 * MiB;
constexpr size_t WS_S1 = 6 * MiB;
constexpr size_t WS_S2 = 17 * MiB;
constexpr size_t WS_DC = 22 * MiB + 512 * 1024;
constexpr size_t WS_WG = 23 * MiB;
constexpr size_t WS_WB = 29 * MiB;
constexpr size_t WS_WO = 32 * MiB;
constexpr size_t WS_ACT = 34 * MiB;
constexpr size_t UU = 4 * MiB;
constexpr size_t WS_AQ0 = WS_ACT + 0 * UU, WS_AQ1 = WS_ACT + 4 * UU, WS_AQ2 = WS_ACT + 8 * UU;
constexpr size_t WS_AK0 = WS_ACT + 12 * UU, WS_AV0 = WS_ACT + 24 * UU;
constexpr size_t WS_GATES = WS_ACT + 12 * UU;
constexpr size_t WS_MERGED = WS_ACT + 50 * UU;
constexpr size_t WS_BQ = WS_ACT + 36 * UU, WS_BK = WS_ACT + 40 * UU, WS_BV = WS_ACT + 41 * UU;
constexpr size_t WS_CQ = WS_ACT + 42 * UU, WS_CK = WS_ACT + 44 * UU, WS_CV = WS_ACT + 46 * UU;
constexpr size_t WS_LOGG = WS_ACT + 50 * UU;
constexpr size_t WS_CR = WS_ACT + 52 * UU;
constexpr size_t WS_STATE = WS_ACT + 56 * UU;
constexpr size_t WS_XB = WS_ACT + 60 * UU;
constexpr size_t WS_ACTH = WS_ACT;
constexpr size_t WS_LSE = WS_ACT + 68 * UU;
constexpr size_t WS_END = WS_LSE + 3 * (size_t)M * 8 * 4;
static_assert(WS_S1 + (size_t)2 * DFF * DM * 2 <= WS_S2 && WS_S2 + (size_t)DM * DFF * 2 <= WS_DC && WS_DC + 8 * 128 * 64 * 4 <= WS_WG, "ws map");
static_assert((size_t)M * DFF * 2 <= 22 * UU && (size_t)7168 * 1024 * 2 <= 4 * UU, "ws map 2");
constexpr int CW_TMO = 0, CW_CODE = 1;
constexpr int CW_BAR = 4096;

constexpr int RING_OFF = 0, RING_BYTES = 131072;
constexpr int LDSCTL_OFF = RING_BYTES, MISC_OFF = LDSCTL_OFF + 320;
constexpr int LDS_BYTES = 147456;
constexpr int INTAB_OFF = MISC_OFF + 256;
constexpr int RSTD_OFF = INTAB_OFF + 256;

#define GAS __attribute__((address_space(1)))
#define LAS __attribute__((address_space(3)))
typedef unsigned short bf16;
typedef unsigned v4u __attribute__((ext_vector_type(4)));
typedef unsigned v2u __attribute__((ext_vector_type(2)));
typedef float f32x4 __attribute__((ext_vector_type(4)));
typedef short bf16x8 __attribute__((ext_vector_type(8)));
typedef _Float16 h16x2 __attribute__((ext_vector_type(2)));
typedef GAS unsigned gu32;
#define RLX_AGENT __ATOMIC_RELAXED, __HIP_MEMORY_SCOPE_AGENT
#define LDS_WAIT() asm volatile("s_waitcnt lgkmcnt(0)" ::: "memory")
#define VM_WAIT() asm volatile("s_waitcnt vmcnt(0)" ::: "memory")
__device__ __forceinline__ unsigned f2bf(float f) { unsigned u = __builtin_bit_cast(unsigned, f); return (u + 0x7fffu + ((u >> 16) & 1u)) >> 16; }
__device__ __forceinline__ float h2f16(unsigned short b) { return (float)__builtin_bit_cast(_Float16, b); }
__device__ __forceinline__ float hlo16(unsigned w) { return h2f16((unsigned short)(w & 0xffffu)); }
__device__ __forceinline__ float hhi16(unsigned w) { return h2f16((unsigned short)(w >> 16)); }
__device__ __forceinline__ float h2f(unsigned short b) { return MK_BF16 ? __builtin_bit_cast(float, (unsigned)b << 16) : h2f16(b); }
__device__ __forceinline__ unsigned short f2h(float f) { return MK_BF16 ? (unsigned short)((__builtin_bit_cast(unsigned, f) + 0x7fffu + ((__builtin_bit_cast(unsigned, f) >> 16) & 1u)) >> 16) : __builtin_bit_cast(unsigned short, (_Float16)f); }
__device__ __forceinline__ float hlo(unsigned w) { return h2f((unsigned short)(w & 0xffffu)); }
__device__ __forceinline__ float hhi(unsigned w) { return h2f((unsigned short)(w >> 16)); }
__device__ __forceinline__ unsigned pk2(float lo, float hi) { return pg8::cvt_pk_h(lo, hi); }
__device__ __forceinline__ float bflo(unsigned w) { return __builtin_bit_cast(float, w << 16); }
__device__ __forceinline__ float bfhi(unsigned w) { return __builtin_bit_cast(float, w & 0xffff0000u); }
__device__ __forceinline__ float bf2f(bf16 h) { return __builtin_bit_cast(float, (unsigned)h << 16); }
__device__ __forceinline__ float fexp2(float x) { return __builtin_amdgcn_exp2f(x); }
__device__ __forceinline__ float fexp(float x) { return __builtin_amdgcn_exp2f(x * LOG2E); }
__device__ __forceinline__ float frcp(float x) { return __builtin_amdgcn_rcpf(x); }
__device__ __forceinline__ float sigmoidf_(float x) { return frcp(1.0f + fexp(-x)); }
__device__ __forceinline__ float siluf_(float x) { return x * sigmoidf_(x); }

#define XB_TMO      128
#define XB_XCNT(j)  (256  + 64 * (j))
#define XB_XSUB(j)  (1280 + 64 * (j))
#define XB_XGEN(j)  (2304 + 64 * (j))
#define XB_TOP      3328
#define XB_TOPGEN   3392
#define XCD_BAR_WORDS 3456
#define XB_SPIN_CAP (1u << 18)
__device__ __forceinline__ unsigned xb_ld(unsigned* p)              { return __hip_atomic_load(p, __ATOMIC_RELAXED, __HIP_MEMORY_SCOPE_AGENT); }
__device__ __forceinline__ unsigned xb_add(unsigned* p, unsigned v) { return __hip_atomic_fetch_add(p, v, __ATOMIC_RELAXED, __HIP_MEMORY_SCOPE_AGENT); }
__device__ __forceinline__ unsigned xb_xcc_id() { return (unsigned)__builtin_amdgcn_s_getreg((3 << 11) | 20) & 0xFu; }
#define XB_SPIN(cond, bar) do { unsigned _sp = 0; while (cond) { __builtin_amdgcn_s_sleep(1); \
    if ((++_sp & 255u) == 0u) { if (xb_ld(&(bar)[XB_TMO])) break; if (_sp > XB_SPIN_CAP) { atomicAdd(&(bar)[XB_TMO], 1u); break; } } } } while (0)
struct XcdBarrier { unsigned* bar; unsigned x; volatile LAS unsigned* st; };
__device__ __forceinline__ XcdBarrier xcd_barrier_post(unsigned* bar, volatile LAS unsigned* st) {
    XcdBarrier b; b.bar = bar; b.x = xb_xcc_id(); b.st = st;
    if (threadIdx.x == 0) (void)xb_add(&bar[XB_XCNT(b.x)], 1u);
    return b;
}
__device__ __forceinline__ void xcd_barrier_complete(unsigned* bar, unsigned x, unsigned& nloc, unsigned& nx) {
    const unsigned G = gridDim.x * gridDim.y * gridDim.z;
    unsigned sum, cnt, mine, sp = 0u;
    for (;;) {
        sum = 0u; cnt = 0u; mine = 0u;
#pragma unroll
        for (unsigned j = 0; j < 16; ++j) { const unsigned c = xb_ld(&bar[XB_XCNT(j)]); sum += c; cnt += (c > 0u) ? 1u : 0u; mine = (j == x) ? c : mine; }
        if (sum == G) break;
        __builtin_amdgcn_s_sleep(1);
        if ((++sp & 255u) == 0u) { if (xb_ld(&bar[XB_TMO])) break; if (sp > XB_SPIN_CAP) { atomicAdd(&bar[XB_TMO], 1u); break; } }
    }
    nloc = mine > 0u ? mine : 1u; nx = cnt > 0u ? cnt : 1u;
}
__device__ __forceinline__ void xcd_barrier(const XcdBarrier& b) {
    asm volatile("s_waitcnt vmcnt(0)" ::: "memory");
    __syncthreads();
    if (threadIdx.x == 0) {
        unsigned* bar = b.bar;
        __builtin_amdgcn_s_waitcnt(0);
        unsigned nloc = b.st[0], nx = b.st[1];
        if (nloc == 0u) { xcd_barrier_complete(bar, b.x, nloc, nx); b.st[0] = nloc; b.st[1] = nx; }
        const unsigned old = xb_add(&bar[XB_XSUB(b.x)], 1u);
        const unsigned gen = old / nloc;
        if (old + 1u == (gen + 1u) * nloc) {
            __builtin_amdgcn_fence(__ATOMIC_RELEASE, "agent");
            asm volatile("s_waitcnt vmcnt(0)" ::: "memory");
            const unsigned og = xb_add(&bar[XB_TOP], 1u);
            const unsigned tg = og / nx;
            if (og + 1u == (tg + 1u) * nx) xb_add(&bar[XB_TOPGEN], 1u);
            else XB_SPIN(xb_ld(&bar[XB_TOPGEN]) == tg, bar);
            __builtin_amdgcn_fence(__ATOMIC_ACQUIRE, "agent");
            xb_add(&bar[XB_XGEN(b.x)], 1u);
            asm volatile("s_waitcnt vmcnt(0)" ::: "memory");
        } else {
            XB_SPIN(xb_ld(&bar[XB_XGEN(b.x)]) == gen, bar);
            __builtin_amdgcn_fence(__ATOMIC_ACQUIRE, "agent");
            asm volatile("s_waitcnt vmcnt(0)" ::: "memory");
        }
    }
    __syncthreads();
}

struct Frame {
    LAS unsigned char* lds;
    volatile LAS unsigned* MISC;
    gu32* ctl;
    int tid, lane, wave;
    int vcu, G, bx;
    unsigned char* ws;
    float* X;
};
__device__ __forceinline__ const float* inptr(const Frame& F, int i) {
    const LAS unsigned* t = (const LAS unsigned*)(F.lds + INTAB_OFF); unsigned lo = t[2 * i], hi = t[2 * i + 1];
    lo = __builtin_amdgcn_readfirstlane(lo); hi = __builtin_amdgcn_readfirstlane(hi);
    return (const float*)(const GAS float*)(((unsigned long long)hi << 32) | lo);
}
__device__ __forceinline__ float wave_sum(float v) {
#pragma unroll
    for (int o = 1; o < 64; o <<= 1) v += __shfl_xor(v, o);
    return v;
}
__device__ __forceinline__ float wave_max(float v) {
#pragma unroll
    for (int o = 1; o < 64; o <<= 1) v = fmaxf(v, __shfl_xor(v, o));
    return v;
}

__device__ __forceinline__ unsigned hmin2(unsigned a, unsigned b) { typedef _Float16 hh2 __attribute__((ext_vector_type(2))); const hh2 x = __builtin_bit_cast(hh2, a), y = __builtin_bit_cast(hh2, b); return __builtin_bit_cast(unsigned, __builtin_elementwise_min(x, y)); }
__device__ __forceinline__ unsigned hmax2(unsigned a, unsigned b) { typedef _Float16 hh2 __attribute__((ext_vector_type(2))); const hh2 x = __builtin_bit_cast(hh2, a), y = __builtin_bit_cast(hh2, b); return __builtin_bit_cast(unsigned, __builtin_elementwise_max(x, y)); }
__device__ __forceinline__ void plswap32(float& a, float& b) { asm("s_nop 1\n\tv_permlane32_swap_b32 %0, %1" : "+v"(a), "+v"(b)); }
__device__ __forceinline__ void plswap16(float& a, float& b) { asm("s_nop 1\n\tv_permlane16_swap_b32 %0, %1" : "+v"(a), "+v"(b)); }
__device__ __forceinline__ float xsum32(float v) { float a = v, b = v; plswap32(a, b); return a + b; }
__device__ __forceinline__ float xsum16(float v) { float a = v, b = v; plswap16(a, b); return a + b; }
__device__ __forceinline__ float xmax32(float v) { float a = v, b = v; plswap32(a, b); return fmaxf(a, b); }
namespace pg8 {
__device__ __forceinline__ void load_rstd(const float* ssq, int pm, int wr, int lane, float (&rs)[2][4]) {
    float mine[2];
#pragma unroll
    for (int ai = 0; ai < 2; ++ai) { const f32x4* p = (const f32x4*)(ssq + (size_t)(pm * 256 + ai * 128 + wr * 64 + lane) * 16);
        const f32x4 a = p[0], b = p[1], c = p[2], d = p[3]; const f32x4 s = (a + b) + (c + d);
        mine[ai] = 1.0f / sqrtf(((s[0] + s[1]) + (s[2] + s[3])) * (1.0f / DM) + NORM_EPS); }
#pragma unroll
    for (int ai = 0; ai < 2; ++ai)
#pragma unroll
        for (int m = 0; m < 4; ++m) rs[ai][m] = __shfl(mine[ai], 16 * m + (lane & 15));
}
__device__ __forceinline__ void get_rstd(const PG8_LAS float* rtab, int rpm, const float* ssq, int pm, int wr, int fr, int lane, float (&rs)[2][4]) {
    if (pm == rpm) {
#pragma unroll
        for (int ai = 0; ai < 2; ++ai)
#pragma unroll
            for (int m = 0; m < 4; ++m) rs[ai][m] = rtab[ai * 128 + wr * 64 + m * 16 + fr];
    } else load_rstd(ssq, pm, wr, lane, rs);
}
__device__ __forceinline__ u32x4 pack8(const f32x4& a, const f32x4& b) { u32x4 w; w.x = cvt_pk_h(a[0], a[1]); w.y = cvt_pk_h(a[2], a[3]); w.z = cvt_pk_h(b[0], b[1]); w.w = cvt_pk_h(b[2], b[3]); return w; }
__device__ __forceinline__ u32x4 pack8_bf(const f32x4& a, const f32x4& b) { u32x4 w; w.x = cvt_pk_bf(a[0], a[1]); w.y = cvt_pk_bf(a[2], a[3]); w.z = cvt_pk_bf(b[0], b[1]); w.w = cvt_pk_bf(b[2], b[3]); return w; }

struct RstdPro { f32x4 a, b, c, d; };
struct NoPro {};
__device__ __forceinline__ void rstd_pro_load(RstdPro& p, const float* ssq, int pm, int tid) {
    p.a = p.b = p.c = p.d = (f32x4){0.f, 0.f, 0.f, 0.f};
    if (tid < 256) { const f32x4* q = (const f32x4*)(ssq + (size_t)(pm * 256 + tid) * 16); p.a = q[0]; p.b = q[1]; p.c = q[2]; p.d = q[3]; }
}
__device__ __forceinline__ void rstd_pro_store(const RstdPro& p, const PG8_LAS float* rtab, int tid) {
    if (tid < 256) { const f32x4 s = (p.a + p.b) + (p.c + p.d); ((PG8_LAS float*)rtab)[tid] = 1.0f / sqrtf(((s[0] + s[1]) + (s[2] + s[3])) * (1.0f / DM) + NORM_EPS); }
}
struct EpiSwiglu {
    static constexpr bool PERM = true;
    static constexpr bool IDEMP = true;
    typedef RstdPro Pro;
    __device__ __forceinline__ void pro_load(Pro& p, const Unit& u, int tid) const { rstd_pro_load(p, ssq, u.pm, tid); }
    __device__ __forceinline__ void pro_store(const Pro& p, int tid) const { rstd_pro_store(p, rtab, tid); }
    bf16_t* O; const float* ssq; const PG8_LAS float* rtab; int rpm;
    __device__ __forceinline__ void init(f32x4 (&)[2][2][4][2], const Unit&, int, int, int) const {}
    __device__ __forceinline__ bool operator()(f32x4 (&acc)[2][2][4][2], const Unit& u, int wr, int wc, int fr_, int fq_, int lane_) const {
        int lane = lane_; asm volatile("" : "+v"(lane)); lane &= 63; const int fr = lane & 15, fq = lane >> 4;
        float rs[2][4]; get_rstd(rtab, rpm, ssq, u.pm, wr, fr, lane, rs);
        const int col0 = u.pn * 128 + wc * 32 + 8 * fq;
#pragma unroll
        for (int ai = 0; ai < 2; ++ai)
#pragma unroll
            for (int m = 0; m < 4; ++m) { const float r = rs[ai][m]; const size_t row = (size_t)(u.pm * BM + ai * HALF + wr * 64 + m * 16 + fr);
                f32x4 o[2]; const float r2 = r * (-LOG2E), rr = r * r;
#pragma unroll
                for (int n = 0; n < 2; ++n) { const f32x4 g = acc[ai][0][m][n], t = g * r2; f32x4 e, s;
#pragma unroll
                    for (int j = 0; j < 4; ++j) e[j] = fexp2(t[j]);
                    const f32x4 d = e + 1.0f;
#pragma unroll
                    for (int j = 0; j < 4; ++j) s[j] = frcp(d[j]);
                    o[n] = (g * acc[ai][1][m][n]) * (s * rr); }
                *(u32x4*)(O + row * DFF + col0) = pack8(o[0], o[1]); }
        return false;
    }
};
struct EpiResidual {
    static constexpr bool PERM = true;
    static constexpr bool IDEMP = true;
    typedef NoPro Pro;
    __device__ __forceinline__ void pro_load(Pro&, const Unit&, int) const {}
    __device__ __forceinline__ void pro_store(const Pro&, int) const {}
    float* Xout; bf16_t* XB; float* ssq; float scale, inv_scale;
    __device__ __forceinline__ void init(f32x4 (&acc)[2][2][4][2], const Unit& u, int wr, int wc, int lane_) const {
        int lane = lane_; asm volatile("" : "+v"(lane)); lane &= 63; const int fr = lane & 15, fq = lane >> 4;
        const int col0 = u.pn * BM + wc * 32 + 8 * fq;
#pragma unroll
        for (int ai = 0; ai < 2; ++ai)
#pragma unroll
            for (int m = 0; m < 4; ++m) { const bf16_t* xr = XB + (size_t)(u.pm * BM + ai * HALF + wr * 64 + m * 16 + fr) * DM + col0;
#pragma unroll
                for (int bj = 0; bj < 2; ++bj) { const u32x4 w = *(const u32x4*)(xr + bj * HALF);
                    acc[ai][bj][m][0] = (f32x4){hlo(w.x), hhi(w.x), hlo(w.y), hhi(w.y)} * inv_scale; acc[ai][bj][m][1] = (f32x4){hlo(w.z), hhi(w.z), hlo(w.w), hhi(w.w)} * inv_scale; }
                if (m & 1) asm volatile("" ::: "memory"); }
    }
    __device__ __forceinline__ bool operator()(f32x4 (&acc)[2][2][4][2], const Unit& u, int wr, int wc, int fr_, int fq_, int lane_) const {
        int lane = lane_; asm volatile("" : "+v"(lane)); lane &= 63; const int fr = lane & 15, fq = lane >> 4;
        const int col0 = u.pn * BM + wc * 32 + 8 * fq;
#pragma unroll
        for (int ai = 0; ai < 2; ++ai)
#pragma unroll
            for (int m = 0; m < 4; ++m) { const size_t row = (size_t)(u.pm * BM + ai * HALF + wr * 64 + m * 16 + fr); float q = 0.f;
#pragma unroll
                for (int bj = 0; bj < 2; ++bj) {
                    const f32x4 x0 = acc[ai][bj][m][0] * scale, x1 = acc[ai][bj][m][1] * scale;
                    if (Xout) { float* xp = Xout + row * DM + col0 + bj * HALF; *(f32x4*)xp = x0; *(f32x4*)(xp + 4) = x1; }
                    q += (x0[0] * x0[0] + x0[1] * x0[1]) + (x0[2] * x0[2] + x0[3] * x0[3]) + (x1[0] * x1[0] + x1[1] * x1[1]) + (x1[2] * x1[2] + x1[3] * x1[3]);
                    if (!Xout) *(u32x4*)(XB + row * DM + col0 + bj * HALF) = pack8(x0, x1); }
                if (!Xout) { q = xsum32(xsum16(q));
                    if (fq == 0) ssq[row * 16 + u.pn * 4 + wc] = q; } }
        return false;
    }
};
struct EpiSigmoid {
    static constexpr bool PERM = true;
    static constexpr bool IDEMP = true;
    typedef RstdPro Pro;
    __device__ __forceinline__ void pro_load(Pro& p, const Unit& u, int tid) const { rstd_pro_load(p, ssq, u.pm, tid); }
    __device__ __forceinline__ void pro_store(const Pro& p, int tid) const { rstd_pro_store(p, rtab, tid); }
    bf16_t* O; const float* ssq; const PG8_LAS float* rtab; int rpm;
    __device__ __forceinline__ void init(f32x4 (&)[2][2][4][2], const Unit&, int, int, int) const {}
    __device__ __forceinline__ bool operator()(f32x4 (&acc)[2][2][4][2], const Unit& u, int wr, int wc, int fr_, int fq_, int lane_) const {
        int lane = lane_; asm volatile("" : "+v"(lane)); lane &= 63; const int fr = lane & 15, fq = lane >> 4;
        float rs[2][4]; get_rstd(rtab, rpm, ssq, u.pm, wr, fr, lane, rs);
        bf16_t* base = O + (size_t)(u.pn >> 2) * M * DM + (u.pn & 3) * 256 + wc * 32 + 8 * fq;
        const bool recip = (u.pn >> 2) != 0;
#pragma unroll
        for (int ai = 0; ai < 2; ++ai)
#pragma unroll
            for (int m = 0; m < 4; ++m) { const float r = rs[ai][m]; const size_t row = (size_t)(u.pm * BM + ai * HALF + wr * 64 + m * 16 + fr);
#pragma unroll
                for (int bj = 0; bj < 2; ++bj) { f32x4 o[2]; const float r2 = r * (-LOG2E);
#pragma unroll
                    for (int n = 0; n < 2; ++n) { const f32x4 t = acc[ai][bj][m][n] * r2; f32x4 e;
#pragma unroll
                        for (int j = 0; j < 4; ++j) e[j] = fexp2(t[j]);
                        const f32x4 d = e + 1.0f;
                        if (recip) { o[n] = d; } else {
#pragma unroll
                        for (int j = 0; j < 4; ++j) o[n][j] = frcp(d[j]); } }
                    u32x4 w = pack8(o[0], o[1]);
                    if (recip) { w.x = hmin2(w.x, 0x7BFF7BFFu); w.y = hmin2(w.y, 0x7BFF7BFFu); w.z = hmin2(w.z, 0x7BFF7BFFu); w.w = hmin2(w.w, 0x7BFF7BFFu); }
                    else { w.x = hmax2(w.x, 0x00010001u); w.y = hmax2(w.y, 0x00010001u); w.z = hmax2(w.z, 0x00010001u); w.w = hmax2(w.w, 0x00010001u); }
                    *(u32x4*)(base + row * DM + bj * HALF) = w; } }
        return false;
    }
};
struct EpiMerge {
    static constexpr bool PERM = true;
    static constexpr bool IDEMP = false;
    typedef NoPro Pro;
    __device__ __forceinline__ void pro_load(Pro&, const Unit&, int) const {}
    __device__ __forceinline__ void pro_store(const Pro&, int) const {}
    const bf16_t* GT; bf16_t* O;
    __device__ __forceinline__ void init(f32x4 (&)[2][2][4][2], const Unit&, int, int, int) const {}
    __device__ __forceinline__ void fetch(const bf16_t* g, const Unit& u, int ai, int wr, int col0, int fr, u32x4 (&t)[4][2]) const {
#pragma unroll
        for (int m = 0; m < 4; ++m)
#pragma unroll
            for (int bj = 0; bj < 2; ++bj) t[m][bj] = *(const u32x4*)(g + (size_t)(u.pm * BM + ai * HALF + wr * 64 + m * 16 + fr) * DM + col0 + bj * HALF);
    }
    __device__ __forceinline__ bool operator()(f32x4 (&acc)[2][2][4][2], const Unit& u, int wr, int wc, int fr_, int fq_, int lane_) const {
        int lane = lane_; asm volatile("" : "+v"(lane)); lane &= 63; const int fr = lane & 15, fq = lane >> 4;
        const int col0 = u.pn * BM + wc * 32 + 8 * fq; const int s = u.seg;
#pragma unroll
        for (int ai = 0; ai < 2; ++ai) {
            u32x4 t[4][2], t2[4][2];
            fetch(GT + (size_t)s * M * DM, u, ai, wr, col0, fr, t);
            if (s < 2) fetch(GT + (size_t)(s + 1) * M * DM, u, ai, wr, col0, fr, t2);
#pragma unroll
            for (int m = 0; m < 4; ++m)
#pragma unroll
                for (int bj = 0; bj < 2; ++bj) { const u32x4 a = t[m][bj];
                    const float ga[8] = {hlo(a.x), hhi(a.x), hlo(a.y), hhi(a.y), hlo(a.z), hhi(a.z), hlo(a.w), hhi(a.w)};
                    if (s == 0) {
#pragma unroll
                    for (int e = 0; e < 8; ++e) acc[ai][bj][m][e >> 2][e & 3] *= ga[e]; } else {
#pragma unroll
                    for (int e = 0; e < 8; ++e) acc[ai][bj][m][e >> 2][e & 3] *= frcp(ga[e]); } }
            if (s < 2) {
#pragma unroll
                for (int m = 0; m < 4; ++m)
#pragma unroll
                    for (int bj = 0; bj < 2; ++bj) { const u32x4 a = t2[m][bj];
                        const float gb[8] = {hlo(a.x), hhi(a.x), hlo(a.y), hhi(a.y), hlo(a.z), hhi(a.z), hlo(a.w), hhi(a.w)};
#pragma unroll
                        for (int e = 0; e < 8; ++e) acc[ai][bj][m][e >> 2][e & 3] *= gb[e]; }
            } else {
#pragma unroll
                for (int m = 0; m < 4; ++m)
#pragma unroll
                    for (int bj = 0; bj < 2; ++bj) *(u32x4*)(O + (size_t)(u.pm * BM + ai * HALF + wr * 64 + m * 16 + fr) * DM + col0 + bj * HALF) = pack8(acc[ai][bj][m][0], acc[ai][bj][m][1]);
            }
            asm volatile("" ::: "memory");
        }
        return s < 2;
    }
};
struct EpiInProj {
    static constexpr bool PERM = true;
    static constexpr bool IDEMP = true;
    typedef RstdPro Pro;
    __device__ __forceinline__ void pro_load(Pro& p, const Unit& u, int tid) const { rstd_pro_load(p, ssq, u.pm, tid); }
    __device__ __forceinline__ void pro_store(const Pro& p, int tid) const { rstd_pro_store(p, rtab, tid); }
    unsigned char* ws; const float* ssq; const bf16_t* rope; const PG8_LAS float* rtab; int rpm;
    const float* aq_n; const float* ak_n; const float* bq_n; const float* bk_n; const float* gbias;
    __device__ __forceinline__ void init(f32x4 (&)[2][2][4][2], const Unit&, int, int, int) const {}
    __device__ __forceinline__ bool operator()(f32x4 (&acc)[2][2][4][2], const Unit& u, int wr, int wc, int fr_, int fq_, int lane_) const {
        int lane = lane_; asm volatile("" : "+v"(lane)); lane &= 63; const int fr = lane & 15, fq = lane >> 4;
        float rs[2][4]; get_rstd(rtab, rpm, ssq, u.pm, wr, fr, lane, rs);
        const int t = u.pn;
        int mode, pitch, colA, colB; bf16_t* dst; const float* gain = nullptr; float sc = 1.f; bool act = false, asbf = false;
        if (t < 18) { const int w = t / 6, tt = t % 6, g = tt >> 1, hd = ((tt & 1) * 4 + wc) * 64 + 8 * fq;
            dst = (bf16_t*)(ws + (w == 0 ? (g == 0 ? WS_AQ0 : (g == 1 ? WS_AQ1 : WS_AQ2)) : (w == 1 ? WS_AK0 + (size_t)g * 4 * UU : WS_AV0 + (size_t)g * 4 * UU)));
            pitch = 512; colA = hd; colB = hd + 32; mode = (w == 2) ? 1 : 0; gain = (w == 0) ? aq_n : ak_n; sc = (w == 0) ? QSCALE : 1.f; }
        else if (t < 20) { dst = (bf16_t*)(ws + WS_BQ); pitch = 512; colA = ((t - 18) * 4 + wc) * 64 + 8 * fq; colB = colA + 32; mode = 0; gain = bq_n; sc = QSCALE; }
        else if (t == 20) { pitch = 128; colA = (wc & 1) * 64 + 8 * fq; colB = colA + 32;
            if (wc < 2) { dst = (bf16_t*)(ws + WS_BK); mode = 0; gain = bk_n; } else { dst = (bf16_t*)(ws + WS_BV); mode = 1; } }
        else { colA = wc * 32 + 8 * fq; colB = colA + 128; mode = 2;
            if (t == 21) { dst = (bf16_t*)(ws + WS_CQ); pitch = 256; sc = 0.125f; mode = 4; }
            else if (t == 22) { dst = (bf16_t*)(ws + WS_CK); pitch = 256; mode = 4; }
            else if (t < 25) { dst = (bf16_t*)(ws + WS_CV); pitch = 512; colA += (t - 23) * 256; colB += (t - 23) * 256; asbf = true; }
            else if (t == 25) { dst = (bf16_t*)(ws + WS_LOGG); pitch = 256; mode = 3; }
            else { dst = (bf16_t*)(ws + WS_CR); pitch = 512; colA += (t - 26) * 256; colB += (t - 26) * 256; act = true; } }
        if (mode == 0) {
            f32x4 gA[2], gB[2];
#pragma unroll
            for (int n = 0; n < 2; ++n) { gA[n] = *(const f32x4*)(gain + 8 * fq + 4 * n); gB[n] = *(const f32x4*)(gain + 32 + 8 * fq + 4 * n); }
#pragma unroll
            for (int ai = 0; ai < 2; ++ai) {
            u32x4 cw[4], sw[4];
#pragma unroll
            for (int m = 0; m < 4; ++m) { const bf16_t* rp = rope + (size_t)(u.pm * BM + ai * HALF + wr * 64 + m * 16 + fr) * 64 + fq * 16; cw[m] = *(const u32x4*)rp; sw[m] = *(const u32x4*)(rp + 8); }
#pragma unroll
                for (int m = 0; m < 4; ++m) { const float r = rs[ai][m]; const size_t row = (size_t)(u.pm * BM + ai * HALF + wr * 64 + m * 16 + fr);
                    f32x4 a[2], b[2]; float ss = 0.f;
#pragma unroll
                    for (int n = 0; n < 2; ++n) { a[n] = acc[ai][0][m][n]; b[n] = acc[ai][1][m][n];
                        ss += (a[n][0] * a[n][0] + a[n][1] * a[n][1]) + (a[n][2] * a[n][2] + a[n][3] * a[n][3]) + (b[n][0] * b[n][0] + b[n][1] * b[n][1]) + (b[n][2] * b[n][2] + b[n][3] * b[n][3]); }
                    ss = xsum32(xsum16(ss));
                    const float rn = r * sc * __builtin_amdgcn_rsqf(ss * (r * r) * (1.0f / 64.0f) + NORM_EPS);
                    const u32x4 cq = cw[m], sq = sw[m];
                    const f32x4 cs[2] = {(f32x4){hlo16(cq.x), hhi16(cq.x), hlo16(cq.y), hhi16(cq.y)}, (f32x4){hlo16(cq.z), hhi16(cq.z), hlo16(cq.w), hhi16(cq.w)}};
                    const f32x4 sn[2] = {(f32x4){hlo16(sq.x), hhi16(sq.x), hlo16(sq.y), hhi16(sq.y)}, (f32x4){hlo16(sq.z), hhi16(sq.z), hlo16(sq.w), hhi16(sq.w)}};
                    f32x4 oa[2], ob[2];
#pragma unroll
                    for (int n = 0; n < 2; ++n) { const f32x4 y1 = a[n] * (gA[n] * rn), y2 = b[n] * (gB[n] * rn);
                        oa[n] = y1 * cs[n] - y2 * sn[n]; ob[n] = y2 * cs[n] + y1 * sn[n]; }
                    *(u32x4*)(dst + row * pitch + colA) = pack8(oa[0], oa[1]); *(u32x4*)(dst + row * pitch + colB) = pack8(ob[0], ob[1]); }
            asm volatile("" ::: "memory"); }
        } else if (mode == 3) {
            f32x4 bA[2], bB[2];
#pragma unroll
            for (int n = 0; n < 2; ++n) { bA[n] = *(const f32x4*)(gbias + colA + 4 * n); bB[n] = *(const f32x4*)(gbias + colB + 4 * n); }
#pragma unroll
            for (int ai = 0; ai < 2; ++ai)
#pragma unroll
                for (int m = 0; m < 4; ++m) { const float r = rs[ai][m]; const size_t row = (size_t)(u.pm * BM + ai * HALF + wr * 64 + m * 16 + fr);
#pragma unroll
                    for (int bj = 0; bj < 2; ++bj) { float v[8];
#pragma unroll
                        for (int e = 0; e < 8; ++e) { const float x = acc[ai][bj][m][e >> 2][e & 3] * r + (bj == 0 ? bA[e >> 2][e & 3] : bB[e >> 2][e & 3]);
                            v[e] = (fminf(x, 0.f) - __builtin_amdgcn_logf(1.0f + fexp(-fabsf(x))) * 0.6931471805599453f) * (1.0f / 16.0f); }
                        u32x4 w; { h16x2 p0 = {(_Float16)v[0], (_Float16)v[1]}, p1 = {(_Float16)v[2], (_Float16)v[3]}, p2 = {(_Float16)v[4], (_Float16)v[5]}, p3 = {(_Float16)v[6], (_Float16)v[7]};
                            w.x = __builtin_bit_cast(unsigned, p0); w.y = __builtin_bit_cast(unsigned, p1); w.z = __builtin_bit_cast(unsigned, p2); w.w = __builtin_bit_cast(unsigned, p3); }
                        *(u32x4*)(dst + row * pitch + (bj == 0 ? colA : colB)) = w; } }
        } else if (mode == 4) {
#pragma unroll
            for (int ai = 0; ai < 2; ++ai)
#pragma unroll
                for (int m = 0; m < 4; ++m) { const float r = rs[ai][m] * sc; const size_t row = (size_t)(u.pm * BM + ai * HALF + wr * 64 + m * 16 + fr);
#pragma unroll
                    for (int bj = 0; bj < 2; ++bj) { float v[8];
#pragma unroll
                        for (int e = 0; e < 8; ++e) v[e] = acc[ai][bj][m][e >> 2][e & 3] * r;
                        u32x4 w; { h16x2 p0 = {(_Float16)v[0], (_Float16)v[1]}, p1 = {(_Float16)v[2], (_Float16)v[3]}, p2 = {(_Float16)v[4], (_Float16)v[5]}, p3 = {(_Float16)v[6], (_Float16)v[7]};
                            w.x = __builtin_bit_cast(unsigned, p0); w.y = __builtin_bit_cast(unsigned, p1); w.z = __builtin_bit_cast(unsigned, p2); w.w = __builtin_bit_cast(unsigned, p3); }
                        *(u32x4*)(dst + row * pitch + (bj == 0 ? colA : colB)) = w; } }
        } else {
#pragma unroll
            for (int ai = 0; ai < 2; ++ai)
#pragma unroll
                for (int m = 0; m < 4; ++m) { const float r = rs[ai][m] * sc; const size_t row = (size_t)(u.pm * BM + ai * HALF + wr * 64 + m * 16 + fr);
#pragma unroll
                    for (int bj = 0; bj < 2; ++bj) { f32x4 o[2];
#pragma unroll
                        for (int n = 0; n < 2; ++n) { o[n] = acc[ai][bj][m][n] * r;
                            if (act) {
#pragma unroll
                                for (int j = 0; j < 4; ++j) o[n][j] = siluf_(o[n][j]); } }
                        *(u32x4*)(dst + row * pitch + (bj == 0 ? colA : colB)) = asbf ? pack8_bf(o[0], o[1]) : pack8(o[0], o[1]); } }
        }
        return false;
    }
};
}

__constant__ float ROPE_INV[32] = {
    1.000000000e+00f, 7.498942614e-01f, 5.623413324e-01f, 4.216965139e-01f, 3.162277639e-01f, 2.371373773e-01f, 1.778279394e-01f, 1.333521307e-01f,
    1.000000015e-01f, 7.498941571e-02f, 5.623413250e-02f, 4.216965288e-02f, 3.162277490e-02f, 2.371373773e-02f, 1.778279431e-02f, 1.333521493e-02f,
    9.999999776e-03f, 7.498941850e-03f, 5.623413250e-03f, 4.216964822e-03f, 3.162277630e-03f, 2.371373586e-03f, 1.778279431e-03f, 1.333521446e-03f,
    1.000000047e-03f, 7.498942432e-04f, 5.623413017e-04f, 4.216965172e-04f, 3.162277571e-04f, 2.371373703e-04f, 1.778279402e-04f, 1.333521504e-04f};

struct ConvJob { const float* W; int ldw; int K; bf16* WT; int nrows; const float* gain; int mode; int base; const float* gate_up; };
__device__ __forceinline__ int conv_src0(int mode, int base, int n0) {
    if (mode == 0) return base + n0;
    const int t = n0 >> 8, c = n0 & 255;
    if (mode == 1) return c < 128 ? t * 128 + c : DFF + t * 128 + (c - 128);
    const int bj = c >> 7, wc = (c >> 5) & 3;
    if (t < 18) return (t / 6) * 1536 + (4 * (t % 6) + wc) * 64 + 32 * bj;
    if (t < 20) return 4608 + (4 * (t - 18) + wc) * 64 + 32 * bj;
    if (t == 20) return 5120 + wc * 64 + 32 * bj;
    if (t == 21) return 5376 + c;
    if (t == 22) return 5632 + c;
    if (t < 25) return 5888 + 256 * (t - 23) + c;
    if (t == 25) return -1;
    return 6416 + 256 * (t - 26) + c;
}
struct ConvRegs { f32x4 v[8]; int n0, kr, c; };
__device__ __forceinline__ void conv_load(const ConvJob& J, int item, int lane, ConvRegs& R) {
    const int nblk = J.nrows / 32, kb = item / nblk, nb = item % nblk, k0 = 64 * kb, n0 = 32 * nb;
    const int src0 = conv_src0(J.mode, J.base, n0), g = lane >> 3, c = lane & 7, kr = k0 + 8 * g;
    R.n0 = n0; R.kr = kr; R.c = c;
    if (src0 >= 0) {
        const float* wp = J.W + (size_t)kr * J.ldw + src0 + 4 * c;
#pragma unroll
        for (int i = 0; i < 8; ++i) R.v[i] = __builtin_nontemporal_load((const f32x4*)(wp + (size_t)i * J.ldw));
    } else {
        f32x4 ug[16];
#pragma unroll
        for (int r = 0; r < 16; ++r) ug[r] = *(const f32x4*)(J.gate_up + r * 256 + (n0 & 255) + 4 * c);
#pragma unroll
        for (int i = 0; i < 8; ++i) { const f32x4* wr = (const f32x4*)(J.W + (size_t)(kr + i) * J.ldw + 6400); f32x4 s = {0.f, 0.f, 0.f, 0.f};
#pragma unroll
            for (int q = 0; q < 4; ++q) { const f32x4 w4 = wr[q]; s += ug[4 * q + 0] * w4[0]; s += ug[4 * q + 1] * w4[1]; s += ug[4 * q + 2] * w4[2]; s += ug[4 * q + 3] * w4[3]; }
            R.v[i] = s; }
    }
}
__device__ __forceinline__ void conv_store(const ConvJob& J, ConvRegs& R) {
    if (J.gain) { const f32x4 g0 = *(const f32x4*)(J.gain + R.kr), g1 = *(const f32x4*)(J.gain + R.kr + 4);
#pragma unroll
        for (int i = 0; i < 4; ++i) { R.v[i] = R.v[i] * g0[i]; R.v[4 + i] = R.v[4 + i] * g1[i]; } }
#pragma unroll
    for (int j = 0; j < 4; ++j) { v4u o; o.x = pk2(R.v[0][j], R.v[1][j]); o.y = pk2(R.v[2][j], R.v[3][j]); o.z = pk2(R.v[4][j], R.v[5][j]); o.w = pk2(R.v[6][j], R.v[7][j]);
        *(GAS v4u*)(J.WT + (size_t)(R.n0 + 4 * R.c + j) * J.K + R.kr) = o; }
}
__device__ __forceinline__ void conv_job(Frame& F, const ConvJob& J) {
    const int gw = F.vcu * NWAVES + F.wave, NGW = F.G * NWAVES, nitems = (J.nrows / 32) * (J.K / 64);
    for (int it = gw; it < nitems; it += 2 * NGW) {
        ConvRegs A, B; conv_load(J, it, F.lane, A);
        const bool two = it + NGW < nitems; if (two) conv_load(J, it + NGW, F.lane, B);
        conv_store(J, A); if (two) conv_store(J, B);
    }
}
__device__ __forceinline__ void conv_set(Frame& F, int set, int l) {
    if (set == 0 || set == 4) { ConvJob J{inptr(F, set == 0 ? 3 : 18) + (size_t)l * DM * 2 * DFF, 2 * DFF, DM, (bf16*)(F.ws + WS_S1), 2 * DFF, inptr(F, set == 0 ? 2 : 17) + (size_t)l * DM, 1, 0, nullptr}; conv_job(F, J); }
    else if (set == 1 || set == 5) { ConvJob J{inptr(F, set == 1 ? 4 : 19) + (size_t)l * DFF * DM, DM, DFF, (bf16*)(F.ws + WS_S2), DM, nullptr, 0, 0, nullptr}; conv_job(F, J); }
    else if (set == 2) { ConvJob J{inptr(F, 6) + (size_t)l * DM * INW, INW, DM, (bf16*)(F.ws + WS_STATE), 7168, inptr(F, 5) + (size_t)l * DM, 2, 0, inptr(F, 12) + (size_t)l * 16 * 256}; conv_job(F, J); }
    else {
        { ConvJob J{inptr(F, 6) + (size_t)l * DM * INW, INW, DM, (bf16*)(F.ws + WS_WG), 3072, inptr(F, 5) + (size_t)l * DM, 0, 6928, nullptr}; conv_job(F, J); }
        for (int i = 0; i < 3; ++i) { ConvJob J{inptr(F, 15) + ((size_t)l * 3 + i) * 512 * DM, DM, 512, (bf16*)(F.ws + WS_WB) + (size_t)i * DM * 512, DM, nullptr, 0, 0, nullptr}; conv_job(F, J); }
        { ConvJob J{inptr(F, 16) + (size_t)l * DM * DM, DM, DM, (bf16*)(F.ws + WS_WO), DM, nullptr, 0, 0, nullptr}; conv_job(F, J); }
    }
}

__device__ __forceinline__ void conv_one(Frame& F, int set, int l, int idx) {
    ConvJob J;
    if (set == 0 || set == 4) J = ConvJob{inptr(F, set == 0 ? 3 : 18) + (size_t)l * DM * 2 * DFF, 2 * DFF, DM, (bf16*)(F.ws + WS_S1), 2 * DFF, inptr(F, set == 0 ? 2 : 17) + (size_t)l * DM, 1, 0, nullptr};
    else if (set == 1 || set == 5) J = ConvJob{inptr(F, set == 1 ? 4 : 19) + (size_t)l * DFF * DM, DM, DFF, (bf16*)(F.ws + WS_S2), DM, nullptr, 0, 0, nullptr};
    else if (set == 2) J = ConvJob{inptr(F, 6) + (size_t)l * DM * INW, INW, DM, (bf16*)(F.ws + WS_STATE), 7168, inptr(F, 5) + (size_t)l * DM, 2, 0, inptr(F, 12) + (size_t)l * 16 * 256};
    else if (idx < 1536) J = ConvJob{inptr(F, 6) + (size_t)l * DM * INW, INW, DM, (bf16*)(F.ws + WS_WG), 3072, inptr(F, 5) + (size_t)l * DM, 0, 6928, nullptr};
    else if (idx < 2304) { const int i = (idx - 1536) >> 8; idx = (idx - 1536) & 255; J = ConvJob{inptr(F, 15) + ((size_t)l * 3 + i) * 512 * DM, DM, 512, (bf16*)(F.ws + WS_WB) + (size_t)i * DM * 512, DM, nullptr, 0, 0, nullptr}; }
    else { idx -= 2304; J = ConvJob{inptr(F, 16) + (size_t)l * DM * DM, DM, DM, (bf16*)(F.ws + WS_WO), DM, nullptr, 0, 0, nullptr}; }
    ConvRegs R; conv_load(J, idx, F.lane, R); conv_store(J, R);
}
constexpr int CONV_N0 = 2816, CONV_N1 = 1408, CONV_N2 = 3584, CONV_N3 = 2816;
__device__ __forceinline__ void shadow_conv(Frame& F, int ph) {
    const int slot = F.vcu * (NWAVES - 1) + (F.wave - 1), nslot = F.G * (NWAVES - 1);
    int set = -1, l = 0, j = 0, nb = 2;
    switch (ph) {
        case 2:  set = 3; l = 0; j = 0; break;          case 3:  set = 3; l = 0; j = 1; break;
        case 11: set = 3; l = 1; j = 0; break;          case 12: set = 3; l = 1; j = 1; break;
        case 4:  set = 4; l = 0; j = 0; break;          case 5:  set = 4; l = 0; j = 1; break;
        case 6:  set = 5; l = 0; j = 0; nb = 1; break;
        case 13: set = 4; l = 1; j = 0; break;          case 14: set = 4; l = 1; j = 1; break;
        case 15: set = 5; l = 1; j = 0; nb = 1; break;
        default: break; }
    if (set < 0 || l >= NLAYER) return;
    const int n = (set == 2) ? CONV_N2 : (set == 3 ? CONV_N3 : (set == 4 ? CONV_N0 : CONV_N1)), quota = (n + nb - 1) / nb, lo = j * quota, hi = (lo + quota < n) ? lo + quota : n;
    for (int v = lo + slot; v < hi; v += nslot) conv_one(F, set, l, v);
}

__device__ __forceinline__ void tail_conv_set(Frame& F, int set, int l, int n, int idle_idx, int n_idle) {
    for (int it = idle_idx * NWAVES + F.wave; it < n; it += n_idle * NWAVES) conv_one(F, set, l, it);
}
__device__ __forceinline__ void tail_conv(Frame& F, int ph, int idle_idx, int n_idle) {
    if (ph == 1) { tail_conv_set(F, 1, 0, CONV_N1, idle_idx, n_idle); tail_conv_set(F, 2, 0, CONV_N2, idle_idx, n_idle); }
    else if (ph == 9 && NLAYER > 1) { tail_conv_set(F, 2, 1, CONV_N2, idle_idx, n_idle); }
    else if (ph == 11) { tail_conv_set(F, 1, 1, CONV_N1, idle_idx, n_idle); }
}

__device__ __forceinline__ void p0_rows(Frame& F) {
    const int gw = F.vcu * NWAVES + F.wave, NGW = F.G * NWAVES;
    const float* x = inptr(F, 0); const int* pos = (const int*)inptr(F, 1);
    bf16* XB = (bf16*)(F.ws + WS_XB); float* ssq = (float*)(F.ws + WS_SSQ);
    for (int m0 = gw; m0 < M; m0 += 4 * NGW) {
        f32x4 v[4][4];
#pragma unroll
        for (int q = 0; q < 4; ++q) { const int m = m0 + q * NGW; if (m < M) { const GAS f32x4* xr = (const GAS f32x4*)(x + (size_t)m * DM) + F.lane;
#pragma unroll
                for (int j = 0; j < 4; ++j) v[q][j] = __builtin_nontemporal_load(xr + 64 * j); } }
#pragma unroll
        for (int q = 0; q < 4; ++q) { const int m = m0 + q * NGW; if (m >= M) break;
            GAS v2u* o8 = (GAS v2u*)(XB + (size_t)m * DM) + F.lane; float s = 0.f;
#pragma unroll
            for (int j = 0; j < 4; ++j) { const f32x4 t = v[q][j]; s += (t.x * t.x + t.y * t.y) + (t.z * t.z + t.w * t.w);
                v2u w; w.x = pk2(t.x, t.y); w.y = pk2(t.z, t.w); o8[64 * j] = w; }
            s = wave_sum(s);
            if (F.lane < 16) ssq[(size_t)m * 16 + F.lane] = (F.lane == 0) ? s : 0.f;
            if (F.lane < 32) { const float ang = (float)pos[m] * ROPE_INV[F.lane];
                const double rev = (double)ang * 0.15915494309189535; const float fr = (float)(rev - __builtin_rint(rev));
                bf16* rp = (bf16*)(F.ws + WS_COS) + (size_t)m * 64 + (F.lane >> 3) * 16 + (F.lane & 7);
                rp[0] = __builtin_bit_cast(unsigned short, (_Float16)__builtin_amdgcn_cosf(fr)); rp[8] = __builtin_bit_cast(unsigned short, (_Float16)__builtin_amdgcn_sinf(fr)); } }
    }
}

typedef float f32x16 __attribute__((ext_vector_type(16)));
typedef _Float16 h16x8 __attribute__((ext_vector_type(8)));
typedef short v4i16_t __attribute__((ext_vector_type(4)));
constexpr int ATT_BIAS_OFF = RSTD_OFF + 2048;
static_assert(ATT_BIAS_OFF + 12288 <= LDS_BYTES && ATT_BIAS_OFF % 16 == 0, "attention mask tables");
constexpr int ATT_K_OFF = 0, ATT_V_OFF = 49152, ATT_OST_OFF = 98304, ATT_SCR_OFF = RSTD_OFF;
struct BandUnit { const bf16* Q; const bf16* K; const bf16* V; bf16* O; float* LSE; int pq, pk, d, q0, win; size_t row0; float sink2; };
__device__ __forceinline__ int crow16(int r, int hi) { return (r & 3) + 8 * (r >> 2) + 4 * hi; }
struct BandRegs { v4u kr[6], vr[6]; bf16x8 qr[4]; };
__device__ __forceinline__ void band_load(Frame& F, const BandUnit& U, BandRegs& R) {
    const int tid = F.tid, c = tid & 7, i32 = F.lane & 31, hi = F.lane >> 5;
#pragma unroll
    for (int i = 0; i < 6; ++i) { const int rr = (tid >> 3) + 64 * i, ci = U.q0 - 128 + rr;
        if (ci >= 0) { const size_t off = (U.row0 + (size_t)ci * U.d) * U.pk + c * 8; R.kr[i] = *(const v4u*)(U.K + off); R.vr[i] = *(const v4u*)(U.V + off); }
        else { R.kr[i] = (v4u){0u, 0u, 0u, 0u}; R.vr[i] = (v4u){0u, 0u, 0u, 0u}; } }
    const size_t qtok = U.row0 + (size_t)(U.q0 + 32 * F.wave + i32) * U.d;
#pragma unroll
    for (int ks = 0; ks < 4; ++ks) R.qr[ks] = *(const bf16x8*)(U.Q + qtok * U.pq + 16 * ks + 8 * hi);
}
__device__ __forceinline__ void band_unit(Frame& F, const BandUnit& U, BandRegs& R, bool has_next, const BandUnit& Un, BandRegs& Rn) {
    const int tid = F.tid, lane = F.lane, w = F.wave, i32 = lane & 31, hi = lane >> 5;
    LAS unsigned char* lds = F.lds;
    { const int c = tid & 7;
#pragma unroll
        for (int i = 0; i < 6; ++i) { const int rr = (tid >> 3) + 64 * i;
            *(LAS v4u*)(lds + ATT_K_OFF + rr * 128 + ((c ^ (rr & 7)) << 4)) = R.kr[i];
            *(LAS v4u*)(lds + ATT_V_OFF + rr * 128 + ((((c >> 1) ^ (((rr >> 1) & 1) << 1)) << 5) | ((c & 1) << 4))) = R.vr[i]; } }
    const size_t qtok = U.row0 + (size_t)(U.q0 + 32 * w + i32) * U.d;
    __syncthreads();
    if (has_next) band_load(F, Un, Rn);
    f32x16 p[5];
#pragma unroll
    for (int kt = 0; kt < 5; ++kt) { const int row = 32 * w + 32 * kt + i32;
        if (kt == 0 || kt == 4) {
            const LAS f32x4* bt = (const LAS f32x4*)(lds + ATT_BIAS_OFF + (kt == 4 ? 8192 : (U.win == 128 ? 0 : 4096))) + lane;
#pragma unroll
            for (int q4 = 0; q4 < 4; ++q4) { const f32x4 v = bt[q4 * 64]; p[kt][4 * q4 + 0] = v[0]; p[kt][4 * q4 + 1] = v[1]; p[kt][4 * q4 + 2] = v[2]; p[kt][4 * q4 + 3] = v[3]; }
        } else {
#pragma unroll
        for (int r = 0; r < 16; ++r) p[kt][r] = 0.f; }
#pragma unroll
        for (int ks = 0; ks < 4; ++ks) { const bf16x8 kf = *(const LAS bf16x8*)(lds + ATT_K_OFF + row * 128 + (((2 * ks + hi) ^ (row & 7)) << 4));
            p[kt] = MK_BF16 ? __builtin_amdgcn_mfma_f32_32x32x16_bf16(kf, R.qr[ks], p[kt], 0, 0, 0) : __builtin_amdgcn_mfma_f32_32x32x16_f16(__builtin_bit_cast(h16x8, kf), __builtin_bit_cast(h16x8, R.qr[ks]), p[kt], 0, 0, 0); } }
    if (U.q0 == 0 && w < 4) {
#pragma unroll
        for (int kt = 0; kt < 4; ++kt)
#pragma unroll
            for (int r = 0; r < 16; ++r) if (32 * w - 128 + 32 * kt + crow16(r, hi) < 0) p[kt][r] = -INFINITY; }
    float mx = U.sink2;
#pragma unroll
    for (int kt = 0; kt < 5; ++kt)
#pragma unroll
        for (int r = 0; r < 16; ++r) mx = fmaxf(mx, p[kt][r]);
    mx = fmaxf(mx, __shfl_xor(mx, 32));
    float ls = 0.f;
#pragma unroll
    for (int kt = 0; kt < 5; ++kt)
#pragma unroll
        for (int r = 0; r < 16; ++r) { p[kt][r] = fexp2(p[kt][r] - mx); ls += p[kt][r]; }
    ls += __shfl_xor(ls, 32);
    ls += fexp2(U.sink2 - mx);
    f32x16 o[2];
#pragma unroll
    for (int r = 0; r < 16; ++r) { o[0][r] = 0.f; o[1][r] = 0.f; }
    const int q_ = (lane & 15) >> 2;
    const int vbase = ATT_V_OFF + (32 * w + 4 * hi + q_) * 128 + 8 * (lane & 3);
    const int gsw = ((q_ >> 1) & 1) << 1, dh = (lane >> 4) & 1;
#pragma unroll
    for (int kt = 0; kt < 5; ++kt)
#pragma unroll
        for (int s = 0; s < 2; ++s) {
            v4u pw; pw.x = pg8::cvt_pk_h(p[kt][8 * s + 0], p[kt][8 * s + 1]); pw.y = pg8::cvt_pk_h(p[kt][8 * s + 2], p[kt][8 * s + 3]);
            pw.z = pg8::cvt_pk_h(p[kt][8 * s + 4], p[kt][8 * s + 5]); pw.w = pg8::cvt_pk_h(p[kt][8 * s + 6], p[kt][8 * s + 7]);
            const bf16x8 pf = __builtin_bit_cast(bf16x8, pw);
#pragma unroll
            for (int db = 0; db < 2; ++db) { const int a = vbase + (32 * kt + 16 * s) * 128 + ((((2 * db + dh) ^ gsw)) << 5);
                const v4i16_t lo = __builtin_amdgcn_ds_read_tr16_b64_v4i16((LAS v4i16_t*)(lds + a)), hv = __builtin_amdgcn_ds_read_tr16_b64_v4i16((LAS v4i16_t*)(lds + a + 8 * 128));
                const bf16x8 vf = {lo[0], lo[1], lo[2], lo[3], hv[0], hv[1], hv[2], hv[3]};
                o[db] = MK_BF16 ? __builtin_amdgcn_mfma_f32_32x32x16_bf16(pf, vf, o[db], 0, 0, 0) : __builtin_amdgcn_mfma_f32_32x32x16_f16(__builtin_bit_cast(h16x8, pf), __builtin_bit_cast(h16x8, vf), o[db], 0, 0, 0); } }
    LAS float* scr = (LAS float*)(lds + ATT_SCR_OFF) + w * 64;
    if (hi == 0) { scr[i32] = frcp(ls); if (U.LSE) U.LSE[qtok * 8] = mx + __builtin_amdgcn_logf(ls); }
    LDS_WAIT();
    LAS bf16* ost = (LAS bf16*)(lds + ATT_OST_OFF) + w * 2048;
#pragma unroll
    for (int r = 0; r < 16; ++r) { const int qi = crow16(r, hi); const float li = scr[qi];
        ost[qi * 64 + i32] = (bf16)f2h(o[0][r] * li); ost[qi * 64 + 32 + i32] = (bf16)f2h(o[1][r] * li); }
    LDS_WAIT();
#pragma unroll
    for (int i = 0; i < 4; ++i) { const int qi = i * 8 + (lane >> 3), ch = lane & 7; const v4u v = *(const LAS v4u*)(ost + qi * 64 + ch * 8);
        *(v4u*)(U.O + (U.row0 + (size_t)(U.q0 + 32 * w + qi) * U.d) * U.pq + ch * 8) = v; }
    __syncthreads();
}
__device__ __forceinline__ void band_make(Frame& F, int u, const float* sinks, BandUnit& U) {
    if (u < 1536) { const int t32 = u & 31, h = (u >> 5) & 7, g = (u >> 8) % 3, b = u / 768, d = (g == 0) ? 1 : (g == 1 ? 4 : 16), tpc = 32 / d, cls = t32 / tpc;
        bf16* q = (bf16*)(F.ws + (g == 0 ? WS_AQ0 : (g == 1 ? WS_AQ1 : WS_AQ2))) + h * 64;
        U.Q = q; U.O = q; U.K = (const bf16*)(F.ws + WS_AK0 + (size_t)g * 4 * UU) + h * 64; U.V = (const bf16*)(F.ws + WS_AV0 + (size_t)g * 4 * UU) + h * 64;
        U.LSE = (float*)(F.ws + WS_LSE) + (size_t)g * M * 8 + h; U.pq = 512; U.pk = 512; U.d = d; U.q0 = (t32 % tpc) * 256; U.win = 128; U.row0 = (size_t)b * SEQ + cls; U.sink2 = -INFINITY;
    } else { const int ub = u - 1536, t32 = ub & 31, hq = (ub >> 5) & 7, b = ub >> 8;
        bf16* q = (bf16*)(F.ws + WS_BQ) + hq * 64;
        U.Q = q; U.O = q; U.K = (const bf16*)(F.ws + WS_BK) + (hq >> 2) * 64; U.V = (const bf16*)(F.ws + WS_BV) + (hq >> 2) * 64;
        U.LSE = nullptr; U.pq = 512; U.pk = 128; U.d = 1; U.q0 = t32 * 256; U.win = 127; U.row0 = (size_t)b * SEQ; U.sink2 = sinks[hq] * LOG2E; }
}
__device__ __forceinline__ void attn_phase(Frame& F, int l) {
    const float* sinks = inptr(F, 11) + l * 8;
    int u = F.vcu; if (u >= 2048) return;
    BandUnit U, Un; BandRegs R, Rn;
    band_make(F, u, sinks, U); band_load(F, U, R);
    if (F.wave == 0) { const int lane = F.lane, i32 = lane & 31, hi = lane >> 5;
#pragma unroll
        for (int q4 = 0; q4 < 4; ++q4) { f32x4 a, b, c;
#pragma unroll
            for (int e = 0; e < 4; ++e) { const int j = crow16(4 * q4 + e, hi); a[e] = (j < i32) ? -INFINITY : 0.f; b[e] = (j < i32 + 1) ? -INFINITY : 0.f; c[e] = (j > i32) ? -INFINITY : 0.f; }
            LAS f32x4* bt = (LAS f32x4*)(F.lds + ATT_BIAS_OFF) + q4 * 64 + lane; bt[0] = a; bt[256] = b; bt[512] = c; } }
    for (;;) {
        const int nu = u + F.G; const bool has_next = nu < 2048;
        if (has_next) band_make(F, nu, sinks, Un); else Un = U;
        band_unit(F, U, R, has_next, Un, Rn);
        if (!has_next) break;
        U = Un; R = Rn; u = nu;
    }
}
__device__ __forceinline__ void amerge_phase(Frame& F) {
    const float* LSE = (const float*)(F.ws + WS_LSE);
    for (int it = F.vcu * 512 + F.tid; it < M * 64; it += F.G * 512) {
        const int row = it >> 6, h = (it >> 3) & 7, c = it & 7; const size_t off = (size_t)row * 512 + h * 64 + c * 8;
        const float l0 = LSE[(size_t)row * 8 + h], l1 = LSE[(size_t)M * 8 + (size_t)row * 8 + h], l2 = LSE[(size_t)2 * M * 8 + (size_t)row * 8 + h];
        const float mx = fmaxf(l0, fmaxf(l1, l2)); float w0 = fexp2(l0 - mx), w1 = fexp2(l1 - mx), w2 = fexp2(l2 - mx); const float inv = 1.0f / (w0 + w1 + w2); w0 *= inv; w1 *= inv; w2 *= inv;
        const v4u a = __builtin_nontemporal_load((const v4u*)((const bf16*)(F.ws + WS_AQ0) + off)), b = __builtin_nontemporal_load((const v4u*)((const bf16*)(F.ws + WS_AQ1) + off)), cc = __builtin_nontemporal_load((const v4u*)((const bf16*)(F.ws + WS_AQ2) + off));
        v4u o;
        o.x = pk2(w0 * hlo(a.x) + w1 * hlo(b.x) + w2 * hlo(cc.x), w0 * hhi(a.x) + w1 * hhi(b.x) + w2 * hhi(cc.x));
        o.y = pk2(w0 * hlo(a.y) + w1 * hlo(b.y) + w2 * hlo(cc.y), w0 * hhi(a.y) + w1 * hhi(b.y) + w2 * hhi(cc.y));
        o.z = pk2(w0 * hlo(a.z) + w1 * hlo(b.z) + w2 * hlo(cc.z), w0 * hhi(a.z) + w1 * hhi(b.z) + w2 * hhi(cc.z));
        o.w = pk2(w0 * hlo(a.w) + w1 * hlo(b.w) + w2 * hlo(cc.w), w0 * hhi(a.w) + w1 * hhi(b.w) + w2 * hhi(cc.w));
        *(v4u*)((bf16*)(F.ws + WS_AQ0) + off) = o;
    }
}

constexpr int GL_LG = 0, GL_K = 8192, GL_Q = 16384, GL_V = 24576, GL_S = 40960, GL_SCR = 57344;
__device__ __forceinline__ int off128(int row, int col) { return row * 128 + ((((col >> 4) ^ (((row >> 1) & 1) << 1))) << 5) + ((col & 15) << 1); }
__device__ __forceinline__ int off256(int row, int col) { return row * 256 + ((((col >> 4) ^ ((row & 3) << 1))) << 5) + ((col & 15) << 1); }
__device__ __forceinline__ v4i16_t trrd(LAS unsigned char* p) { return __builtin_amdgcn_ds_read_tr16_b64_v4i16((LAS v4i16_t*)p); }
template <bool W256> __device__ __forceinline__ bf16x8 tr_frag(LAS unsigned char* img, int rlo, int rhi, int c0, int lane) {
    const int q = (lane & 15) >> 2, col = c0 + 16 * ((lane >> 4) & 1) + 4 * (lane & 3);
    const v4i16_t lo = trrd(img + (W256 ? off256(rlo + q, col) : off128(rlo + q, col))), hv = trrd(img + (W256 ? off256(rhi + q, col) : off128(rhi + q, col)));
    return (bf16x8){lo[0], lo[1], lo[2], lo[3], hv[0], hv[1], hv[2], hv[3]};
}
__device__ __forceinline__ h16x8 tri_frag(int tok, int ks, int h) {
    h16x8 f;
#pragma unroll
    for (int j = 0; j < 8; ++j) f[j] = (16 * ks + 8 * h + j <= tok) ? (_Float16)1.0f : (_Float16)0.0f;
    return f;
}
__device__ __forceinline__ void split8(const float (&x)[8], bf16x8& hi, bf16x8& lo) {
    v4u h, l;
    h.x = pg8::cvt_pk_bf(x[0], x[1]); h.y = pg8::cvt_pk_bf(x[2], x[3]); h.z = pg8::cvt_pk_bf(x[4], x[5]); h.w = pg8::cvt_pk_bf(x[6], x[7]);
    l.x = pg8::cvt_pk_bf(x[0] - bflo(h.x), x[1] - bfhi(h.x)); l.y = pg8::cvt_pk_bf(x[2] - bflo(h.y), x[3] - bfhi(h.y));
    l.z = pg8::cvt_pk_bf(x[4] - bflo(h.z), x[5] - bfhi(h.z)); l.w = pg8::cvt_pk_bf(x[6] - bflo(h.w), x[7] - bfhi(h.w));
    hi = __builtin_bit_cast(bf16x8, h); lo = __builtin_bit_cast(bf16x8, l);
}
__device__ __forceinline__ void split4(const float (&x)[4], v2u& h, v2u& l) {
    h.x = pg8::cvt_pk_bf(x[0], x[1]); h.y = pg8::cvt_pk_bf(x[2], x[3]);
    l.x = pg8::cvt_pk_bf(x[0] - bflo(h.x), x[1] - bfhi(h.x)); l.y = pg8::cvt_pk_bf(x[2] - bflo(h.y), x[3] - bfhi(h.y));
}
constexpr int GL_TP = 136, GL_QH = 61440, GL_QL = GL_QH + 64 * GL_TP, GL_KH = GL_QL + 64 * GL_TP, GL_KL = GL_KH + 64 * GL_TP;
static_assert(GL_KL + 64 * GL_TP <= 131072, "GLA images");
__device__ __forceinline__ void gla_load64(LAS unsigned char* img, const bf16* src, int pitch, int tid) {
    const int row = tid >> 3, c = tid & 7; *(LAS v4u*)(img + off128(row, 8 * c)) = *(const v4u*)(src + (size_t)row * pitch + 8 * c);
}
__device__ __forceinline__ void gla_load128(LAS unsigned char* img, const bf16* src, int pitch, int tid) {
#pragma unroll
    for (int i = 0; i < 2; ++i) { const int row = (tid >> 4) + 32 * i, c = tid & 15; *(LAS v4u*)(img + off256(row, 8 * c)) = *(const v4u*)(src + (size_t)row * pitch + 8 * c); }
}
__device__ __forceinline__ void gla1_phase(Frame& F) {
    const int tid = F.tid, lane = F.lane, w = F.wave, l31 = lane & 31, hi = lane >> 5, db = w >> 2, eb = w & 3;
    LAS unsigned char* lds = F.lds;
    const bf16* CK = (const bf16*)(F.ws + WS_CK); const bf16* CV = (const bf16*)(F.ws + WS_CV); const bf16* LG = (const bf16*)(F.ws + WS_LOGG);
    bf16* ST = (bf16*)(F.ws + WS_STATE); float* DC = (float*)(F.ws + WS_DC);
    for (int item = F.bx; item < 8 * 128; item += F.G) {
        const int bh = item >> 7, c = item & 127, b = bh >> 2, h = bh & 3; const size_t row0 = (size_t)b * SEQ + c * 64;
        gla_load64(lds + GL_LG, LG + row0 * 256 + h * 64, 256, tid); gla_load64(lds + GL_K, CK + row0 * 256 + h * 64, 256, tid); gla_load128(lds + GL_V, CV + row0 * 512 + h * 128, 512, tid);
        __syncthreads();
        f32x16 bN[2];
#pragma unroll
        for (int tb = 0; tb < 2; ++tb) {
#pragma unroll
            for (int r = 0; r < 16; ++r) bN[tb][r] = 0.f;
#pragma unroll
            for (int ks = 0; ks < 2 * tb + 2; ++ks) { const h16x8 lg = __builtin_bit_cast(h16x8, tr_frag<false>(lds + GL_LG, 16 * ks + 8 * hi, 16 * ks + 8 * hi + 4, 32 * db, lane));
                bN[tb] = __builtin_amdgcn_mfma_f32_32x32x16_f16(tri_frag(32 * tb + l31, ks, hi), lg, bN[tb], 0, 0, 0); } }
        const float bl = __shfl(bN[1][15], 32 + l31);
        f32x16 ut;
#pragma unroll
        for (int r = 0; r < 16; ++r) ut[r] = 0.f;
#pragma unroll
        for (int tb = 0; tb < 2; ++tb) { float kp[16];
#pragma unroll
            for (int g = 0; g < 4; ++g) { const v4i16_t kv = trrd(lds + GL_K + off128(32 * tb + 8 * g + 4 * hi + ((lane & 15) >> 2), 32 * db + 16 * ((lane >> 4) & 1) + 4 * (lane & 3)));
#pragma unroll
                for (int q = 0; q < 4; ++q) kp[4 * g + q] = h2f16((unsigned short)kv[q]) * fexp(bl - bN[tb][4 * g + q]); }
#pragma unroll
            for (int s = 0; s < 2; ++s) { const float x8[8] = {kp[8 * s + 0], kp[8 * s + 1], kp[8 * s + 2], kp[8 * s + 3], kp[8 * s + 4], kp[8 * s + 5], kp[8 * s + 6], kp[8 * s + 7]}; bf16x8 kh, kl; split8(x8, kh, kl);
                const bf16x8 vf = tr_frag<true>(lds + GL_V, 32 * tb + 16 * s + 4 * hi, 32 * tb + 16 * s + 8 + 4 * hi, 32 * eb, lane);
                ut = __builtin_amdgcn_mfma_f32_32x32x16_bf16(vf, kh, ut, 0, 0, 0); ut = __builtin_amdgcn_mfma_f32_32x32x16_bf16(vf, kl, ut, 0, 0, 0); } }
        bf16* dst = ST + ((size_t)item * 64 + 32 * db + l31) * 128 + 32 * eb + 4 * hi;
#pragma unroll
        for (int g = 0; g < 4; ++g) { v2u o; o.x = pg8::cvt_pk_bf(ut[4 * g + 0], ut[4 * g + 1]); o.y = pg8::cvt_pk_bf(ut[4 * g + 2], ut[4 * g + 3]); *(v2u*)(dst + 8 * g) = o; }
        if (eb == 0 && hi == 0) DC[(size_t)item * 64 + 32 * db + l31] = fexp(bl);
        __syncthreads();
    }
}
constexpr int SCAN_DC_OFF = RSTD_OFF;
__device__ __forceinline__ void gla2_phase(Frame& F) {
    bf16* ST = (bf16*)(F.ws + WS_STATE); const float* DC = (const float*)(F.ws + WS_DC);
    const int tid = F.tid; LAS unsigned char* lds = F.lds; LAS float* dct = (LAS float*)(lds + SCAN_DC_OFF);
    for (int item = F.vcu; item < 8 * 32; item += F.G) {
        const int bh = item >> 5, d0 = (item & 31) * 2;
        bf16* base = ST + ((size_t)bh * 128 * 64 + d0) * 128;
        { v4u r[8];
#pragma unroll
            for (int i = 0; i < 8; ++i) { const int q = tid + 512 * i, c = q >> 5, o = (q & 31) * 8; r[i] = __builtin_nontemporal_load((const v4u*)(base + (size_t)c * 64 * 128 + o)); }
#pragma unroll
            for (int i = 0; i < 8; ++i) { const int q = tid + 512 * i; *(LAS v4u*)(lds + q * 16) = r[i]; } }
        if (tid < 256) dct[tid] = DC[((size_t)bh * 128 + (tid >> 1)) * 64 + d0 + (tid & 1)];
        __syncthreads();
        if (tid < 256) { const int dl = tid >> 7; LAS bf16* p = (LAS bf16*)lds + tid; float S = 0.f;
#pragma unroll 8
            for (int c = 0; c < 128; ++c) { const float u = bf2f(p[c * 256]); p[c * 256] = (bf16)f2bf(S); S = dct[c * 2 + dl] * S + u; } }
        __syncthreads();
        { v4u r[8];
#pragma unroll
            for (int i = 0; i < 8; ++i) { const int q = tid + 512 * i; r[i] = *(const LAS v4u*)(lds + q * 16); }
#pragma unroll
            for (int i = 0; i < 8; ++i) { const int q = tid + 512 * i, c = q >> 5, o = (q & 31) * 8; *(v4u*)(base + (size_t)c * 64 * 128 + o) = r[i]; } }
        __syncthreads();
    }
}
__device__ __forceinline__ void gla3_phase(Frame& F, int l) {
    const int tid = F.tid, lane = F.lane, w = F.wave, l31 = lane & 31, hi = lane >> 5, tb = w >> 2, eb = w & 3;
    LAS unsigned char* lds = F.lds;
    const bf16* CQ = (const bf16*)(F.ws + WS_CQ); const bf16* CK = (const bf16*)(F.ws + WS_CK); bf16* CV = (bf16*)(F.ws + WS_CV); const bf16* LG = (const bf16*)(F.ws + WS_LOGG);
    const bf16* CR = (const bf16*)(F.ws + WS_CR); const bf16* ST = (const bf16*)(F.ws + WS_STATE); const float* gain = inptr(F, 14) + l * 128;
    LAS float* scr = (LAS float*)(lds + GL_SCR);
    v4u rlg, rk, rq, rv[2], rs[2];
#define GLA3_FETCH(it_) do { const int bh_ = (it_) >> 7, c_ = (it_) & 127; const size_t r0_ = (size_t)(bh_ >> 2) * SEQ + c_ * 64; const int h_ = bh_ & 3, ra_ = tid >> 3, ca_ = (tid & 7) * 8; \
        rlg = __builtin_nontemporal_load((const v4u*)(LG + (r0_ + ra_) * 256 + h_ * 64 + ca_)); rk = __builtin_nontemporal_load((const v4u*)(CK + (r0_ + ra_) * 256 + h_ * 64 + ca_)); rq = __builtin_nontemporal_load((const v4u*)(CQ + (r0_ + ra_) * 256 + h_ * 64 + ca_)); \
        _Pragma("unroll") for (int i_ = 0; i_ < 2; ++i_) { const int rb_ = (tid >> 4) + 32 * i_, cb_ = (tid & 15) * 8; rv[i_] = __builtin_nontemporal_load((const v4u*)(CV + (r0_ + rb_) * 512 + h_ * 128 + cb_)); rs[i_] = __builtin_nontemporal_load((const v4u*)(ST + (size_t)(it_) * 64 * 128 + rb_ * 128 + cb_)); } } while (0)
    if (F.bx < 8 * 128) GLA3_FETCH(F.bx);
    for (int item = F.bx; item < 8 * 128; item += F.G) {
        const int bh = item >> 7, c = item & 127, b = bh >> 2, h = bh & 3; const size_t row0 = (size_t)b * SEQ + c * 64;
        { const int ra = tid >> 3, ca = (tid & 7) * 8;
            *(LAS v4u*)(lds + GL_LG + off128(ra, ca)) = rlg; *(LAS v4u*)(lds + GL_K + off128(ra, ca)) = rk; *(LAS v4u*)(lds + GL_Q + off128(ra, ca)) = rq;
#pragma unroll
            for (int i = 0; i < 2; ++i) { const int rb = (tid >> 4) + 32 * i, cb = (tid & 15) * 8; *(LAS v4u*)(lds + GL_V + off256(rb, cb)) = rv[i]; *(LAS v4u*)(lds + GL_S + off256(rb, cb)) = rs[i]; } }
        __syncthreads();
        if (item + F.G < 8 * 128) GLA3_FETCH(item + F.G);
        {   const int dbi = w & 1, xb = (w >> 1) & 1, gh = w >> 2, t = 32 * xb + l31;
            f32x16 bt;
#pragma unroll
            for (int r = 0; r < 16; ++r) bt[r] = 0.f;
            for (int ks = 0; ks < 2 * xb + 2; ++ks) { const h16x8 lg = __builtin_bit_cast(h16x8, tr_frag<false>(lds + GL_LG, 16 * ks + 8 * hi, 16 * ks + 8 * hi + 4, 32 * dbi, lane));
                bt = __builtin_amdgcn_mfma_f32_32x32x16_f16(lg, tri_frag(t, ks, hi), bt, 0, 0, 0); }
#pragma unroll
            for (int gg = 0; gg < 2; ++gg) { const int dcol = 32 * dbi + 8 * (2 * gh + gg) + 4 * hi;
                const v2u qa = *(const LAS v2u*)(lds + GL_Q + off128(t, dcol)), ka = *(const LAS v2u*)(lds + GL_K + off128(t, dcol));
                const float qv[4] = {hlo16(qa.x), hhi16(qa.x), hlo16(qa.y), hhi16(qa.y)}, kv[4] = {hlo16(ka.x), hhi16(ka.x), hlo16(ka.y), hhi16(ka.y)}; float qx[4], kx[4];
#pragma unroll
                for (int j = 0; j < 4; ++j) { const float bb = gh == 0 ? bt[4 * gg + j] : bt[8 + 4 * gg + j]; qx[j] = qv[j] * fexp(bb); kx[j] = kv[j] * fexp(-bb); }
                v2u qh, ql2, kh2, kl2; split4(qx, qh, ql2); split4(kx, kh2, kl2);
                const int o = t * GL_TP + dcol * 2;
                *(LAS v2u*)(lds + GL_QH + o) = qh; *(LAS v2u*)(lds + GL_QL + o) = ql2; *(LAS v2u*)(lds + GL_KH + o) = kh2; *(LAS v2u*)(lds + GL_KL + o) = kl2; } }
        __syncthreads();
        bf16x8 qf[2][2], ql[2][2];
#pragma unroll
        for (int dbi = 0; dbi < 2; ++dbi)
#pragma unroll
            for (int s = 0; s < 2; ++s) { const int o = (32 * tb + l31) * GL_TP + (32 * dbi + 16 * s + 4 * hi) * 2;
                const v2u a = *(const LAS v2u*)(lds + GL_QH + o), b2 = *(const LAS v2u*)(lds + GL_QH + o + 16), c = *(const LAS v2u*)(lds + GL_QL + o), d2 = *(const LAS v2u*)(lds + GL_QL + o + 16);
                qf[dbi][s] = __builtin_bit_cast(bf16x8, (v4u){a.x, a.y, b2.x, b2.y}); ql[dbi][s] = __builtin_bit_cast(bf16x8, (v4u){c.x, c.y, d2.x, d2.y}); }
        f32x16 ot;
#pragma unroll
        for (int r = 0; r < 16; ++r) ot[r] = 0.f;
#pragma unroll
        for (int dbi = 0; dbi < 2; ++dbi)
#pragma unroll
            for (int s = 0; s < 2; ++s) { const bf16x8 sf = tr_frag<true>(lds + GL_S, 32 * dbi + 16 * s + 4 * hi, 32 * dbi + 16 * s + 8 + 4 * hi, 32 * eb, lane);
                ot = __builtin_amdgcn_mfma_f32_32x32x16_bf16(sf, qf[dbi][s], ot, 0, 0, 0); ot = __builtin_amdgcn_mfma_f32_32x32x16_bf16(sf, ql[dbi][s], ot, 0, 0, 0); }
#pragma unroll
        for (int sb = 0; sb < 2; ++sb) if (sb <= tb) {
            f32x16 at;
#pragma unroll
            for (int r = 0; r < 16; ++r) at[r] = 0.f;
#pragma unroll
            for (int dbi = 0; dbi < 2; ++dbi)
#pragma unroll
                for (int s = 0; s < 2; ++s) { const int o = (32 * sb + l31) * GL_TP + (32 * dbi + 16 * s + 4 * hi) * 2;
                    const v2u a = *(const LAS v2u*)(lds + GL_KH + o), b2 = *(const LAS v2u*)(lds + GL_KH + o + 16), c = *(const LAS v2u*)(lds + GL_KL + o), d2 = *(const LAS v2u*)(lds + GL_KL + o + 16);
                    const bf16x8 kh = __builtin_bit_cast(bf16x8, (v4u){a.x, a.y, b2.x, b2.y}), kl = __builtin_bit_cast(bf16x8, (v4u){c.x, c.y, d2.x, d2.y});
                    at = __builtin_amdgcn_mfma_f32_32x32x16_bf16(kh, qf[dbi][s], at, 0, 0, 0); at = __builtin_amdgcn_mfma_f32_32x32x16_bf16(kl, qf[dbi][s], at, 0, 0, 0); at = __builtin_amdgcn_mfma_f32_32x32x16_bf16(kh, ql[dbi][s], at, 0, 0, 0); }
            if (sb == tb) {
#pragma unroll
                for (int r = 0; r < 16; ++r) if (crow16(r, hi) > l31) at[r] = 0.f; }
#pragma unroll
            for (int s = 0; s < 2; ++s) { const float x8[8] = {at[8 * s + 0], at[8 * s + 1], at[8 * s + 2], at[8 * s + 3], at[8 * s + 4], at[8 * s + 5], at[8 * s + 6], at[8 * s + 7]}; bf16x8 ph, pl; split8(x8, ph, pl);
                const bf16x8 vf = tr_frag<true>(lds + GL_V, 32 * sb + 16 * s + 4 * hi, 32 * sb + 16 * s + 8 + 4 * hi, 32 * eb, lane);
                ot = __builtin_amdgcn_mfma_f32_32x32x16_bf16(vf, ph, ot, 0, 0, 0); ot = __builtin_amdgcn_mfma_f32_32x32x16_bf16(vf, pl, ot, 0, 0, 0); } }
        float q2 = 0.f;
#pragma unroll
        for (int r = 0; r < 16; ++r) q2 += ot[r] * ot[r];
        q2 = xsum32(q2);
        if (hi == 0) scr[(tb * 4 + eb) * 32 + l31] = q2;
        __syncthreads();
        const float rn = 1.0f / sqrtf(((scr[(tb * 4 + 0) * 32 + l31] + scr[(tb * 4 + 1) * 32 + l31]) + (scr[(tb * 4 + 2) * 32 + l31] + scr[(tb * 4 + 3) * 32 + l31])) * (1.0f / 128.0f) + NORM_EPS);
        const size_t tok = row0 + 32 * tb + l31; const int ecol = h * 128 + 32 * eb + 4 * hi;
#pragma unroll
        for (int g = 0; g < 4; ++g) { const v2u cr = *(const v2u*)(CR + tok * 512 + ecol + 8 * g); const f32x4 gn = *(const f32x4*)(gain + 32 * eb + 4 * hi + 8 * g);
            v2u o; o.x = pg8::cvt_pk_h(ot[4 * g + 0] * rn * gn[0] * hlo(cr.x), ot[4 * g + 1] * rn * gn[1] * hhi(cr.x)); o.y = pg8::cvt_pk_h(ot[4 * g + 2] * rn * gn[2] * hlo(cr.y), ot[4 * g + 3] * rn * gn[3] * hhi(cr.y));
            *(v2u*)(CV + tok * 512 + ecol + 8 * g) = o; }
        __syncthreads();
    }
}
#undef GLA3_FETCH

__device__ __forceinline__ void xcd_barrier_shadow(const XcdBarrier& b, Frame& F, int ph) {
    asm volatile("s_waitcnt vmcnt(0)" ::: "memory");
    __syncthreads();
    if (F.wave == 0) __builtin_amdgcn_s_setprio(3);
    if (F.tid == 0) {
        unsigned* bar = b.bar;
        __builtin_amdgcn_s_waitcnt(0);
        unsigned nloc = b.st[0], nx = b.st[1];
        if (nloc == 0u) { xcd_barrier_complete(bar, b.x, nloc, nx); b.st[0] = nloc; b.st[1] = nx; }
        const unsigned old = xb_add(&bar[XB_XSUB(b.x)], 1u);
        const unsigned gen = old / nloc;
        if (old + 1u == (gen + 1u) * nloc) {
            __builtin_amdgcn_fence(__ATOMIC_RELEASE, "agent");
            asm volatile("s_waitcnt vmcnt(0)" ::: "memory");
            const unsigned og = xb_add(&bar[XB_TOP], 1u);
            const unsigned tg = og / nx;
            __builtin_amdgcn_fence(__ATOMIC_ACQUIRE, "agent");
            if (og + 1u == (tg + 1u) * nx) xb_add(&bar[XB_TOPGEN], 1u);
            else XB_SPIN(xb_ld(&bar[XB_TOPGEN]) == tg, bar);
            xb_add(&bar[XB_XGEN(b.x)], 1u);
            asm volatile("s_waitcnt vmcnt(0)" ::: "memory");
        } else {
            __builtin_amdgcn_fence(__ATOMIC_ACQUIRE, "agent");
            XB_SPIN(xb_ld(&bar[XB_XGEN(b.x)]) == gen, bar);
            asm volatile("s_waitcnt vmcnt(0)" ::: "memory");
        }
    } else if (F.wave != 0) {
        shadow_conv(F, ph);
    }
    if (F.wave == 0) __builtin_amdgcn_s_setprio(0);
    __syncthreads();
}
template <class T> __device__ __forceinline__ T* launder(T* p) {
    unsigned long long v = (unsigned long long)p; unsigned lo = (unsigned)v, hi = (unsigned)(v >> 32);
    asm volatile("" : "+s"(lo), "+s"(hi));
    return (T*)(GAS T*)(((unsigned long long)hi << 32) | lo);
}
#ifndef PROBE_CAT
#define PROBE_CAT (-1)
#endif
#define TB() unsigned long long t0_ = (PROBE_CAT >= 0) ? __builtin_amdgcn_s_memrealtime() : 0ull; unsigned long long c0_ = (PROBE_CAT == 98) ? __builtin_readcyclecounter() : 0ull
#define TE(cat) do { if ((cat) == PROBE_CAT || (PROBE_CAT == 97 && (cat) < 10)) tacc_ += __builtin_amdgcn_s_memrealtime() - t0_; if (PROBE_CAT == 98 && (cat) == 10) tacc_ += (__builtin_readcyclecounter() - c0_) >> 5; (void)c0_; } while (0)
template <class Sched> __device__ __forceinline__ int rstd_table(Frame& F, const Sched& S) {
    pg8::Unit u; if (!S.next(0, u)) return -1;
    if (F.tid < 256) { const f32x4* p = (const f32x4*)((const float*)(F.ws + WS_SSQ) + (size_t)(u.pm * 256 + F.tid) * 16); const f32x4 a = p[0], b = p[1], c = p[2], d = p[3]; const f32x4 s = (a + b) + (c + d);
        ((LAS float*)(F.lds + RSTD_OFF))[F.tid] = 1.0f / sqrtf(((s[0] + s[1]) + (s[2] + s[3])) * (1.0f / DM) + NORM_EPS); }
    __syncthreads();
    return u.pm;
}
constexpr int PH_PER_LAYER = 10, N_PHASES = 1 + NLAYER * PH_PER_LAYER;
struct Args { const void* in[20]; float* out; unsigned char* ws; int ph_lo, ph_hi, li, pad; };
__global__ void __launch_bounds__(NWAVES * 64, 2) mk_fwd(Args args) {
    extern __shared__ __attribute__((aligned(16))) unsigned char lds[];
    Frame F;
    F.lds = (LAS unsigned char*)lds;
    F.MISC = (volatile LAS unsigned*)(F.lds + MISC_OFF);
    F.tid = threadIdx.x; F.lane = F.tid & 63; F.wave = __builtin_amdgcn_readfirstlane(F.tid >> 6); const int wave0_ = F.wave;
    F.G = gridDim.x; F.bx = blockIdx.x; F.vcu = 0;
    F.ws = args.ws; F.X = args.out;
    F.ctl = (gu32*)(args.ws + WS_CTL);
    for (int u = F.tid; u < (LDS_BYTES - LDSCTL_OFF) / 4; u += NWAVES * 64) ((LAS unsigned*)(F.lds + LDSCTL_OFF))[u] = 0u;
    __syncthreads();
    if (F.tid == 0) {
#pragma unroll
        for (int i = 0; i < 20; ++i) ((LAS unsigned long long*)(F.lds + INTAB_OFF))[i] = (unsigned long long)args.in[i];
    }
    __syncthreads();
    XcdBarrier bar; bar.bar = (unsigned*)(F.ctl + CW_BAR); bar.x = 0; bar.st = nullptr;
    if (!MK_PER_PHASE) bar = xcd_barrier_post((unsigned*)(F.ctl + CW_BAR), F.MISC + 8);
#ifdef EXTRA_BARS
    for (int i_ = 0; i_ < EXTRA_BARS; ++i_) xcd_barrier(bar);
#endif
    unsigned long long tacc_ = 0ull; const unsigned long long tk0_ = (PROBE_CAT == 99) ? __builtin_amdgcn_s_memrealtime() : 0ull;
    for (int ph = args.ph_lo; ph < args.ph_hi; ++ph) {
        { int wv_ = wave0_; asm volatile("" : "+s"(wv_)); int t_ = wv_ * 64 + (int)__builtin_amdgcn_mbcnt_hi(~0u, __builtin_amdgcn_mbcnt_lo(~0u, 0u)); asm volatile("" : "+v"(t_)); t_ &= 511;
          F.tid = t_; F.lane = t_ & 63; F.wave = __builtin_amdgcn_readfirstlane(t_ >> 6); }
        F.ws = launder(args.ws); F.X = launder(args.out);
        { int bx_ = blockIdx.x, g_ = gridDim.x; asm volatile("" : "+s"(bx_), "+s"(g_)); F.bx = bx_; F.G = g_; F.vcu = (g_ % 8 == 0) ? (bx_ % 8) * (g_ / 8) + bx_ / 8 : bx_; }
        const float* ssq = (const float*)(F.ws + WS_SSQ);
        pg8::bf16_t* XB = (pg8::bf16_t*)(F.ws + WS_XB);
        if (ph == 0) {
            { TB(); p0_rows(F); conv_set(F, 0, 0); TE(4); }
        } else {
            const int l = (ph - 1) / PH_PER_LAYER, k = (ph - 1) % PH_PER_LAYER;
            if (k == 0 || k == 8) {
                pg8::Gemm g{XB, XB, XB, (const pg8::bf16_t*)(F.ws + WS_S1), nullptr, nullptr, M, 2 * DFF, DM};
                pg8::StaticOrder S; S.init(M, 2 * DFF, F.G, F.bx);
                pg8::Unit u0_; const int rpm = S.next(0, u0_) ? u0_.pm : -1; pg8::EpiSwiglu E{(pg8::bf16_t*)(F.ws + WS_ACTH), ssq, (const LAS float*)(F.lds + RSTD_OFF), rpm};
                { TB(); pg8::gemm_phase<pg8::EpiSwiglu, pg8::StaticOrder, true>(F.lds + RING_OFF, g, S, E, F.tid); TE(0); TE(10); }
                { const int rem = S.nwg % F.G; if (rem == 0) tail_conv(F, ph, F.bx, F.G); else if (F.bx >= rem) tail_conv(F, ph, F.bx - rem, F.G - rem); }
            } else if (k == 1 || k == 9) {
                { TB(); if (k == 9 && l + 1 < NLAYER) { conv_set(F, 0, l + 1); __syncthreads(); } TE(4); }
                const pg8::bf16_t* A = (const pg8::bf16_t*)(F.ws + WS_ACTH);
                pg8::Gemm g{A, A, A, (const pg8::bf16_t*)(F.ws + WS_S2), nullptr, nullptr, M, DM, DFF};
                pg8::StaticOrder S; S.init(M, DM, F.G, F.bx);
                pg8::EpiResidual E{(k == 9 && l == NLAYER - 1) ? F.X : nullptr, XB, (float*)(F.ws + WS_SSQ), 0.5f, 2.0f};
                { TB(); pg8::gemm_phase<pg8::EpiResidual, pg8::StaticOrder, true>(F.lds + RING_OFF, g, S, E, F.tid); TE(0); TE(11); }
            } else if (k == 2) {
                pg8::Gemm g{XB, XB, XB, (const pg8::bf16_t*)(F.ws + WS_STATE), nullptr, nullptr, M, 7168, DM};
                pg8::StaticOrder S; S.init(M, 7168, F.G, F.bx);
                pg8::Unit u0_; const int rpm = S.next(0, u0_) ? u0_.pm : -1; pg8::EpiInProj E{F.ws, ssq, (const pg8::bf16_t*)(F.ws + WS_COS), (const LAS float*)(F.lds + RSTD_OFF), rpm, inptr(F, 7) + l * 64, inptr(F, 8) + l * 64, inptr(F, 9) + l * 64, inptr(F, 10) + l * 64, inptr(F, 13) + l * 256};
                { TB(); pg8::gemm_phase<pg8::EpiInProj, pg8::StaticOrder, true>(F.lds + RING_OFF, g, S, E, F.tid); TE(0); TE(12); }
            } else if (k == 3) {
                { TB(); gla1_phase(F); __syncthreads(); TE(2); } { TB(); attn_phase(F, l); TE(1); }
            } else if (k == 4) { { TB(); gla2_phase(F); TE(3); } { TB(); amerge_phase(F); TE(6); }
            } else if (k == 5) {
                { TB(); gla3_phase(F, l); __syncthreads(); TE(3); }
                pg8::Gemm g{XB, XB, XB, (const pg8::bf16_t*)(F.ws + WS_WG), nullptr, nullptr, M, 3 * DM, DM};
                pg8::StaticOrder S; S.init(M, 3 * DM, F.G, F.bx);
                pg8::Unit u0_; const int rpm = S.next(0, u0_) ? u0_.pm : -1; pg8::EpiSigmoid E{(pg8::bf16_t*)(F.ws + WS_GATES), ssq, (const LAS float*)(F.lds + RSTD_OFF), rpm};
                { TB(); pg8::gemm_phase<pg8::EpiSigmoid, pg8::StaticOrder, true>(F.lds + RING_OFF, g, S, E, F.tid); TE(0); TE(13); }
            } else if (k == 6) {
                const pg8::bf16_t* WB = (const pg8::bf16_t*)(F.ws + WS_WB);
                pg8::Gemm g{(const pg8::bf16_t*)(F.ws + WS_AQ0), (const pg8::bf16_t*)(F.ws + WS_BQ), (const pg8::bf16_t*)(F.ws + WS_CV), WB, WB + (size_t)DM * 512, WB + (size_t)2 * DM * 512, M, DM, 512};
                pg8::Seg3Order S; S.b.init(M, DM, F.G, F.bx);
                pg8::EpiMerge E{(const pg8::bf16_t*)(F.ws + WS_GATES), (pg8::bf16_t*)(F.ws + WS_MERGED)};
                { TB(); pg8::gemm_phase<pg8::EpiMerge, pg8::Seg3Order, true>(F.lds + RING_OFF, g, S, E, F.tid); TE(0); TE(14); }
            } else if (k == 7) {
                const pg8::bf16_t* A = (const pg8::bf16_t*)(F.ws + WS_MERGED);
                pg8::Gemm g{A, A, A, (const pg8::bf16_t*)(F.ws + WS_WO), nullptr, nullptr, M, DM, DM};
                pg8::StaticOrder S; S.init(M, DM, F.G, F.bx);
                pg8::EpiResidual E{nullptr, XB, (float*)(F.ws + WS_SSQ), 1.0f, 1.0f};
                { TB(); pg8::gemm_phase<pg8::EpiResidual, pg8::StaticOrder, true>(F.lds + RING_OFF, g, S, E, F.tid); TE(0); TE(15); }
            }
        }
        if (ph + 1 < args.ph_hi) { TB(); xcd_barrier_shadow(bar, F, ph); TE(5); }
    }
    if (PROBE_CAT == 99) tacc_ = __builtin_amdgcn_s_memrealtime() - tk0_;
    if (PROBE_CAT >= 0 && blockIdx.x == 0 && threadIdx.x == 0) { const unsigned long long ts_ = __builtin_amdgcn_s_memrealtime(); while (__builtin_amdgcn_s_memrealtime() - ts_ < tacc_) __builtin_amdgcn_s_sleep(8); }
}

extern "C" void kernel_launch(void* const* d_in, const int* in_sizes, int n_in, void* d_out, int out_size, void* d_ws, size_t ws_size, hipStream_t stream) {
    static int grid = 0;
    if (grid == 0) {
        if (n_in != 20 || out_size != M * DM || ws_size < WS_END) { fprintf(stderr, "kernel_launch: unexpected problem (n_in %d, out %d, ws %zu < %zu); nothing launched\n", n_in, out_size, ws_size, (size_t)WS_END); grid = -1; return; }
        int dev = 0, cus = 0, per_cu = 0;
        if (hipGetDevice(&dev) != hipSuccess || hipDeviceGetAttribute(&cus, hipDeviceAttributeMultiprocessorCount, dev) != hipSuccess) { grid = -1; return; }
        if (hipFuncSetAttribute((const void*)mk_fwd, hipFuncAttributeMaxDynamicSharedMemorySize, LDS_BYTES) != hipSuccess) { fprintf(stderr, "kernel_launch: hipFuncSetAttribute failed\n"); grid = -1; return; }
        if (hipOccupancyMaxActiveBlocksPerMultiprocessor(&per_cu, (const void*)mk_fwd, NWAVES * 64, LDS_BYTES) != hipSuccess || per_cu < 1)
            fprintf(stderr, "kernel_launch: note: occupancy query reports %d workgroups per CU\n", per_cu);
        (void)hipGetLastError();
        grid = cus;
    }
    if (grid < 0) return;
    if (hipMemsetAsync((char*)d_ws + WS_CTL, 0, CTL_ZERO_BYTES, stream) != hipSuccess) return;
    Args a{};
    for (int i = 0; i < 20; ++i) a.in[i] = d_in[i];
    a.out = (float*)d_out; a.ws = (unsigned char*)d_ws;
#if MK_PER_PHASE
    for (int p = 0; p < N_PHASES; ++p) { a.ph_lo = p; a.ph_hi = p + 1; a.li = p; hipLaunchKernelGGL(mk_fwd, dim3(grid), dim3(NWAVES * 64), LDS_BYTES, stream, a); }
#else
    a.ph_lo = 0; a.ph_hi = N_PHASES; a.li = 0;
    hipLaunchKernelGGL(mk_fwd, dim3(grid), dim3(NWAVES * 64), LDS_BYTES, stream, a);
#endif
}
```

```cpp
#include <hip/hip_runtime.h>
#include <cstdio>
#include <cstdint>

#ifndef MK_BF16
#define MK_BF16 0
#endif
#ifndef MK_PER_PHASE
#define MK_PER_PHASE 0
#endif
static_assert(MK_PER_PHASE == 0, "one launch only");

namespace pg8 {
#define PG8_LAS __attribute__((address_space(3)))
typedef unsigned short bf16_t;
typedef short bf16x8 __attribute__((ext_vector_type(8)));
typedef _Float16 h16x8_t __attribute__((ext_vector_type(8)));
typedef float f32x4 __attribute__((ext_vector_type(4)));
typedef unsigned u32x4 __attribute__((ext_vector_type(4)));
constexpr int BM = 256, BK = 64, HALF = 128, HTB = HALF * BK * 2  , STAGE_BYTES = 8 * HTB, NXCD = 8, WGM = 8;

__host__ __device__ __forceinline__ int lds_byte(int r, int c) { const int st = (r >> 4) * 2 + (c >> 5), rr = r & 15, cc = c & 31, ob = rr * 64 + cc * 2; return st * 1024 + (ob ^ (((ob >> 9) & 1) << 5)); }
__host__ __device__ __forceinline__ void stage_rc(int b, int& R, int& C) { const int st = b / 1024, sb = b % 1024, swz = sb ^ (((sb >> 9) & 1) << 5); R = (st >> 1) * 16 + swz / 64; C = (st & 1) * 32 + (swz % 64) / 2; }
__host__ __device__ __forceinline__ int perm32(int rho) { const int n = rho >> 4, i = rho & 15; return 8 * (i >> 2) + 4 * n + (i & 3); }

struct Unit { int pm, pn, seg; };
struct Gemm { const bf16_t* A0; const bf16_t* A1; const bf16_t* A2; const bf16_t* B0; const bf16_t* B1; const bf16_t* B2; int M, N, K; };

struct StaticOrder {
    int nM, nN, nwg, G, c;
    __host__ __device__ void init(int M, int N, int G_, int c_) { nM = M / BM; nN = N / BM; nwg = nM * nN; G = G_; c = c_; }
    __host__ __device__ bool next(int i, Unit& u) const {
        const long L = (long)i * G + c; if (L >= nwg) return false;
        int wgid = (int)L; { const int q = nwg / NXCD, r = nwg % NXCD, xcd = wgid % NXCD, off = wgid / NXCD; wgid = (xcd < r ? xcd * (q + 1) : r * (q + 1) + (xcd - r) * q) + off; }
        const int nig = WGM * nN, gid = wgid / nig, fm = gid * WGM, gsz = (nM - fm) < WGM ? (nM - fm) : WGM;
        u.pm = fm + ((wgid % nig) % gsz); u.pn = (wgid % nig) / gsz; u.seg = 0; return true;
    }
};
struct Seg3Order {
    StaticOrder b;
    __host__ __device__ bool next(int i, Unit& u) const { if (!b.next(i / 3, u)) return false; u.seg = i % 3; return true; }
};

typedef float f32x2_t __attribute__((ext_vector_type(2))); typedef __bf16 bf16x2_t __attribute__((ext_vector_type(2))); typedef _Float16 h16x2_t __attribute__((ext_vector_type(2)));
__device__ __forceinline__ unsigned cvt_pk_bf(float lo, float hi) { f32x2_t v = {lo, hi}; bf16x2_t b = __builtin_convertvector(v, bf16x2_t); return __builtin_bit_cast(unsigned, b); }
__device__ __forceinline__ unsigned cvt_pk_h16(float lo, float hi) { h16x2_t b = {(_Float16)lo, (_Float16)hi}; return __builtin_bit_cast(unsigned, b); }
__device__ __forceinline__ unsigned cvt_pk_h(float lo, float hi) { return MK_BF16 ? cvt_pk_bf(lo, hi) : cvt_pk_h16(lo, hi); }

template <class Epi, class Sched, bool ALIGN_EPI = false>
__device__ __forceinline__ void gemm_phase(PG8_LAS unsigned char* lds, const Gemm g, const Sched& S, const Epi& E, int tid_in) {
    int tid_ = tid_in; asm volatile("" : "+v"(tid_));
    const int tid = tid_ & 511, wid = __builtin_amdgcn_readfirstlane(tid >> 6), lane = tid & 63, wr = wid >> 2, wc = wid & 3, fr = lane & 15, fq = lane >> 4;
    const int K = g.K, nt = K / BK;
    unsigned voffA[2], voffB[2];
#pragma unroll
    for (int i = 0; i < 2; ++i) { int R, C; stage_rc(tid * 16 + i * 8192, R, C); const int Rb = Epi::PERM ? ((R & ~31) + perm32(R & 31)) : R;
        voffA[i] = (unsigned)(R * K + C) * 2u; voffB[i] = (unsigned)(Rb * K + C) * 2u; }
    const size_t kstep = (size_t)(BK * 2);
    const size_t hstep = (size_t)HALF * K * 2;
    const size_t tstep = 2 * hstep;
    const unsigned ldsw = (unsigned)wid * 1024u;
    const int aoff = lds_byte(wr * 64 + fr, fq * 8), boff = lds_byte(wc * 32 + fr, fq * 8);
#define PG8_SA(b, h) (((b) * 2 + (h)) * HTB)
#define PG8_SB(b, h) ((4 + (b) * 2 + (h)) * HTB)
#define PG8_STAGE(bufoff, gbase, voff) do { _Pragma("unroll") for (int _i = 0; _i < 2; ++_i) \
        __builtin_amdgcn_global_load_lds((const unsigned*)((const char*)(gbase) + (voff)[_i]), (PG8_LAS unsigned*)(lds + (bufoff) + ldsw + _i * 8192), 16, 0, 0); } while (0)
#define PG8_LDA(dst, b, h) do { _Pragma("unroll") for (int m = 0; m < 4; ++m) _Pragma("unroll") for (int k = 0; k < 2; ++k) dst[m][k] = *(const PG8_LAS bf16x8*)(lds + PG8_SA(b, h) + aoff + m * 2048 + k * 1024); } while (0)
#define PG8_LDB(dst, b, h) do { _Pragma("unroll") for (int n = 0; n < 2; ++n) _Pragma("unroll") for (int k = 0; k < 2; ++k) dst[n][k] = *(const PG8_LAS bf16x8*)(lds + PG8_SB(b, h) + boff + n * 2048 + k * 1024); } while (0)
#define PG8_MMA(ai, bj, At, Bt) do { __builtin_amdgcn_s_setprio(1); _Pragma("unroll") for (int m = 0; m < 4; ++m) _Pragma("unroll") for (int n = 0; n < 2; ++n) _Pragma("unroll") for (int k = 0; k < 2; ++k) \
        acc[ai][bj][m][n] = MK_BF16 ? __builtin_amdgcn_mfma_f32_16x16x32_bf16(Bt[n][k], At[m][k], acc[ai][bj][m][n], 0, 0, 0) : __builtin_amdgcn_mfma_f32_16x16x32_f16(__builtin_bit_cast(h16x8_t, Bt[n][k]), __builtin_bit_cast(h16x8_t, At[m][k]), acc[ai][bj][m][n], 0, 0, 0); __builtin_amdgcn_s_setprio(0); } while (0)
#define PG8_WAIT_V(n) asm volatile("s_waitcnt vmcnt(" #n ")" ::: "memory")
#define PG8_WAIT_L(n) asm volatile("s_waitcnt lgkmcnt(" #n ")" ::: "memory")
#define PG8_BAR __builtin_amdgcn_s_barrier()
#define PG8_SCHED __builtin_amdgcn_sched_barrier(0)
#define PG8_ASEL(u) ((u).seg == 0 ? g.A0 : ((u).seg == 1 ? g.A1 : g.A2))
#define PG8_BSEL(u) ((u).seg == 0 ? g.B0 : ((u).seg == 1 ? g.B1 : g.B2))
    Unit cur, nxt; int ui = 0;
    if (!S.next(0, cur)) return;
    f32x4 acc[2][2][4][2];
#pragma unroll
    for (int a = 0; a < 2; ++a)
#pragma unroll
        for (int b = 0; b < 2; ++b)
#pragma unroll
            for (int m = 0; m < 4; ++m)
#pragma unroll
                for (int n = 0; n < 2; ++n) acc[a][b][m][n] = (f32x4){0.f, 0.f, 0.f, 0.f};
    E.init(acc, cur, wr, wc, lane);
    typename Epi::Pro pro; E.pro_load(pro, cur, tid);
    bf16x8 At[4][2], B0[2][2], B1[2][2];
    const char* cA = (const char*)PG8_ASEL(cur) + (size_t)cur.pm * tstep; const char* cB = (const char*)PG8_BSEL(cur) + (size_t)cur.pn * tstep;
    PG8_STAGE(PG8_SB(0, 0), cB, voffB); PG8_STAGE(PG8_SB(0, 1), cB + hstep, voffB); PG8_STAGE(PG8_SA(0, 0), cA, voffA); PG8_STAGE(PG8_SA(0, 1), cA + hstep, voffA);
    E.pro_store(pro, tid);
    if (wr == 1) PG8_BAR;
    PG8_WAIT_V(2); PG8_BAR;
    PG8_STAGE(PG8_SB(1, 0), cB + kstep, voffB); PG8_STAGE(PG8_SA(1, 0), cA + kstep, voffA); PG8_STAGE(PG8_SB(1, 1), cB + hstep + kstep, voffB);
    PG8_WAIT_V(6); PG8_BAR;
    for (;;) {
        const bool has_next = S.next(ui + 1, nxt);
        const char* nA = has_next ? (const char*)PG8_ASEL(nxt) + (size_t)nxt.pm * tstep : cA; const char* nB = has_next ? (const char*)PG8_BSEL(nxt) + (size_t)nxt.pn * tstep : cB;
        for (int t = 0; t < nt; t += 2) {
            const bool last = (t == nt - 2);
            const char* a1 = cA + (size_t)(t + 1) * kstep;
            const char* a2 = last ? nA : cA + (size_t)(t + 2) * kstep; const char* b2 = last ? nB : cB + (size_t)(t + 2) * kstep;
            const char* a3 = a2 + kstep; const char* b3 = b2 + kstep;
            PG8_LDB(B0, 0, 0); PG8_LDB(B1, 0, 1); PG8_SCHED; PG8_LDA(At, 0, 0); PG8_STAGE(PG8_SA(1, 1), a1 + hstep, voffA);
            PG8_WAIT_V(8); PG8_WAIT_L(0); PG8_BAR; PG8_MMA(0, 0, At, B0); PG8_MMA(0, 1, At, B1); PG8_BAR; PG8_SCHED;
            PG8_LDA(At, 0, 1); PG8_STAGE(PG8_SB(0, 0), b2, voffB); PG8_STAGE(PG8_SB(0, 1), b2 + hstep, voffB); PG8_STAGE(PG8_SA(0, 0), a2, voffA);
            PG8_WAIT_V(8); PG8_WAIT_L(0); PG8_BAR; PG8_MMA(1, 0, At, B0); PG8_MMA(1, 1, At, B1); PG8_BAR; PG8_SCHED;
            PG8_LDB(B0, 1, 0); PG8_LDB(B1, 1, 1); PG8_SCHED; PG8_LDA(At, 1, 0); PG8_STAGE(PG8_SA(0, 1), a2 + hstep, voffA);
            PG8_WAIT_V(8); PG8_WAIT_L(0); PG8_BAR; PG8_MMA(0, 0, At, B0); PG8_MMA(0, 1, At, B1); PG8_BAR; PG8_SCHED;
            PG8_LDA(At, 1, 1); PG8_STAGE(PG8_SB(1, 0), b3, voffB); PG8_STAGE(PG8_SB(1, 1), b3 + hstep, voffB); PG8_STAGE(PG8_SA(1, 0), a3, voffA);
            PG8_WAIT_V(8); PG8_WAIT_L(0); PG8_BAR; PG8_MMA(1, 0, At, B0); PG8_MMA(1, 1, At, B1); PG8_BAR; PG8_SCHED;
        }
        if constexpr (ALIGN_EPI) { if (wr == 0) PG8_BAR; }
        const bool keep = E(acc, cur, wr, wc, fr, fq, lane);
#ifdef PROBE_EPI2
        if constexpr (Epi::IDEMP) {
#pragma unroll
            for (int a = 0; a < 2; ++a)
#pragma unroll
                for (int b = 0; b < 2; ++b)
#pragma unroll
                    for (int m = 0; m < 4; ++m)
#pragma unroll
                        for (int n = 0; n < 2; ++n) asm volatile("" : "+v"(acc[a][b][m][n]));
            asm volatile("" ::: "memory");
            (void)E(acc, cur, wr, wc, fr, fq, lane);
        }
#endif
        if (!has_next) break;
        if (!keep) {
#pragma unroll
        for (int a = 0; a < 2; ++a)
#pragma unroll
            for (int b = 0; b < 2; ++b)
#pragma unroll
                for (int m = 0; m < 4; ++m)
#pragma unroll
                    for (int n = 0; n < 2; ++n) acc[a][b][m][n] = (f32x4){0.f, 0.f, 0.f, 0.f};
        E.init(acc, nxt, wr, wc, lane);
        }
        cur = nxt; cA = nA; cB = nB; ++ui;
        if constexpr (ALIGN_EPI) { if (wr == 1) PG8_BAR; }
    }
    PG8_WAIT_V(0);
    if constexpr (!ALIGN_EPI) { if (wr == 0) PG8_BAR; }
    PG8_BAR;
#undef PG8_SA
#undef PG8_SB
#undef PG8_STAGE
#undef PG8_LDA
#undef PG8_LDB
#undef PG8_MMA
#undef PG8_WAIT_V
#undef PG8_WAIT_L
#undef PG8_BAR
#undef PG8_SCHED
#undef PG8_ASEL
#undef PG8_BSEL
}
}

constexpr int NWAVES = 8;
constexpr int BATCH = 2, SEQ = 8192, DM = 1024, M = BATCH * SEQ, DFF = 2816, NLAYER = 2, INW = 10000;
constexpr float NORM_EPS = 1e-6f;
constexpr float LOG2E = 1.4426950408889634f;
constexpr float QSCALE = 0.125f * LOG2E;

constexpr size_t MiB = 1u << 20;
constexpr size_t WS_CTL = 0, CTL_ZERO_BYTES = 64 * 1024;
constexpr size_t WS_SSQ = 1 * MiB;
constexpr size_t WS_COS = 2 * MiB;
constexpr size_t WS_S1 = 6 * MiB;
constexpr size_t WS_S2 = 17 * MiB;
constexpr size_t WS_DC = 22 * MiB + 512 * 1024;
constexpr size_t WS_WG = 23 * MiB;
constexpr size_t WS_WB = 29 * MiB;
constexpr size_t WS_WO = 32 * MiB;
constexpr size_t WS_ACT = 34 * MiB;
constexpr size_t UU = 4 * MiB;
constexpr size_t WS_AQ0 = WS_ACT + 0 * UU, WS_AQ1 = WS_ACT + 4 * UU, WS_AQ2 = WS_ACT + 8 * UU;
constexpr size_t WS_AK0 = WS_ACT + 12 * UU, WS_AV0 = WS_ACT + 24 * UU;
constexpr size_t WS_GATES = WS_ACT + 12 * UU;
constexpr size_t WS_MERGED = WS_ACT + 50 * UU;
constexpr size_t WS_BQ = WS_ACT + 36 * UU, WS_BK = WS_ACT + 40 * UU, WS_BV = WS_ACT + 41 * UU;
constexpr size_t WS_CQ = WS_ACT + 42 * UU, WS_CK = WS_ACT + 44 * UU, WS_CV = WS_ACT + 46 * UU;
constexpr size_t WS_LOGG = WS_ACT + 50 * UU;
constexpr size_t WS_CR = WS_ACT + 52 * UU;
constexpr size_t WS_STATE = WS_ACT + 56 * UU;
constexpr size_t WS_XB = WS_ACT + 60 * UU;
constexpr size_t WS_ACTH = WS_ACT;
constexpr size_t WS_LSE = WS_ACT + 68 * UU;
constexpr size_t WS_END = WS_LSE + 3 * (size_t)M * 8 * 4;
static_assert(WS_S1 + (size_t)2 * DFF * DM * 2 <= WS_S2 && WS_S2 + (size_t)DM * DFF * 2 <= WS_DC && WS_DC + 8 * 128 * 64 * 4 <= WS_WG, "ws map");
static_assert((size_t)M * DFF * 2 <= 22 * UU && (size_t)7168 * 1024 * 2 <= 4 * UU, "ws map 2");
constexpr int CW_TMO = 0, CW_CODE = 1;
constexpr int CW_BAR = 4096;

constexpr int RING_OFF = 0, RING_BYTES = 131072;
constexpr int LDSCTL_OFF = RING_BYTES, MISC_OFF = LDSCTL_OFF + 320;
constexpr int LDS_BYTES = 147456;
constexpr int INTAB_OFF = MISC_OFF + 256;
constexpr int RSTD_OFF = INTAB_OFF + 256;

#define GAS __attribute__((address_space(1)))
#define LAS __attribute__((address_space(3)))
typedef unsigned short bf16;
typedef unsigned v4u __attribute__((ext_vector_type(4)));
typedef unsigned v2u __attribute__((ext_vector_type(2)));
typedef float f32x4 __attribute__((ext_vector_type(4)));
typedef short bf16x8 __attribute__((ext_vector_type(8)));
typedef _Float16 h16x2 __attribute__((ext_vector_type(2)));
typedef GAS unsigned gu32;
#define RLX_AGENT __ATOMIC_RELAXED, __HIP_MEMORY_SCOPE_AGENT
#define LDS_WAIT() asm volatile("s_waitcnt lgkmcnt(0)" ::: "memory")
#define VM_WAIT() asm volatile("s_waitcnt vmcnt(0)" ::: "memory")
__device__ __forceinline__ unsigned f2bf(float f) { unsigned u = __builtin_bit_cast(unsigned, f); return (u + 0x7fffu + ((u >> 16) & 1u)) >> 16; }
__device__ __forceinline__ float h2f16(unsigned short b) { return (float)__builtin_bit_cast(_Float16, b); }
__device__ __forceinline__ float hlo16(unsigned w) { return h2f16((unsigned short)(w & 0xffffu)); }
__device__ __forceinline__ float hhi16(unsigned w) { return h2f16((unsigned short)(w >> 16)); }
__device__ __forceinline__ float h2f(unsigned short b) { return MK_BF16 ? __builtin_bit_cast(float, (unsigned)b << 16) : h2f16(b); }
__device__ __forceinline__ unsigned short f2h(float f) { return MK_BF16 ? (unsigned short)((__builtin_bit_cast(unsigned, f) + 0x7fffu + ((__builtin_bit_cast(unsigned, f) >> 16) & 1u)) >> 16) : __builtin_bit_cast(unsigned short, (_Float16)f); }
__device__ __forceinline__ float hlo(unsigned w) { return h2f((unsigned short)(w & 0xffffu)); }
__device__ __forceinline__ float hhi(unsigned w) { return h2f((unsigned short)(w >> 16)); }
__device__ __forceinline__ unsigned pk2(float lo, float hi) { return pg8::cvt_pk_h(lo, hi); }
__device__ __forceinline__ float bflo(unsigned w) { return __builtin_bit_cast(float, w << 16); }
__device__ __forceinline__ float bfhi(unsigned w) { return __builtin_bit_cast(float, w & 0xffff0000u); }
__device__ __forceinline__ float bf2f(bf16 h) { return __builtin_bit_cast(float, (unsigned)h << 16); }
__device__ __forceinline__ float fexp2(float x) { return __builtin_amdgcn_exp2f(x); }
__device__ __forceinline__ float fexp(float x) { return __builtin_amdgcn_exp2f(x * LOG2E); }
__device__ __forceinline__ float frcp(float x) { return __builtin_amdgcn_rcpf(x); }
__device__ __forceinline__ float sigmoidf_(float x) { return frcp(1.0f + fexp(-x)); }
__device__ __forceinline__ float siluf_(float x) { return x * sigmoidf_(x); }

#define XB_TMO      128
#define XB_XCNT(j)  (256  + 64 * (j))
#define XB_XSUB(j)  (1280 + 64 * (j))
#define XB_XGEN(j)  (2304 + 64 * (j))
#define XB_TOP      3328
#define XB_TOPGEN   3392
#define XCD_BAR_WORDS 3456
#define XB_SPIN_CAP (1u << 18)
__device__ __forceinline__ unsigned xb_ld(unsigned* p)              { return __hip_atomic_load(p, __ATOMIC_RELAXED, __HIP_MEMORY_SCOPE_AGENT); }
__device__ __forceinline__ unsigned xb_add(unsigned* p, unsigned v) { return __hip_atomic_fetch_add(p, v, __ATOMIC_RELAXED, __HIP_MEMORY_SCOPE_AGENT); }
__device__ __forceinline__ unsigned xb_xcc_id() { return (unsigned)__builtin_amdgcn_s_getreg((3 << 11) | 20) & 0xFu; }
#define XB_SPIN(cond, bar) do { unsigned _sp = 0; while (cond) { __builtin_amdgcn_s_sleep(1); \
    if ((++_sp & 255u) == 0u) { if (xb_ld(&(bar)[XB_TMO])) break; if (_sp > XB_SPIN_CAP) { atomicAdd(&(bar)[XB_TMO], 1u); break; } } } } while (0)
struct XcdBarrier { unsigned* bar; unsigned x; volatile LAS unsigned* st; };
__device__ __forceinline__ XcdBarrier xcd_barrier_post(unsigned* bar, volatile LAS unsigned* st) {
    XcdBarrier b; b.bar = bar; b.x = xb_xcc_id(); b.st = st;
    if (threadIdx.x == 0) (void)xb_add(&bar[XB_XCNT(b.x)], 1u);
    return b;
}
__device__ __forceinline__ void xcd_barrier_complete(unsigned* bar, unsigned x, unsigned& nloc, unsigned& nx) {
    const unsigned G = gridDim.x * gridDim.y * gridDim.z;
    unsigned sum, cnt, mine, sp = 0u;
    for (;;) {
        sum = 0u; cnt = 0u; mine = 0u;
#pragma unroll
        for (unsigned j = 0; j < 16; ++j) { const unsigned c = xb_ld(&bar[XB_XCNT(j)]); sum += c; cnt += (c > 0u) ? 1u : 0u; mine = (j == x) ? c : mine; }
        if (sum == G) break;
        __builtin_amdgcn_s_sleep(1);
        if ((++sp & 255u) == 0u) { if (xb_ld(&bar[XB_TMO])) break; if (sp > XB_SPIN_CAP) { atomicAdd(&bar[XB_TMO], 1u); break; } }
    }
    nloc = mine > 0u ? mine : 1u; nx = cnt > 0u ? cnt : 1u;
}
__device__ __forceinline__ void xcd_barrier(const XcdBarrier& b) {
    asm volatile("s_waitcnt vmcnt(0)" ::: "memory");
    __syncthreads();
    if (threadIdx.x == 0) {
        unsigned* bar = b.bar;
        __builtin_amdgcn_s_waitcnt(0);
        unsigned nloc = b.st[0], nx = b.st[1];
        if (nloc == 0u) { xcd_barrier_complete(bar, b.x, nloc, nx); b.st[0] = nloc; b.st[1] = nx; }
        const unsigned old = xb_add(&bar[XB_XSUB(b.x)], 1u);
        const unsigned gen = old / nloc;
        if (old + 1u == (gen + 1u) * nloc) {
            __builtin_amdgcn_fence(__ATOMIC_RELEASE, "agent");
            asm volatile("s_waitcnt vmcnt(0)" ::: "memory");
            const unsigned og = xb_add(&bar[XB_TOP], 1u);
            const unsigned tg = og / nx;
            if (og + 1u == (tg + 1u) * nx) xb_add(&bar[XB_TOPGEN], 1u);
            else XB_SPIN(xb_ld(&bar[XB_TOPGEN]) == tg, bar);
            __builtin_amdgcn_fence(__ATOMIC_ACQUIRE, "agent");
            xb_add(&bar[XB_XGEN(b.x)], 1u);
            asm volatile("s_waitcnt vmcnt(0)" ::: "memory");
        } else {
            XB_SPIN(xb_ld(&bar[XB_XGEN(b.x)]) == gen, bar);
            __builtin_amdgcn_fence(__ATOMIC_ACQUIRE, "agent");
            asm volatile("s_waitcnt vmcnt(0)" ::: "memory");
        }
    }
    __syncthreads();
}

struct Frame {
    LAS unsigned char* lds;
    volatile LAS unsigned* MISC;
    gu32* ctl;
    int tid, lane, wave;
    int vcu, G, bx;
    unsigned char* ws;
    float* X;
};
__device__ __forceinline__ const float* inptr(const Frame& F, int i) {
    const LAS unsigned* t = (const LAS unsigned*)(F.lds + INTAB_OFF); unsigned lo = t[2 * i], hi = t[2 * i + 1];
    lo = __builtin_amdgcn_readfirstlane(lo); hi = __builtin_amdgcn_readfirstlane(hi);
    return (const float*)(const GAS float*)(((unsigned long long)hi << 32) | lo);
}
__device__ __forceinline__ float wave_sum(float v) {
#pragma unroll
    for (int o = 1; o < 64; o <<= 1) v += __shfl_xor(v, o);
    return v;
}
__device__ __forceinline__ float wave_max(float v) {
#pragma unroll
    for (int o = 1; o < 64; o <<= 1) v = fmaxf(v, __shfl_xor(v, o));
    return v;
}

__device__ __forceinline__ unsigned hmin2(unsigned a, unsigned b) { typedef _Float16 hh2 __attribute__((ext_vector_type(2))); const hh2 x = __builtin_bit_cast(hh2, a), y = __builtin_bit_cast(hh2, b); return __builtin_bit_cast(unsigned, __builtin_elementwise_min(x, y)); }
__device__ __forceinline__ unsigned hmax2(unsigned a, unsigned b) { typedef _Float16 hh2 __attribute__((ext_vector_type(2))); const hh2 x = __builtin_bit_cast(hh2, a), y = __builtin_bit_cast(hh2, b); return __builtin_bit_cast(unsigned, __builtin_elementwise_max(x, y)); }
__device__ __forceinline__ void plswap32(float& a, float& b) { asm("s_nop 1\n\tv_permlane32_swap_b32 %0, %1" : "+v"(a), "+v"(b)); }
__device__ __forceinline__ void plswap16(float& a, float& b) { asm("s_nop 1\n\tv_permlane16_swap_b32 %0, %1" : "+v"(a), "+v"(b)); }
__device__ __forceinline__ float xsum32(float v) { float a = v, b = v; plswap32(a, b); return a + b; }
__device__ __forceinline__ float xsum16(float v) { float a = v, b = v; plswap16(a, b); return a + b; }
__device__ __forceinline__ float xmax32(float v) { float a = v, b = v; plswap32(a, b); return fmaxf(a, b); }
namespace pg8 {
__device__ __forceinline__ void load_rstd(const float* ssq, int pm, int wr, int lane, float (&rs)[2][4]) {
    float mine[2];
#pragma unroll
    for (int ai = 0; ai < 2; ++ai) { const f32x4* p = (const f32x4*)(ssq + (size_t)(pm * 256 + ai * 128 + wr * 64 + lane) * 16);
        const f32x4 a = p[0], b = p[1], c = p[2], d = p[3]; const f32x4 s = (a + b) + (c + d);
        mine[ai] = 1.0f / sqrtf(((s[0] + s[1]) + (s[2] + s[3])) * (1.0f / DM) + NORM_EPS); }
#pragma unroll
    for (int ai = 0; ai < 2; ++ai)
#pragma unroll
        for (int m = 0; m < 4; ++m) rs[ai][m] = __shfl(mine[ai], 16 * m + (lane & 15));
}
__device__ __forceinline__ void get_rstd(const PG8_LAS float* rtab, int rpm, const float* ssq, int pm, int wr, int fr, int lane, float (&rs)[2][4]) {
    if (pm == rpm) {
#pragma unroll
        for (int ai = 0; ai < 2; ++ai)
#pragma unroll
            for (int m = 0; m < 4; ++m) rs[ai][m] = rtab[ai * 128 + wr * 64 + m * 16 + fr];
    } else load_rstd(ssq, pm, wr, lane, rs);
}
__device__ __forceinline__ u32x4 pack8(const f32x4& a, const f32x4& b) { u32x4 w; w.x = cvt_pk_h(a[0], a[1]); w.y = cvt_pk_h(a[2], a[3]); w.z = cvt_pk_h(b[0], b[1]); w.w = cvt_pk_h(b[2], b[3]); return w; }
__device__ __forceinline__ u32x4 pack8_bf(const f32x4& a, const f32x4& b) { u32x4 w; w.x = cvt_pk_bf(a[0], a[1]); w.y = cvt_pk_bf(a[2], a[3]); w.z = cvt_pk_bf(b[0], b[1]); w.w = cvt_pk_bf(b[2], b[3]); return w; }

struct RstdPro { f32x4 a, b, c, d; };
struct NoPro {};
__device__ __forceinline__ void rstd_pro_load(RstdPro& p, const float* ssq, int pm, int tid) {
    p.a = p.b = p.c = p.d = (f32x4){0.f, 0.f, 0.f, 0.f};
    if (tid < 256) { const f32x4* q = (const f32x4*)(ssq + (size_t)(pm * 256 + tid) * 16); p.a = q[0]; p.b = q[1]; p.c = q[2]; p.d = q[3]; }
}
__device__ __forceinline__ void rstd_pro_store(const RstdPro& p, const PG8_LAS float* rtab, int tid) {
    if (tid < 256) { const f32x4 s = (p.a + p.b) + (p.c + p.d); ((PG8_LAS float*)rtab)[tid] = 1.0f / sqrtf(((s[0] + s[1]) + (s[2] + s[3])) * (1.0f / DM) + NORM_EPS); }
}
struct EpiSwiglu {
    static constexpr bool PERM = true;
    static constexpr bool IDEMP = true;
    typedef RstdPro Pro;
    __device__ __forceinline__ void pro_load(Pro& p, const Unit& u, int tid) const { rstd_pro_load(p, ssq, u.pm, tid); }
    __device__ __forceinline__ void pro_store(const Pro& p, int tid) const { rstd_pro_store(p, rtab, tid); }
    bf16_t* O; const float* ssq; const PG8_LAS float* rtab; int rpm;
    __device__ __forceinline__ void init(f32x4 (&)[2][2][4][2], const Unit&, int, int, int) const {}
    __device__ __forceinline__ bool operator()(f32x4 (&acc)[2][2][4][2], const Unit& u, int wr, int wc, int fr_, int fq_, int lane_) const {
        int lane = lane_; asm volatile("" : "+v"(lane)); lane &= 63; const int fr = lane & 15, fq = lane >> 4;
        float rs[2][4]; get_rstd(rtab, rpm, ssq, u.pm, wr, fr, lane, rs);
        const int col0 = u.pn * 128 + wc * 32 + 8 * fq;
#pragma unroll
        for (int ai = 0; ai < 2; ++ai)
#pragma unroll
            for (int m = 0; m < 4; ++m) { const float r = rs[ai][m]; const size_t row = (size_t)(u.pm * BM + ai * HALF + wr * 64 + m * 16 + fr);
                f32x4 o[2]; const float r2 = r * (-LOG2E), rr = r * r;
#pragma unroll
                for (int n = 0; n < 2; ++n) { const f32x4 g = acc[ai][0][m][n], t = g * r2; f32x4 e, s;
#pragma unroll
                    for (int j = 0; j < 4; ++j) e[j] = fexp2(t[j]);
                    const f32x4 d = e + 1.0f;
#pragma unroll
                    for (int j = 0; j < 4; ++j) s[j] = frcp(d[j]);
                    o[n] = (g * acc[ai][1][m][n]) * (s * rr); }
                *(u32x4*)(O + row * DFF + col0) = pack8(o[0], o[1]); }
        return false;
    }
};
struct EpiResidual {
    static constexpr bool PERM = true;
    static constexpr bool IDEMP = true;
    typedef NoPro Pro;
    __device__ __forceinline__ void pro_load(Pro&, const Unit&, int) const {}
    __device__ __forceinline__ void pro_store(const Pro&, int) const {}
    float* Xout; bf16_t* XB; float* ssq; float scale, inv_scale;
    __device__ __forceinline__ void init(f32x4 (&acc)[2][2][4][2], const Unit& u, int wr, int wc, int lane_) const {
        int lane = lane_; asm volatile("" : "+v"(lane)); lane &= 63; const int fr = lane & 15, fq = lane >> 4;
        const int col0 = u.pn * BM + wc * 32 + 8 * fq;
#pragma unroll
        for (int ai = 0; ai < 2; ++ai)
#pragma unroll
            for (int m = 0; m < 4; ++m) { const bf16_t* xr = XB + (size_t)(u.pm * BM + ai * HALF + wr * 64 + m * 16 + fr) * DM + col0;
#pragma unroll
                for (int bj = 0; bj < 2; ++bj) { const u32x4 w = *(const u32x4*)(xr + bj * HALF);
                    acc[ai][bj][m][0] = (f32x4){hlo(w.x), hhi(w.x), hlo(w.y), hhi(w.y)} * inv_scale; acc[ai][bj][m][1] = (f32x4){hlo(w.z), hhi(w.z), hlo(w.w), hhi(w.w)} * inv_scale; }
                if (m & 1) asm volatile("" ::: "memory"); }
    }
    __device__ __forceinline__ bool operator()(f32x4 (&acc)[2][2][4][2], const Unit& u, int wr, int wc, int fr_, int fq_, int lane_) const {
        int lane = lane_; asm volatile("" : "+v"(lane)); lane &= 63; const int fr = lane & 15, fq = lane >> 4;
        const int col0 = u.pn * BM + wc * 32 + 8 * fq;
#pragma unroll
        for (int ai = 0; ai < 2; ++ai)
#pragma unroll
            for (int m = 0; m < 4; ++m) { const size_t row = (size_t)(u.pm * BM + ai * HALF + wr * 64 + m * 16 + fr); float q = 0.f;
#pragma unroll
                for (int bj = 0; bj < 2; ++bj) {
                    const f32x4 x0 = acc[ai][bj][m][0] * scale, x1 = acc[ai][bj][m][1] * scale;
                    if (Xout) { float* xp = Xout + row * DM + col0 + bj * HALF; *(f32x4*)xp = x0; *(f32x4*)(xp + 4) = x1; }
                    q += (x0[0] * x0[0] + x0[1] * x0[1]) + (x0[2] * x0[2] + x0[3] * x0[3]) + (x1[0] * x1[0] + x1[1] * x1[1]) + (x1[2] * x1[2] + x1[3] * x1[3]);
                    if (!Xout) *(u32x4*)(XB + row * DM + col0 + bj * HALF) = pack8(x0, x1); }
                if (!Xout) { q = xsum32(xsum16(q));
                    if (fq == 0) ssq[row * 16 + u.pn * 4 + wc] = q; } }
        return false;
    }
};
struct EpiSigmoid {
    static constexpr bool PERM = true;
    static constexpr bool IDEMP = true;
    typedef RstdPro Pro;
    __device__ __forceinline__ void pro_load(Pro& p, const Unit& u, int tid) const { rstd_pro_load(p, ssq, u.pm, tid); }
    __device__ __forceinline__ void pro_store(const Pro& p, int tid) const { rstd_pro_store(p, rtab, tid); }
    bf16_t* O; const float* ssq; const PG8_LAS float* rtab; int rpm;
    __device__ __forceinline__ void init(f32x4 (&)[2][2][4][2], const Unit&, int, int, int) const {}
    __device__ __forceinline__ bool operator()(f32x4 (&acc)[2][2][4][2], const Unit& u, int wr, int wc, int fr_, int fq_, int lane_) const {
        int lane = lane_; asm volatile("" : "+v"(lane)); lane &= 63; const int fr = lane & 15, fq = lane >> 4;
        float rs[2][4]; get_rstd(rtab, rpm, ssq, u.pm, wr, fr, lane, rs);
        bf16_t* base = O + (size_t)(u.pn >> 2) * M * DM + (u.pn & 3) * 256 + wc * 32 + 8 * fq;
        const bool recip = (u.pn >> 2) != 0;
#pragma unroll
        for (int ai = 0; ai < 2; ++ai)
#pragma unroll
            for (int m = 0; m < 4; ++m) { const float r = rs[ai][m]; const size_t row = (size_t)(u.pm * BM + ai * HALF + wr * 64 + m * 16 + fr);
#pragma unroll
                for (int bj = 0; bj < 2; ++bj) { f32x4 o[2]; const float r2 = r * (-LOG2E);
#pragma unroll
                    for (int n = 0; n < 2; ++n) { const f32x4 t = acc[ai][bj][m][n] * r2; f32x4 e;
#pragma unroll
                        for (int j = 0; j < 4; ++j) e[j] = fexp2(t[j]);
                        const f32x4 d = e + 1.0f;
                        if (recip) { o[n] = d; } else {
#pragma unroll
                        for (int j = 0; j < 4; ++j) o[n][j] = frcp(d[j]); } }
                    u32x4 w = pack8(o[0], o[1]);
                    if (recip) { w.x = hmin2(w.x, 0x7BFF7BFFu); w.y = hmin2(w.y, 0x7BFF7BFFu); w.z = hmin2(w.z, 0x7BFF7BFFu); w.w = hmin2(w.w, 0x7BFF7BFFu); }
                    else { w.x = hmax2(w.x, 0x00010001u); w.y = hmax2(w.y, 0x00010001u); w.z = hmax2(w.z, 0x00010001u); w.w = hmax2(w.w, 0x00010001u); }
                    *(u32x4*)(base + row * DM + bj * HALF) = w; } }
        return false;
    }
};
struct EpiMerge {
    static constexpr bool PERM = true;
    static constexpr bool IDEMP = false;
    typedef NoPro Pro;
    __device__ __forceinline__ void pro_load(Pro&, const Unit&, int) const {}
    __device__ __forceinline__ void pro_store(const Pro&, int) const {}
    const bf16_t* GT; bf16_t* O;
    __device__ __forceinline__ void init(f32x4 (&)[2][2][4][2], const Unit&, int, int, int) const {}
    __device__ __forceinline__ void fetch(const bf16_t* g, const Unit& u, int ai, int wr, int col0, int fr, u32x4 (&t)[4][2]) const {
#pragma unroll
        for (int m = 0; m < 4; ++m)
#pragma unroll
            for (int bj = 0; bj < 2; ++bj) t[m][bj] = *(const u32x4*)(g + (size_t)(u.pm * BM + ai * HALF + wr * 64 + m * 16 + fr) * DM + col0 + bj * HALF);
    }
    __device__ __forceinline__ bool operator()(f32x4 (&acc)[2][2][4][2], const Unit& u, int wr, int wc, int fr_, int fq_, int lane_) const {
        int lane = lane_; asm volatile("" : "+v"(lane)); lane &= 63; const int fr = lane & 15, fq = lane >> 4;
        const int col0 = u.pn * BM + wc * 32 + 8 * fq; const int s = u.seg;
#pragma unroll
        for (int ai = 0; ai < 2; ++ai) {
            u32x4 t[4][2], t2[4][2];
            fetch(GT + (size_t)s * M * DM, u, ai, wr, col0, fr, t);
            if (s < 2) fetch(GT + (size_t)(s + 1) * M * DM, u, ai, wr, col0, fr, t2);
#pragma unroll
            for (int m = 0; m < 4; ++m)
#pragma unroll
                for (int bj = 0; bj < 2; ++bj) { const u32x4 a = t[m][bj];
                    const float ga[8] = {hlo(a.x), hhi(a.x), hlo(a.y), hhi(a.y), hlo(a.z), hhi(a.z), hlo(a.w), hhi(a.w)};
                    if (s == 0) {
#pragma unroll
                    for (int e = 0; e < 8; ++e) acc[ai][bj][m][e >> 2][e & 3] *= ga[e]; } else {
#pragma unroll
                    for (int e = 0; e < 8; ++e) acc[ai][bj][m][e >> 2][e & 3] *= frcp(ga[e]); } }
            if (s < 2) {
#pragma unroll
                for (int m = 0; m < 4; ++m)
#pragma unroll
                    for (int bj = 0; bj < 2; ++bj) { const u32x4 a = t2[m][bj];
                        const float gb[8] = {hlo(a.x), hhi(a.x), hlo(a.y), hhi(a.y), hlo(a.z), hhi(a.z), hlo(a.w), hhi(a.w)};
#pragma unroll
                        for (int e = 0; e < 8; ++e) acc[ai][bj][m][e >> 2][e & 3] *= gb[e]; }
            } else {
#pragma unroll
                for (int m = 0; m < 4; ++m)
#pragma unroll
                    for (int bj = 0; bj < 2; ++bj) *(u32x4*)(O + (size_t)(u.pm * BM + ai * HALF + wr * 64 + m * 16 + fr) * DM + col0 + bj * HALF) = pack8(acc[ai][bj][m][0], acc[ai][bj][m][1]);
            }
            asm volatile("" ::: "memory");
        }
        return s < 2;
    }
};
struct EpiInProj {
    static constexpr bool PERM = true;
    static constexpr bool IDEMP = true;
    typedef RstdPro Pro;
    __device__ __forceinline__ void pro_load(Pro& p, const Unit& u, int tid) const { rstd_pro_load(p, ssq, u.pm, tid); }
    __device__ __forceinline__ void pro_store(const Pro& p, int tid) const { rstd_pro_store(p, rtab, tid); }
    unsigned char* ws; const float* ssq; const bf16_t* rope; const PG8_LAS float* rtab; int rpm;
    const float* aq_n; const float* ak_n; const float* bq_n; const float* bk_n; const float* gbias;
    __device__ __forceinline__ void init(f32x4 (&)[2][2][4][2], const Unit&, int, int, int) const {}
    __device__ __forceinline__ bool operator()(f32x4 (&acc)[2][2][4][2], const Unit& u, int wr, int wc, int fr_, int fq_, int lane_) const {
        int lane = lane_; asm volatile("" : "+v"(lane)); lane &= 63; const int fr = lane & 15, fq = lane >> 4;
        float rs[2][4]; get_rstd(rtab, rpm, ssq, u.pm, wr, fr, lane, rs);
        const int t = u.pn;
        int mode, pitch, colA, colB; bf16_t* dst; const float* gain = nullptr; float sc = 1.f; bool act = false, asbf = false;
        if (t < 18) { const int w = t / 6, tt = t % 6, g = tt >> 1, hd = ((tt & 1) * 4 + wc) * 64 + 8 * fq;
            dst = (bf16_t*)(ws + (w == 0 ? (g == 0 ? WS_AQ0 : (g == 1 ? WS_AQ1 : WS_AQ2)) : (w == 1 ? WS_AK0 + (size_t)g * 4 * UU : WS_AV0 + (size_t)g * 4 * UU)));
            pitch = 512; colA = hd; colB = hd + 32; mode = (w == 2) ? 1 : 0; gain = (w == 0) ? aq_n : ak_n; sc = (w == 0) ? QSCALE : 1.f; }
        else if (t < 20) { dst = (bf16_t*)(ws + WS_BQ); pitch = 512; colA = ((t - 18) * 4 + wc) * 64 + 8 * fq; colB = colA + 32; mode = 0; gain = bq_n; sc = QSCALE; }
        else if (t == 20) { pitch = 128; colA = (wc & 1) * 64 + 8 * fq; colB = colA + 32;
            if (wc < 2) { dst = (bf16_t*)(ws + WS_BK); mode = 0; gain = bk_n; } else { dst = (bf16_t*)(ws + WS_BV); mode = 1; } }
        else { colA = wc * 32 + 8 * fq; colB = colA + 128; mode = 2;
            if (t == 21) { dst = (bf16_t*)(ws + WS_CQ); pitch = 256; sc = 0.125f; mode = 4; }
            else if (t == 22) { dst = (bf16_t*)(ws + WS_CK); pitch = 256; mode = 4; }
            else if (t < 25) { dst = (bf16_t*)(ws + WS_CV); pitch = 512; colA += (t - 23) * 256; colB += (t - 23) * 256; asbf = true; }
            else if (t == 25) { dst = (bf16_t*)(ws + WS_LOGG); pitch = 256; mode = 3; }
            else { dst = (bf16_t*)(ws + WS_CR); pitch = 512; colA += (t - 26) * 256; colB += (t - 26) * 256; act = true; } }
        if (mode == 0) {
            f32x4 gA[2], gB[2];
#pragma unroll
            for (int n = 0; n < 2; ++n) { gA[n] = *(const f32x4*)(gain + 8 * fq + 4 * n); gB[n] = *(const f32x4*)(gain + 32 + 8 * fq + 4 * n); }
#pragma unroll
            for (int ai = 0; ai < 2; ++ai) {
            u32x4 cw[4], sw[4];
#pragma unroll
            for (int m = 0; m < 4; ++m) { const bf16_t* rp = rope + (size_t)(u.pm * BM + ai * HALF + wr * 64 + m * 16 + fr) * 64 + fq * 16; cw[m] = *(const u32x4*)rp; sw[m] = *(const u32x4*)(rp + 8); }
#pragma unroll
                for (int m = 0; m < 4; ++m) { const float r = rs[ai][m]; const size_t row = (size_t)(u.pm * BM + ai * HALF + wr * 64 + m * 16 + fr);
                    f32x4 a[2], b[2]; float ss = 0.f;
#pragma unroll
                    for (int n = 0; n < 2; ++n) { a[n] = acc[ai][0][m][n]; b[n] = acc[ai][1][m][n];
                        ss += (a[n][0] * a[n][0] + a[n][1] * a[n][1]) + (a[n][2] * a[n][2] + a[n][3] * a[n][3]) + (b[n][0] * b[n][0] + b[n][1] * b[n][1]) + (b[n][2] * b[n][2] + b[n][3] * b[n][3]); }
                    ss = xsum32(xsum16(ss));
                    const float rn = r * sc * __builtin_amdgcn_rsqf(ss * (r * r) * (1.0f / 64.0f) + NORM_EPS);
                    const u32x4 cq = cw[m], sq = sw[m];
                    const f32x4 cs[2] = {(f32x4){hlo16(cq.x), hhi16(cq.x), hlo16(cq.y), hhi16(cq.y)}, (f32x4){hlo16(cq.z), hhi16(cq.z), hlo16(cq.w), hhi16(cq.w)}};
                    const f32x4 sn[2] = {(f32x4){hlo16(sq.x), hhi16(sq.x), hlo16(sq.y), hhi16(sq.y)}, (f32x4){hlo16(sq.z), hhi16(sq.z), hlo16(sq.w), hhi16(sq.w)}};
                    f32x4 oa[2], ob[2];
#pragma unroll
                    for (int n = 0; n < 2; ++n) { const f32x4 y1 = a[n] * (gA[n] * rn), y2 = b[n] * (gB[n] * rn);
                        oa[n] = y1 * cs[n] - y2 * sn[n]; ob[n] = y2 * cs[n] + y1 * sn[n]; }
                    *(u32x4*)(dst + row * pitch + colA) = pack8(oa[0], oa[1]); *(u32x4*)(dst + row * pitch + colB) = pack8(ob[0], ob[1]); }
            asm volatile("" ::: "memory"); }
        } else if (mode == 3) {
            f32x4 bA[2], bB[2];
#pragma unroll
            for (int n = 0; n < 2; ++n) { bA[n] = *(const f32x4*)(gbias + colA + 4 * n); bB[n] = *(const f32x4*)(gbias + colB + 4 * n); }
#pragma unroll
            for (int ai = 0; ai < 2; ++ai)
#pragma unroll
                for (int m = 0; m < 4; ++m) { const float r = rs[ai][m]; const size_t row = (size_t)(u.pm * BM + ai * HALF + wr * 64 + m * 16 + fr);
#pragma unroll
                    for (int bj = 0; bj < 2; ++bj) { float v[8];
#pragma unroll
                        for (int e = 0; e < 8; ++e) { const float x = acc[ai][bj][m][e >> 2][e & 3] * r + (bj == 0 ? bA[e >> 2][e & 3] : bB[e >> 2][e & 3]);
                            v[e] = (fminf(x, 0.f) - __builtin_amdgcn_logf(1.0f + fexp(-fabsf(x))) * 0.6931471805599453f) * (1.0f / 16.0f); }
                        u32x4 w; { h16x2 p0 = {(_Float16)v[0], (_Float16)v[1]}, p1 = {(_Float16)v[2], (_Float16)v[3]}, p2 = {(_Float16)v[4], (_Float16)v[5]}, p3 = {(_Float16)v[6], (_Float16)v[7]};
                            w.x = __builtin_bit_cast(unsigned, p0); w.y = __builtin_bit_cast(unsigned, p1); w.z = __builtin_bit_cast(unsigned, p2); w.w = __builtin_bit_cast(unsigned, p3); }
                        *(u32x4*)(dst + row * pitch + (bj == 0 ? colA : colB)) = w; } }
        } else if (mode == 4) {
#pragma unroll
            for (int ai = 0; ai < 2; ++ai)
#pragma unroll
                for (int m = 0; m < 4; ++m) { const float r = rs[ai][m] * sc; const size_t row = (size_t)(u.pm * BM + ai * HALF + wr * 64 + m * 16 + fr);
#pragma unroll
                    for (int bj = 0; bj < 2; ++bj) { float v[8];
#pragma unroll
                        for (int e = 0; e < 8; ++e) v[e] = acc[ai][bj][m][e >> 2][e & 3] * r;
                        u32x4 w; { h16x2 p0 = {(_Float16)v[0], (_Float16)v[1]}, p1 = {(_Float16)v[2], (_Float16)v[3]}, p2 = {(_Float16)v[4], (_Float16)v[5]}, p3 = {(_Float16)v[6], (_Float16)v[7]};
                            w.x = __builtin_bit_cast(unsigned, p0); w.y = __builtin_bit_cast(unsigned, p1); w.z = __builtin_bit_cast(unsigned, p2); w.w = __builtin_bit_cast(unsigned, p3); }
                        *(u32x4*)(dst + row * pitch + (bj == 0 ? colA : colB)) = w; } }
        } else {
#pragma unroll
            for (int ai = 0; ai < 2; ++ai)
#pragma unroll
                for (int m = 0; m < 4; ++m) { const float r = rs[ai][m] * sc; const size_t row = (size_t)(u.pm * BM + ai * HALF + wr * 64 + m * 16 + fr);
#pragma unroll
                    for (int bj = 0; bj < 2; ++bj) { f32x4 o[2];
#pragma unroll
                        for (int n = 0; n < 2; ++n) { o[n] = acc[ai][bj][m][n] * r;
                            if (act) {
#pragma unroll
                                for (int j = 0; j < 4; ++j) o[n][j] = siluf_(o[n][j]); } }
                        *(u32x4*)(dst + row * pitch + (bj == 0 ? colA : colB)) = asbf ? pack8_bf(o[0], o[1]) : pack8(o[0], o[1]); } }
        }
        return false;
    }
};
}

__constant__ float ROPE_INV[32] = {
    1.000000000e+00f, 7.498942614e-01f, 5.623413324e-01f, 4.216965139e-01f, 3.162277639e-01f, 2.371373773e-01f, 1.778279394e-01f, 1.333521307e-01f,
    1.000000015e-01f, 7.498941571e-02f, 5.623413250e-02f, 4.216965288e-02f, 3.162277490e-02f, 2.371373773e-02f, 1.778279431e-02f, 1.333521493e-02f,
    9.999999776e-03f, 7.498941850e-03f, 5.623413250e-03f, 4.216964822e-03f, 3.162277630e-03f, 2.371373586e-03f, 1.778279431e-03f, 1.333521446e-03f,
    1.000000047e-03f, 7.498942432e-04f, 5.623413017e-04f, 4.216965172e-04f, 3.162277571e-04f, 2.371373703e-04f, 1.778279402e-04f, 1.333521504e-04f};

struct ConvJob { const float* W; int ldw; int K; bf16* WT; int nrows; const float* gain; int mode; int base; const float* gate_up; };
__device__ __forceinline__ int conv_src0(int mode, int base, int n0) {
    if (mode == 0) return base + n0;
    const int t = n0 >> 8, c = n0 & 255;
    if (mode == 1) return c < 128 ? t * 128 + c : DFF + t * 128 + (c - 128);
    const int bj = c >> 7, wc = (c >> 5) & 3;
    if (t < 18) return (t / 6) * 1536 + (4 * (t % 6) + wc) * 64 + 32 * bj;
    if (t < 20) return 4608 + (4 * (t - 18) + wc) * 64 + 32 * bj;
    if (t == 20) return 5120 + wc * 64 + 32 * bj;
    if (t == 21) return 5376 + c;
    if (t == 22) return 5632 + c;
    if (t < 25) return 5888 + 256 * (t - 23) + c;
    if (t == 25) return -1;
    return 6416 + 256 * (t - 26) + c;
}
struct ConvRegs { f32x4 v[8]; int n0, kr, c; };
__device__ __forceinline__ void conv_load(const ConvJob& J, int item, int lane, ConvRegs& R) {
    const int nblk = J.nrows / 32, kb = item / nblk, nb = item % nblk, k0 = 64 * kb, n0 = 32 * nb;
    const int src0 = conv_src0(J.mode, J.base, n0), g = lane >> 3, c = lane & 7, kr = k0 + 8 * g;
    R.n0 = n0; R.kr = kr; R.c = c;
    if (src0 >= 0) {
        const float* wp = J.W + (size_t)kr * J.ldw + src0 + 4 * c;
#pragma unroll
        for (int i = 0; i < 8; ++i) R.v[i] = __builtin_nontemporal_load((const f32x4*)(wp + (size_t)i * J.ldw));
    } else {
        f32x4 ug[16];
#pragma unroll
        for (int r = 0; r < 16; ++r) ug[r] = *(const f32x4*)(J.gate_up + r * 256 + (n0 & 255) + 4 * c);
#pragma unroll
        for (int i = 0; i < 8; ++i) { const f32x4* wr = (const f32x4*)(J.W + (size_t)(kr + i) * J.ldw + 6400); f32x4 s = {0.f, 0.f, 0.f, 0.f};
#pragma unroll
            for (int q = 0; q < 4; ++q) { const f32x4 w4 = wr[q]; s += ug[4 * q + 0] * w4[0]; s += ug[4 * q + 1] * w4[1]; s += ug[4 * q + 2] * w4[2]; s += ug[4 * q + 3] * w4[3]; }
            R.v[i] = s; }
    }
}
__device__ __forceinline__ void conv_store(const ConvJob& J, ConvRegs& R) {
    if (J.gain) { const f32x4 g0 = *(const f32x4*)(J.gain + R.kr), g1 = *(const f32x4*)(J.gain + R.kr + 4);
#pragma unroll
        for (int i = 0; i < 4; ++i) { R.v[i] = R.v[i] * g0[i]; R.v[4 + i] = R.v[4 + i] * g1[i]; } }
#pragma unroll
    for (int j = 0; j < 4; ++j) { v4u o; o.x = pk2(R.v[0][j], R.v[1][j]); o.y = pk2(R.v[2][j], R.v[3][j]); o.z = pk2(R.v[4][j], R.v[5][j]); o.w = pk2(R.v[6][j], R.v[7][j]);
        *(GAS v4u*)(J.WT + (size_t)(R.n0 + 4 * R.c + j) * J.K + R.kr) = o; }
}
__device__ __forceinline__ void conv_job(Frame& F, const ConvJob& J) {
    const int gw = F.vcu * NWAVES + F.wave, NGW = F.G * NWAVES, nitems = (J.nrows / 32) * (J.K / 64);
    for (int it = gw; it < nitems; it += 2 * NGW) {
        ConvRegs A, B; conv_load(J, it, F.lane, A);
        const bool two = it + NGW < nitems; if (two) conv_load(J, it + NGW, F.lane, B);
        conv_store(J, A); if (two) conv_store(J, B);
    }
}
__device__ __forceinline__ void conv_set(Frame& F, int set, int l) {
    if (set == 0 || set == 4) { ConvJob J{inptr(F, set == 0 ? 3 : 18) + (size_t)l * DM * 2 * DFF, 2 * DFF, DM, (bf16*)(F.ws + WS_S1), 2 * DFF, inptr(F, set == 0 ? 2 : 17) + (size_t)l * DM, 1, 0, nullptr}; conv_job(F, J); }
    else if (set == 1 || set == 5) { ConvJob J{inptr(F, set == 1 ? 4 : 19) + (size_t)l * DFF * DM, DM, DFF, (bf16*)(F.ws + WS_S2), DM, nullptr, 0, 0, nullptr}; conv_job(F, J); }
    else if (set == 2) { ConvJob J{inptr(F, 6) + (size_t)l * DM * INW, INW, DM, (bf16*)(F.ws + WS_STATE), 7168, inptr(F, 5) + (size_t)l * DM, 2, 0, inptr(F, 12) + (size_t)l * 16 * 256}; conv_job(F, J); }
    else {
        { ConvJob J{inptr(F, 6) + (size_t)l * DM * INW, INW, DM, (bf16*)(F.ws + WS_WG), 3072, inptr(F, 5) + (size_t)l * DM, 0, 6928, nullptr}; conv_job(F, J); }
        for (int i = 0; i < 3; ++i) { ConvJob J{inptr(F, 15) + ((size_t)l * 3 + i) * 512 * DM, DM, 512, (bf16*)(F.ws + WS_WB) + (size_t)i * DM * 512, DM, nullptr, 0, 0, nullptr}; conv_job(F, J); }
        { ConvJob J{inptr(F, 16) + (size_t)l * DM * DM, DM, DM, (bf16*)(F.ws + WS_WO), DM, nullptr, 0, 0, nullptr}; conv_job(F, J); }
    }
}

__device__ __forceinline__ void conv_one(Frame& F, int set, int l, int idx) {
    ConvJob J;
    if (set == 0 || set == 4) J = ConvJob{inptr(F, set == 0 ? 3 : 18) + (size_t)l * DM * 2 * DFF, 2 * DFF, DM, (bf16*)(F.ws + WS_S1), 2 * DFF, inptr(F, set == 0 ? 2 : 17) + (size_t)l * DM, 1, 0, nullptr};
    else if (set == 1 || set == 5) J = ConvJob{inptr(F, set == 1 ? 4 : 19) + (size_t)l * DFF * DM, DM, DFF, (bf16*)(F.ws + WS_S2), DM, nullptr, 0, 0, nullptr};
    else if (set == 2) J = ConvJob{inptr(F, 6) + (size_t)l * DM * INW, INW, DM, (bf16*)(F.ws + WS_STATE), 7168, inptr(F, 5) + (size_t)l * DM, 2, 0, inptr(F, 12) + (size_t)l * 16 * 256};
    else if (idx < 1536) J = ConvJob{inptr(F, 6) + (size_t)l * DM * INW, INW, DM, (bf16*)(F.ws + WS_WG), 3072, inptr(F, 5) + (size_t)l * DM, 0, 6928, nullptr};
    else if (idx < 2304) { const int i = (idx - 1536) >> 8; idx = (idx - 1536) & 255; J = ConvJob{inptr(F, 15) + ((size_t)l * 3 + i) * 512 * DM, DM, 512, (bf16*)(F.ws + WS_WB) + (size_t)i * DM * 512, DM, nullptr, 0, 0, nullptr}; }
    else { idx -= 2304; J = ConvJob{inptr(F, 16) + (size_t)l * DM * DM, DM, DM, (bf16*)(F.ws + WS_WO), DM, nullptr, 0, 0, nullptr}; }
    ConvRegs R; conv_load(J, idx, F.lane, R); conv_store(J, R);
}
constexpr int CONV_N0 = 2816, CONV_N1 = 1408, CONV_N2 = 3584, CONV_N3 = 2816;
__device__ __forceinline__ void shadow_conv(Frame& F, int ph) {
    const int slot = F.vcu * (NWAVES - 1) + (F.wave - 1), nslot = F.G * (NWAVES - 1);
    int set = -1, l = 0, j = 0, nb = 2;
    switch (ph) {
        case 2:  set = 3; l = 0; j = 0; break;          case 3:  set = 3; l = 0; j = 1; break;
        case 11: set = 3; l = 1; j = 0; break;          case 12: set = 3; l = 1; j = 1; break;
        case 4:  set = 4; l = 0; j = 0; break;          case 5:  set = 4; l = 0; j = 1; break;
        case 6:  set = 5; l = 0; j = 0; nb = 1; break;
        case 13: set = 4; l = 1; j = 0; break;          case 14: set = 4; l = 1; j = 1; break;
        case 15: set = 5; l = 1; j = 0; nb = 1; break;
        default: break; }
    if (set < 0 || l >= NLAYER) return;
    const int n = (set == 2) ? CONV_N2 : (set == 3 ? CONV_N3 : (set == 4 ? CONV_N0 : CONV_N1)), quota = (n + nb - 1) / nb, lo = j * quota, hi = (lo + quota < n) ? lo + quota : n;
    for (int v = lo + slot; v < hi; v += nslot) conv_one(F, set, l, v);
}

__device__ __forceinline__ void tail_conv_set(Frame& F, int set, int l, int n, int idle_idx, int n_idle) {
    for (int it = idle_idx * NWAVES + F.wave; it < n; it += n_idle * NWAVES) conv_one(F, set, l, it);
}
__device__ __forceinline__ void tail_conv(Frame& F, int ph, int idle_idx, int n_idle) {
    if (ph == 1) { tail_conv_set(F, 1, 0, CONV_N1, idle_idx, n_idle); tail_conv_set(F, 2, 0, CONV_N2, idle_idx, n_idle); }
    else if (ph == 9 && NLAYER > 1) { tail_conv_set(F, 2, 1, CONV_N2, idle_idx, n_idle); }
    else if (ph == 11) { tail_conv_set(F, 1, 1, CONV_N1, idle_idx, n_idle); }
}

__device__ __forceinline__ void p0_rows(Frame& F) {
    const int gw = F.vcu * NWAVES + F.wave, NGW = F.G * NWAVES;
    const float* x = inptr(F, 0); const int* pos = (const int*)inptr(F, 1);
    bf16* XB = (bf16*)(F.ws + WS_XB); float* ssq = (float*)(F.ws + WS_SSQ);
    for (int m0 = gw; m0 < M; m0 += 4 * NGW) {
        f32x4 v[4][4];
#pragma unroll
        for (int q = 0; q < 4; ++q) { const int m = m0 + q * NGW; if (m < M) { const GAS f32x4* xr = (const GAS f32x4*)(x + (size_t)m * DM) + F.lane;
#pragma unroll
                for (int j = 0; j < 4; ++j) v[q][j] = __builtin_nontemporal_load(xr + 64 * j); } }
#pragma unroll
        for (int q = 0; q < 4; ++q) { const int m = m0 + q * NGW; if (m >= M) break;
            GAS v2u* o8 = (GAS v2u*)(XB + (size_t)m * DM) + F.lane; float s = 0.f;
#pragma unroll
            for (int j = 0; j < 4; ++j) { const f32x4 t = v[q][j]; s += (t.x * t.x + t.y * t.y) + (t.z * t.z + t.w * t.w);
                v2u w; w.x = pk2(t.x, t.y); w.y = pk2(t.z, t.w); o8[64 * j] = w; }
            s = wave_sum(s);
            if (F.lane < 16) ssq[(size_t)m * 16 + F.lane] = (F.lane == 0) ? s : 0.f;
            if (F.lane < 32) { const float ang = (float)pos[m] * ROPE_INV[F.lane];
                const double rev = (double)ang * 0.15915494309189535; const float fr = (float)(rev - __builtin_rint(rev));
                bf16* rp = (bf16*)(F.ws + WS_COS) + (size_t)m * 64 + (F.lane >> 3) * 16 + (F.lane & 7);
                rp[0] = __builtin_bit_cast(unsigned short, (_Float16)__builtin_amdgcn_cosf(fr)); rp[8] = __builtin_bit_cast(unsigned short, (_Float16)__builtin_amdgcn_sinf(fr)); } }
    }
}

typedef float f32x16 __attribute__((ext_vector_type(16)));
typedef _Float16 h16x8 __attribute__((ext_vector_type(8)));
typedef short v4i16_t __attribute__((ext_vector_type(4)));
constexpr int ATT_BIAS_OFF = RSTD_OFF + 2048;
static_assert(ATT_BIAS_OFF + 12288 <= LDS_BYTES && ATT_BIAS_OFF % 16 == 0, "attention mask tables");
constexpr int ATT_K_OFF = 0, ATT_V_OFF = 49152, ATT_OST_OFF = 98304, ATT_SCR_OFF = RSTD_OFF;
struct BandUnit { const bf16* Q; const bf16* K; const bf16* V; bf16* O; float* LSE; int pq, pk, d, q0, win; size_t row0; float sink2; };
__device__ __forceinline__ int crow16(int r, int hi) { return (r & 3) + 8 * (r >> 2) + 4 * hi; }
struct BandRegs { v4u kr[6], vr[6]; bf16x8 qr[4]; };
__device__ __forceinline__ void band_load(Frame& F, const BandUnit& U, BandRegs& R) {
    const int tid = F.tid, c = tid & 7, i32 = F.lane & 31, hi = F.lane >> 5;
#pragma unroll
    for (int i = 0; i < 6; ++i) { const int rr = (tid >> 3) + 64 * i, ci = U.q0 - 128 + rr;
        if (ci >= 0) { const size_t off = (U.row0 + (size_t)ci * U.d) * U.pk + c * 8; R.kr[i] = *(const v4u*)(U.K + off); R.vr[i] = *(const v4u*)(U.V + off); }
        else { R.kr[i] = (v4u){0u, 0u, 0u, 0u}; R.vr[i] = (v4u){0u, 0u, 0u, 0u}; } }
    const size_t qtok = U.row0 + (size_t)(U.q0 + 32 * F.wave + i32) * U.d;
#pragma unroll
    for (int ks = 0; ks < 4; ++ks) R.qr[ks] = *(const bf16x8*)(U.Q + qtok * U.pq + 16 * ks + 8 * hi);
}
__device__ __forceinline__ void band_unit(Frame& F, const BandUnit& U, BandRegs& R, bool has_next, const BandUnit& Un, BandRegs& Rn) {
    const int tid = F.tid, lane = F.lane, w = F.wave, i32 = lane & 31, hi = lane >> 5;
    LAS unsigned char* lds = F.lds;
    { const int c = tid & 7;
#pragma unroll
        for (int i = 0; i < 6; ++i) { const int rr = (tid >> 3) + 64 * i;
            *(LAS v4u*)(lds + ATT_K_OFF + rr * 128 + ((c ^ (rr & 7)) << 4)) = R.kr[i];
            *(LAS v4u*)(lds + ATT_V_OFF + rr * 128 + ((((c >> 1) ^ (((rr >> 1) & 1) << 1)) << 5) | ((c & 1) << 4))) = R.vr[i]; } }
    const size_t qtok = U.row0 + (size_t)(U.q0 + 32 * w + i32) * U.d;
    __syncthreads();
    if (has_next) band_load(F, Un, Rn);
    f32x16 p[5];
#pragma unroll
    for (int kt = 0; kt < 5; ++kt) { const int row = 32 * w + 32 * kt + i32;
        if (kt == 0 || kt == 4) {
            const LAS f32x4* bt = (const LAS f32x4*)(lds + ATT_BIAS_OFF + (kt == 4 ? 8192 : (U.win == 128 ? 0 : 4096))) + lane;
#pragma unroll
            for (int q4 = 0; q4 < 4; ++q4) { const f32x4 v = bt[q4 * 64]; p[kt][4 * q4 + 0] = v[0]; p[kt][4 * q4 + 1] = v[1]; p[kt][4 * q4 + 2] = v[2]; p[kt][4 * q4 + 3] = v[3]; }
        } else {
#pragma unroll
        for (int r = 0; r < 16; ++r) p[kt][r] = 0.f; }
#pragma unroll
        for (int ks = 0; ks < 4; ++ks) { const bf16x8 kf = *(const LAS bf16x8*)(lds + ATT_K_OFF + row * 128 + (((2 * ks + hi) ^ (row & 7)) << 4));
            p[kt] = MK_BF16 ? __builtin_amdgcn_mfma_f32_32x32x16_bf16(kf, R.qr[ks], p[kt], 0, 0, 0) : __builtin_amdgcn_mfma_f32_32x32x16_f16(__builtin_bit_cast(h16x8, kf), __builtin_bit_cast(h16x8, R.qr[ks]), p[kt], 0, 0, 0); } }
    if (U.q0 == 0 && w < 4) {
#pragma unroll
        for (int kt = 0; kt < 4; ++kt)
#pragma unroll
            for (int r = 0; r < 16; ++r) if (32 * w - 128 + 32 * kt + crow16(r, hi) < 0) p[kt][r] = -INFINITY; }
    float mx = U.sink2;
#pragma unroll
    for (int kt = 0; kt < 5; ++kt)
#pragma unroll
        for (int r = 0; r < 16; ++r) mx = fmaxf(mx, p[kt][r]);
    mx = fmaxf(mx, __shfl_xor(mx, 32));
    float ls = 0.f;
#pragma unroll
    for (int kt = 0; kt < 5; ++kt)
#pragma unroll
        for (int r = 0; r < 16; ++r) { p[kt][r] = fexp2(p[kt][r] - mx); ls += p[kt][r]; }
    ls += __shfl_xor(ls, 32);
    ls += fexp2(U.sink2 - mx);
    f32x16 o[2];
#pragma unroll
    for (int r = 0; r < 16; ++r) { o[0][r] = 0.f; o[1][r] = 0.f; }
    const int q_ = (lane & 15) >> 2;
    const int vbase = ATT_V_OFF + (32 * w + 4 * hi + q_) * 128 + 8 * (lane & 3);
    const int gsw = ((q_ >> 1) & 1) << 1, dh = (lane >> 4) & 1;
#pragma unroll
    for (int kt = 0; kt < 5; ++kt)
#pragma unroll
        for (int s = 0; s < 2; ++s) {
            v4u pw; pw.x = pg8::cvt_pk_h(p[kt][8 * s + 0], p[kt][8 * s + 1]); pw.y = pg8::cvt_pk_h(p[kt][8 * s + 2], p[kt][8 * s + 3]);
            pw.z = pg8::cvt_pk_h(p[kt][8 * s + 4], p[kt][8 * s + 5]); pw.w = pg8::cvt_pk_h(p[kt][8 * s + 6], p[kt][8 * s + 7]);
            const bf16x8 pf = __builtin_bit_cast(bf16x8, pw);
#pragma unroll
            for (int db = 0; db < 2; ++db) { const int a = vbase + (32 * kt + 16 * s) * 128 + ((((2 * db + dh) ^ gsw)) << 5);
                const v4i16_t lo = __builtin_amdgcn_ds_read_tr16_b64_v4i16((LAS v4i16_t*)(lds + a)), hv = __builtin_amdgcn_ds_read_tr16_b64_v4i16((LAS v4i16_t*)(lds + a + 8 * 128));
                const bf16x8 vf = {lo[0], lo[1], lo[2], lo[3], hv[0], hv[1], hv[2], hv[3]};
                o[db] = MK_BF16 ? __builtin_amdgcn_mfma_f32_32x32x16_bf16(pf, vf, o[db], 0, 0, 0) : __builtin_amdgcn_mfma_f32_32x32x16_f16(__builtin_bit_cast(h16x8, pf), __builtin_bit_cast(h16x8, vf), o[db], 0, 0, 0); } }
    LAS float* scr = (LAS float*)(lds + ATT_SCR_OFF) + w * 64;
    if (hi == 0) { scr[i32] = frcp(ls); if (U.LSE) U.LSE[qtok * 8] = mx + __builtin_amdgcn_logf(ls); }
    LDS_WAIT();
    LAS bf16* ost = (LAS bf16*)(lds + ATT_OST_OFF) + w * 2048;
#pragma unroll
    for (int r = 0; r < 16; ++r) { const int qi = crow16(r, hi); const float li = scr[qi];
        ost[qi * 64 + i32] = (bf16)f2h(o[0][r] * li); ost[qi * 64 + 32 + i32] = (bf16)f2h(o[1][r] * li); }
    LDS_WAIT();
#pragma unroll
    for (int i = 0; i < 4; ++i) { const int qi = i * 8 + (lane >> 3), ch = lane & 7; const v4u v = *(const LAS v4u*)(ost + qi * 64 + ch * 8);
        *(v4u*)(U.O + (U.row0 + (size_t)(U.q0 + 32 * w + qi) * U.d) * U.pq + ch * 8) = v; }
    __syncthreads();
}
__device__ __forceinline__ void band_make(Frame& F, int u, const float* sinks, BandUnit& U) {
    if (u < 1536) { const int t32 = u & 31, h = (u >> 5) & 7, g = (u >> 8) % 3, b = u / 768, d = (g == 0) ? 1 : (g == 1 ? 4 : 16), tpc = 32 / d, cls = t32 / tpc;
        bf16* q = (bf16*)(F.ws + (g == 0 ? WS_AQ0 : (g == 1 ? WS_AQ1 : WS_AQ2))) + h * 64;
        U.Q = q; U.O = q; U.K = (const bf16*)(F.ws + WS_AK0 + (size_t)g * 4 * UU) + h * 64; U.V = (const bf16*)(F.ws + WS_AV0 + (size_t)g * 4 * UU) + h * 64;
        U.LSE = (float*)(F.ws + WS_LSE) + (size_t)g * M * 8 + h; U.pq = 512; U.pk = 512; U.d = d; U.q0 = (t32 % tpc) * 256; U.win = 128; U.row0 = (size_t)b * SEQ + cls; U.sink2 = -INFINITY;
    } else { const int ub = u - 1536, t32 = ub & 31, hq = (ub >> 5) & 7, b = ub >> 8;
        bf16* q = (bf16*)(F.ws + WS_BQ) + hq * 64;
        U.Q = q; U.O = q; U.K = (const bf16*)(F.ws + WS_BK) + (hq >> 2) * 64; U.V = (const bf16*)(F.ws + WS_BV) + (hq >> 2) * 64;
        U.LSE = nullptr; U.pq = 512; U.pk = 128; U.d = 1; U.q0 = t32 * 256; U.win = 127; U.row0 = (size_t)b * SEQ; U.sink2 = sinks[hq] * LOG2E; }
}
__device__ __forceinline__ void attn_phase(Frame& F, int l) {
    const float* sinks = inptr(F, 11) + l * 8;
    int u = F.vcu; if (u >= 2048) return;
    BandUnit U, Un; BandRegs R, Rn;
    band_make(F, u, sinks, U); band_load(F, U, R);
    if (F.wave == 0) { const int lane = F.lane, i32 = lane & 31, hi = lane >> 5;
#pragma unroll
        for (int q4 = 0; q4 < 4; ++q4) { f32x4 a, b, c;
#pragma unroll
            for (int e = 0; e < 4; ++e) { const int j = crow16(4 * q4 + e, hi); a[e] = (j < i32) ? -INFINITY : 0.f; b[e] = (j < i32 + 1) ? -INFINITY : 0.f; c[e] = (j > i32) ? -INFINITY : 0.f; }
            LAS f32x4* bt = (LAS f32x4*)(F.lds + ATT_BIAS_OFF) + q4 * 64 + lane; bt[0] = a; bt[256] = b; bt[512] = c; } }
    for (;;) {
        const int nu = u + F.G; const bool has_next = nu < 2048;
        if (has_next) band_make(F, nu, sinks, Un); else Un = U;
        band_unit(F, U, R, has_next, Un, Rn);
        if (!has_next) break;
        U = Un; R = Rn; u = nu;
    }
}
__device__ __forceinline__ void amerge_phase(Frame& F) {
    const float* LSE = (const float*)(F.ws + WS_LSE);
    const int step = F.G * 512, N = M * 64;
    v4u a, b, cc; float l0, l1, l2;
#define AM_FETCH(it_) do { const int row_ = (it_) >> 6, h_ = ((it_) >> 3) & 7, c_ = (it_) & 7; const size_t off_ = (size_t)row_ * 512 + h_ * 64 + c_ * 8; \
        l0 = LSE[(size_t)row_ * 8 + h_]; l1 = LSE[(size_t)M * 8 + (size_t)row_ * 8 + h_]; l2 = LSE[(size_t)2 * M * 8 + (size_t)row_ * 8 + h_]; \
        a = *(const v4u*)((const bf16*)(F.ws + WS_AQ0) + off_); b = *(const v4u*)((const bf16*)(F.ws + WS_AQ1) + off_); cc = *(const v4u*)((const bf16*)(F.ws + WS_AQ2) + off_); } while (0)
    int it = F.vcu * 512 + F.tid;
    if (it < N) AM_FETCH(it);
    for (; it < N; it += step) {
        const int row = it >> 6, h = (it >> 3) & 7, c = it & 7; const size_t off = (size_t)row * 512 + h * 64 + c * 8;
        const v4u a0 = a, b0 = b, c0 = cc; const float m0 = l0, m1 = l1, m2 = l2;
        if (it + step < N) AM_FETCH(it + step);
        const float mx = fmaxf(m0, fmaxf(m1, m2)); float w0 = fexp2(m0 - mx), w1 = fexp2(m1 - mx), w2 = fexp2(m2 - mx); const float inv = frcp(w0 + w1 + w2); w0 *= inv; w1 *= inv; w2 *= inv;
        v4u o;
        o.x = pk2(w0 * hlo(a0.x) + w1 * hlo(b0.x) + w2 * hlo(c0.x), w0 * hhi(a0.x) + w1 * hhi(b0.x) + w2 * hhi(c0.x));
        o.y = pk2(w0 * hlo(a0.y) + w1 * hlo(b0.y) + w2 * hlo(c0.y), w0 * hhi(a0.y) + w1 * hhi(b0.y) + w2 * hhi(c0.y));
        o.z = pk2(w0 * hlo(a0.z) + w1 * hlo(b0.z) + w2 * hlo(c0.z), w0 * hhi(a0.z) + w1 * hhi(b0.z) + w2 * hhi(c0.z));
        o.w = pk2(w0 * hlo(a0.w) + w1 * hlo(b0.w) + w2 * hlo(c0.w), w0 * hhi(a0.w) + w1 * hhi(b0.w) + w2 * hhi(c0.w));
        *(v4u*)((bf16*)(F.ws + WS_AQ0) + off) = o;
    }
#undef AM_FETCH
}

constexpr int GL_LG = 0, GL_K = 8192, GL_Q = 16384, GL_V = 24576, GL_S = 40960, GL_SCR = 57344;
__device__ __forceinline__ int off128(int row, int col) { return row * 128 + ((((col >> 4) ^ (((row >> 1) & 1) << 1))) << 5) + ((col & 15) << 1); }
__device__ __forceinline__ int off256(int row, int col) { return row * 256 + ((((col >> 4) ^ ((row & 3) << 1))) << 5) + ((col & 15) << 1); }
__device__ __forceinline__ v4i16_t trrd(LAS unsigned char* p) { return __builtin_amdgcn_ds_read_tr16_b64_v4i16((LAS v4i16_t*)p); }
template <bool W256> __device__ __forceinline__ bf16x8 tr_frag(LAS unsigned char* img, int rlo, int rhi, int c0, int lane) {
    const int q = (lane & 15) >> 2, col = c0 + 16 * ((lane >> 4) & 1) + 4 * (lane & 3);
    const v4i16_t lo = trrd(img + (W256 ? off256(rlo + q, col) : off128(rlo + q, col))), hv = trrd(img + (W256 ? off256(rhi + q, col) : off128(rhi + q, col)));
    return (bf16x8){lo[0], lo[1], lo[2], lo[3], hv[0], hv[1], hv[2], hv[3]};
}
__device__ __forceinline__ h16x8 tri_frag(int tok, int ks, int h) {
    h16x8 f;
#pragma unroll
    for (int j = 0; j < 8; ++j) f[j] = (16 * ks + 8 * h + j <= tok) ? (_Float16)1.0f : (_Float16)0.0f;
    return f;
}
__device__ __forceinline__ void split8(const float (&x)[8], bf16x8& hi, bf16x8& lo) {
    v4u h, l;
    h.x = pg8::cvt_pk_bf(x[0], x[1]); h.y = pg8::cvt_pk_bf(x[2], x[3]); h.z = pg8::cvt_pk_bf(x[4], x[5]); h.w = pg8::cvt_pk_bf(x[6], x[7]);
    l.x = pg8::cvt_pk_bf(x[0] - bflo(h.x), x[1] - bfhi(h.x)); l.y = pg8::cvt_pk_bf(x[2] - bflo(h.y), x[3] - bfhi(h.y));
    l.z = pg8::cvt_pk_bf(x[4] - bflo(h.z), x[5] - bfhi(h.z)); l.w = pg8::cvt_pk_bf(x[6] - bflo(h.w), x[7] - bfhi(h.w));
    hi = __builtin_bit_cast(bf16x8, h); lo = __builtin_bit_cast(bf16x8, l);
}
__device__ __forceinline__ void split4(const float (&x)[4], v2u& h, v2u& l) {
    h.x = pg8::cvt_pk_bf(x[0], x[1]); h.y = pg8::cvt_pk_bf(x[2], x[3]);
    l.x = pg8::cvt_pk_bf(x[0] - bflo(h.x), x[1] - bfhi(h.x)); l.y = pg8::cvt_pk_bf(x[2] - bflo(h.y), x[3] - bfhi(h.y));
}
constexpr int GL_TP = 136, GL_QH = 61440, GL_QL = GL_QH + 64 * GL_TP, GL_KH = GL_QL + 64 * GL_TP, GL_KL = GL_KH + 64 * GL_TP;
static_assert(GL_KL + 64 * GL_TP <= 131072, "GLA images");
__device__ __forceinline__ void gla_load64(LAS unsigned char* img, const bf16* src, int pitch, int tid) {
    const int row = tid >> 3, c = tid & 7; *(LAS v4u*)(img + off128(row, 8 * c)) = *(const v4u*)(src + (size_t)row * pitch + 8 * c);
}
__device__ __forceinline__ void gla_load128(LAS unsigned char* img, const bf16* src, int pitch, int tid) {
#pragma unroll
    for (int i = 0; i < 2; ++i) { const int row = (tid >> 4) + 32 * i, c = tid & 15; *(LAS v4u*)(img + off256(row, 8 * c)) = *(const v4u*)(src + (size_t)row * pitch + 8 * c); }
}
__device__ __forceinline__ void gla1_phase(Frame& F) {
    const int tid = F.tid, lane = F.lane, w = F.wave, l31 = lane & 31, hi = lane >> 5, db = w >> 2, eb = w & 3;
    LAS unsigned char* lds = F.lds;
    const bf16* CK = (const bf16*)(F.ws + WS_CK); const bf16* CV = (const bf16*)(F.ws + WS_CV); const bf16* LG = (const bf16*)(F.ws + WS_LOGG);
    bf16* ST = (bf16*)(F.ws + WS_STATE); float* DC = (float*)(F.ws + WS_DC);
    v4u rlg, rk, rv[2];
#define GLA1_FETCH(it_) do { const int bh_ = (it_) >> 7, c_ = (it_) & 127; const size_t r0_ = (size_t)(bh_ >> 2) * SEQ + c_ * 64; const int h_ = bh_ & 3, ra_ = tid >> 3, ca_ = (tid & 7) * 8; \
        rlg = *(const v4u*)(LG + (r0_ + ra_) * 256 + h_ * 64 + ca_); rk = *(const v4u*)(CK + (r0_ + ra_) * 256 + h_ * 64 + ca_); \
        _Pragma("unroll") for (int i_ = 0; i_ < 2; ++i_) { const int rb_ = (tid >> 4) + 32 * i_, cb_ = (tid & 15) * 8; rv[i_] = *(const v4u*)(CV + (r0_ + rb_) * 512 + h_ * 128 + cb_); } } while (0)
    if (F.bx < 8 * 128) GLA1_FETCH(F.bx);
    for (int item = F.bx; item < 8 * 128; item += F.G) {
        { const int ra = tid >> 3, ca = (tid & 7) * 8;
            *(LAS v4u*)(lds + GL_LG + off128(ra, ca)) = rlg; *(LAS v4u*)(lds + GL_K + off128(ra, ca)) = rk;
#pragma unroll
            for (int i = 0; i < 2; ++i) { const int rb = (tid >> 4) + 32 * i, cb = (tid & 15) * 8; *(LAS v4u*)(lds + GL_V + off256(rb, cb)) = rv[i]; } }
        __syncthreads();
        if (item + F.G < 8 * 128) GLA1_FETCH(item + F.G);
        f32x16 bN[2];
#pragma unroll
        for (int tb = 0; tb < 2; ++tb) {
#pragma unroll
            for (int r = 0; r < 16; ++r) bN[tb][r] = 0.f;
#pragma unroll
            for (int ks = 0; ks < 2 * tb + 2; ++ks) { const h16x8 lg = __builtin_bit_cast(h16x8, tr_frag<false>(lds + GL_LG, 16 * ks + 8 * hi, 16 * ks + 8 * hi + 4, 32 * db, lane));
                bN[tb] = __builtin_amdgcn_mfma_f32_32x32x16_f16(tri_frag(32 * tb + l31, ks, hi), lg, bN[tb], 0, 0, 0); } }
        const float bl = __shfl(bN[1][15], 32 + l31);
        f32x16 ut;
#pragma unroll
        for (int r = 0; r < 16; ++r) ut[r] = 0.f;
#pragma unroll
        for (int tb = 0; tb < 2; ++tb) { float kp[16];
#pragma unroll
            for (int g = 0; g < 4; ++g) { const v4i16_t kv = trrd(lds + GL_K + off128(32 * tb + 8 * g + 4 * hi + ((lane & 15) >> 2), 32 * db + 16 * ((lane >> 4) & 1) + 4 * (lane & 3)));
#pragma unroll
                for (int q = 0; q < 4; ++q) kp[4 * g + q] = h2f16((unsigned short)kv[q]) * fexp(bl - bN[tb][4 * g + q]); }
#pragma unroll
            for (int s = 0; s < 2; ++s) { const float x8[8] = {kp[8 * s + 0], kp[8 * s + 1], kp[8 * s + 2], kp[8 * s + 3], kp[8 * s + 4], kp[8 * s + 5], kp[8 * s + 6], kp[8 * s + 7]}; bf16x8 kh, kl; split8(x8, kh, kl);
                const bf16x8 vf = tr_frag<true>(lds + GL_V, 32 * tb + 16 * s + 4 * hi, 32 * tb + 16 * s + 8 + 4 * hi, 32 * eb, lane);
                ut = __builtin_amdgcn_mfma_f32_32x32x16_bf16(vf, kh, ut, 0, 0, 0); ut = __builtin_amdgcn_mfma_f32_32x32x16_bf16(vf, kl, ut, 0, 0, 0); } }
        bf16* dst = ST + ((size_t)item * 64 + 32 * db + l31) * 128 + 32 * eb + 4 * hi;
#pragma unroll
        for (int g = 0; g < 4; ++g) { v2u o; o.x = pg8::cvt_pk_bf(ut[4 * g + 0], ut[4 * g + 1]); o.y = pg8::cvt_pk_bf(ut[4 * g + 2], ut[4 * g + 3]); *(v2u*)(dst + 8 * g) = o; }
        if (eb == 0 && hi == 0) DC[(size_t)item * 64 + 32 * db + l31] = fexp(bl);
        __syncthreads();
    }
}
#undef GLA1_FETCH
constexpr int SCAN_DC_OFF = RSTD_OFF;
__device__ __forceinline__ void gla2_phase(Frame& F) {
    bf16* ST = (bf16*)(F.ws + WS_STATE); const float* DC = (const float*)(F.ws + WS_DC);
    const int tid = F.tid; LAS unsigned char* lds = F.lds; LAS float* dct = (LAS float*)(lds + SCAN_DC_OFF);
    for (int item = F.vcu; item < 8 * 32; item += F.G) {
        const int bh = item >> 5, d0 = (item & 31) * 2;
        bf16* base = ST + ((size_t)bh * 128 * 64 + d0) * 128;
        { v4u r[8];
#pragma unroll
            for (int i = 0; i < 8; ++i) { const int q = tid + 512 * i, c = q >> 5, o = (q & 31) * 8; r[i] = *(const v4u*)(base + (size_t)c * 64 * 128 + o); }
#pragma unroll
            for (int i = 0; i < 8; ++i) { const int q = tid + 512 * i; *(LAS v4u*)(lds + q * 16) = r[i]; } }
        if (tid < 256) dct[tid] = DC[((size_t)bh * 128 + (tid >> 1)) * 64 + d0 + (tid & 1)];
        __syncthreads();
        if (tid < 256) { const int dl = tid >> 7; LAS bf16* p = (LAS bf16*)lds + tid; float S = 0.f;
#pragma unroll 8
            for (int c = 0; c < 128; ++c) { const float u = bf2f(p[c * 256]); p[c * 256] = (bf16)f2bf(S); S = dct[c * 2 + dl] * S + u; } }
        __syncthreads();
        { v4u r[8];
#pragma unroll
            for (int i = 0; i < 8; ++i) { const int q = tid + 512 * i; r[i] = *(const LAS v4u*)(lds + q * 16); }
#pragma unroll
            for (int i = 0; i < 8; ++i) { const int q = tid + 512 * i, c = q >> 5, o = (q & 31) * 8; *(v4u*)(base + (size_t)c * 64 * 128 + o) = r[i]; } }
        __syncthreads();
    }
}
__device__ __forceinline__ void gla3_phase(Frame& F, int l) {
    const int tid = F.tid, lane = F.lane, w = F.wave, l31 = lane & 31, hi = lane >> 5, tb = w >> 2, eb = w & 3;
    LAS unsigned char* lds = F.lds;
    const bf16* CQ = (const bf16*)(F.ws + WS_CQ); const bf16* CK = (const bf16*)(F.ws + WS_CK); bf16* CV = (bf16*)(F.ws + WS_CV); const bf16* LG = (const bf16*)(F.ws + WS_LOGG);
    const bf16* CR = (const bf16*)(F.ws + WS_CR); const bf16* ST = (const bf16*)(F.ws + WS_STATE); const float* gain = inptr(F, 14) + l * 128;
    LAS float* scr = (LAS float*)(lds + GL_SCR);
    v4u rlg, rk, rq, rv[2], rs[2];
#define GLA3_FETCH(it_) do { const int bh_ = (it_) >> 7, c_ = (it_) & 127; const size_t r0_ = (size_t)(bh_ >> 2) * SEQ + c_ * 64; const int h_ = bh_ & 3, ra_ = tid >> 3, ca_ = (tid & 7) * 8; \
        rlg = *(const v4u*)(LG + (r0_ + ra_) * 256 + h_ * 64 + ca_); rk = *(const v4u*)(CK + (r0_ + ra_) * 256 + h_ * 64 + ca_); rq = *(const v4u*)(CQ + (r0_ + ra_) * 256 + h_ * 64 + ca_); \
        _Pragma("unroll") for (int i_ = 0; i_ < 2; ++i_) { const int rb_ = (tid >> 4) + 32 * i_, cb_ = (tid & 15) * 8; rv[i_] = *(const v4u*)(CV + (r0_ + rb_) * 512 + h_ * 128 + cb_); rs[i_] = *(const v4u*)(ST + (size_t)(it_) * 64 * 128 + rb_ * 128 + cb_); } } while (0)
    if (F.bx < 8 * 128) GLA3_FETCH(F.bx);
    for (int item = F.bx; item < 8 * 128; item += F.G) {
        const int bh = item >> 7, c = item & 127, b = bh >> 2, h = bh & 3; const size_t row0 = (size_t)b * SEQ + c * 64;
        { const int ra = tid >> 3, ca = (tid & 7) * 8;
            *(LAS v4u*)(lds + GL_LG + off128(ra, ca)) = rlg; *(LAS v4u*)(lds + GL_K + off128(ra, ca)) = rk; *(LAS v4u*)(lds + GL_Q + off128(ra, ca)) = rq;
#pragma unroll
            for (int i = 0; i < 2; ++i) { const int rb = (tid >> 4) + 32 * i, cb = (tid & 15) * 8; *(LAS v4u*)(lds + GL_V + off256(rb, cb)) = rv[i]; *(LAS v4u*)(lds + GL_S + off256(rb, cb)) = rs[i]; } }
        __syncthreads();
        if (item + F.G < 8 * 128) GLA3_FETCH(item + F.G);
        {   const int dbi = w & 1, xb = (w >> 1) & 1, gh = w >> 2, t = 32 * xb + l31;
            f32x16 bt;
#pragma unroll
            for (int r = 0; r < 16; ++r) bt[r] = 0.f;
            for (int ks = 0; ks < 2 * xb + 2; ++ks) { const h16x8 lg = __builtin_bit_cast(h16x8, tr_frag<false>(lds + GL_LG, 16 * ks + 8 * hi, 16 * ks + 8 * hi + 4, 32 * dbi, lane));
                bt = __builtin_amdgcn_mfma_f32_32x32x16_f16(lg, tri_frag(t, ks, hi), bt, 0, 0, 0); }
#pragma unroll
            for (int gg = 0; gg < 2; ++gg) { const int dcol = 32 * dbi + 8 * (2 * gh + gg) + 4 * hi;
                const v2u qa = *(const LAS v2u*)(lds + GL_Q + off128(t, dcol)), ka = *(const LAS v2u*)(lds + GL_K + off128(t, dcol));
                const float qv[4] = {hlo16(qa.x), hhi16(qa.x), hlo16(qa.y), hhi16(qa.y)}, kv[4] = {hlo16(ka.x), hhi16(ka.x), hlo16(ka.y), hhi16(ka.y)}; float qx[4], kx[4];
#pragma unroll
                for (int j = 0; j < 4; ++j) { const float bb = gh == 0 ? bt[4 * gg + j] : bt[8 + 4 * gg + j]; qx[j] = qv[j] * fexp(bb); kx[j] = kv[j] * fexp(-bb); }
                v2u qh, ql2, kh2, kl2; split4(qx, qh, ql2); split4(kx, kh2, kl2);
                const int o = t * GL_TP + dcol * 2;
                *(LAS v2u*)(lds + GL_QH + o) = qh; *(LAS v2u*)(lds + GL_QL + o) = ql2; *(LAS v2u*)(lds + GL_KH + o) = kh2; *(LAS v2u*)(lds + GL_KL + o) = kl2; } }
        __syncthreads();
        bf16x8 qf[2][2], ql[2][2];
#pragma unroll
        for (int dbi = 0; dbi < 2; ++dbi)
#pragma unroll
            for (int s = 0; s < 2; ++s) { const int o = (32 * tb + l31) * GL_TP + (32 * dbi + 16 * s + 4 * hi) * 2;
                const v2u a = *(const LAS v2u*)(lds + GL_QH + o), b2 = *(const LAS v2u*)(lds + GL_QH + o + 16), c = *(const LAS v2u*)(lds + GL_QL + o), d2 = *(const LAS v2u*)(lds + GL_QL + o + 16);
                qf[dbi][s] = __builtin_bit_cast(bf16x8, (v4u){a.x, a.y, b2.x, b2.y}); ql[dbi][s] = __builtin_bit_cast(bf16x8, (v4u){c.x, c.y, d2.x, d2.y}); }
        f32x16 ot;
#pragma unroll
        for (int r = 0; r < 16; ++r) ot[r] = 0.f;
#pragma unroll
        for (int dbi = 0; dbi < 2; ++dbi)
#pragma unroll
            for (int s = 0; s < 2; ++s) { const bf16x8 sf = tr_frag<true>(lds + GL_S, 32 * dbi + 16 * s + 4 * hi, 32 * dbi + 16 * s + 8 + 4 * hi, 32 * eb, lane);
                ot = __builtin_amdgcn_mfma_f32_32x32x16_bf16(sf, qf[dbi][s], ot, 0, 0, 0); ot = __builtin_amdgcn_mfma_f32_32x32x16_bf16(sf, ql[dbi][s], ot, 0, 0, 0); }
#pragma unroll
        for (int sb = 0; sb < 2; ++sb) if (sb <= tb) {
            f32x16 at;
#pragma unroll
            for (int r = 0; r < 16; ++r) at[r] = 0.f;
#pragma unroll
            for (int dbi = 0; dbi < 2; ++dbi)
#pragma unroll
                for (int s = 0; s < 2; ++s) { const int o = (32 * sb + l31) * GL_TP + (32 * dbi + 16 * s + 4 * hi) * 2;
                    const v2u a = *(const LAS v2u*)(lds + GL_KH + o), b2 = *(const LAS v2u*)(lds + GL_KH + o + 16), c = *(const LAS v2u*)(lds + GL_KL + o), d2 = *(const LAS v2u*)(lds + GL_KL + o + 16);
                    const bf16x8 kh = __builtin_bit_cast(bf16x8, (v4u){a.x, a.y, b2.x, b2.y}), kl = __builtin_bit_cast(bf16x8, (v4u){c.x, c.y, d2.x, d2.y});
                    at = __builtin_amdgcn_mfma_f32_32x32x16_bf16(kh, qf[dbi][s], at, 0, 0, 0); at = __builtin_amdgcn_mfma_f32_32x32x16_bf16(kl, qf[dbi][s], at, 0, 0, 0); at = __builtin_amdgcn_mfma_f32_32x32x16_bf16(kh, ql[dbi][s], at, 0, 0, 0); }
            if (sb == tb) {
#pragma unroll
                for (int r = 0; r < 16; ++r) if (crow16(r, hi) > l31) at[r] = 0.f; }
#pragma unroll
            for (int s = 0; s < 2; ++s) { const float x8[8] = {at[8 * s + 0], at[8 * s + 1], at[8 * s + 2], at[8 * s + 3], at[8 * s + 4], at[8 * s + 5], at[8 * s + 6], at[8 * s + 7]}; bf16x8 ph, pl; split8(x8, ph, pl);
                const bf16x8 vf = tr_frag<true>(lds + GL_V, 32 * sb + 16 * s + 4 * hi, 32 * sb + 16 * s + 8 + 4 * hi, 32 * eb, lane);
                ot = __builtin_amdgcn_mfma_f32_32x32x16_bf16(vf, ph, ot, 0, 0, 0); ot = __builtin_amdgcn_mfma_f32_32x32x16_bf16(vf, pl, ot, 0, 0, 0); } }
        float q2 = 0.f;
#pragma unroll
        for (int r = 0; r < 16; ++r) q2 += ot[r] * ot[r];
        q2 = xsum32(q2);
        if (hi == 0) scr[(tb * 4 + eb) * 32 + l31] = q2;
        __syncthreads();
        const float rn = 1.0f / sqrtf(((scr[(tb * 4 + 0) * 32 + l31] + scr[(tb * 4 + 1) * 32 + l31]) + (scr[(tb * 4 + 2) * 32 + l31] + scr[(tb * 4 + 3) * 32 + l31])) * (1.0f / 128.0f) + NORM_EPS);
        const size_t tok = row0 + 32 * tb + l31; const int ecol = h * 128 + 32 * eb + 4 * hi;
#pragma unroll
        for (int g = 0; g < 4; ++g) { const v2u cr = *(const v2u*)(CR + tok * 512 + ecol + 8 * g); const f32x4 gn = *(const f32x4*)(gain + 32 * eb + 4 * hi + 8 * g);
            v2u o; o.x = pg8::cvt_pk_h(ot[4 * g + 0] * rn * gn[0] * hlo(cr.x), ot[4 * g + 1] * rn * gn[1] * hhi(cr.x)); o.y = pg8::cvt_pk_h(ot[4 * g + 2] * rn * gn[2] * hlo(cr.y), ot[4 * g + 3] * rn * gn[3] * hhi(cr.y));
            *(v2u*)(CV + tok * 512 + ecol + 8 * g) = o; }
        __syncthreads();
    }
}
#undef GLA3_FETCH

__device__ __forceinline__ void xcd_barrier_shadow(const XcdBarrier& b, Frame& F, int ph) {
    asm volatile("s_waitcnt vmcnt(0)" ::: "memory");
    __syncthreads();
    if (F.wave == 0) __builtin_amdgcn_s_setprio(3);
    if (F.tid == 0) {
        unsigned* bar = b.bar;
        __builtin_amdgcn_s_waitcnt(0);
        unsigned nloc = b.st[0], nx = b.st[1];
        if (nloc == 0u) { xcd_barrier_complete(bar, b.x, nloc, nx); b.st[0] = nloc; b.st[1] = nx; }
        const unsigned old = xb_add(&bar[XB_XSUB(b.x)], 1u);
        const unsigned gen = old / nloc;
        if (old + 1u == (gen + 1u) * nloc) {
            __builtin_amdgcn_fence(__ATOMIC_RELEASE, "agent");
            asm volatile("s_waitcnt vmcnt(0)" ::: "memory");
            const unsigned og = xb_add(&bar[XB_TOP], 1u);
            const unsigned tg = og / nx;
            __builtin_amdgcn_fence(__ATOMIC_ACQUIRE, "agent");
            if (og + 1u == (tg + 1u) * nx) xb_add(&bar[XB_TOPGEN], 1u);
            else XB_SPIN(xb_ld(&bar[XB_TOPGEN]) == tg, bar);
            xb_add(&bar[XB_XGEN(b.x)], 1u);
            asm volatile("s_waitcnt vmcnt(0)" ::: "memory");
        } else {
            __builtin_amdgcn_fence(__ATOMIC_ACQUIRE, "agent");
            XB_SPIN(xb_ld(&bar[XB_XGEN(b.x)]) == gen, bar);
            asm volatile("s_waitcnt vmcnt(0)" ::: "memory");
        }
    } else if (F.wave != 0) {
        shadow_conv(F, ph);
    }
    if (F.wave == 0) __builtin_amdgcn_s_setprio(0);
    __syncthreads();
}
template <class T> __device__ __forceinline__ T* launder(T* p) {
    unsigned long long v = (unsigned long long)p; unsigned lo = (unsigned)v, hi = (unsigned)(v >> 32);
    asm volatile("" : "+s"(lo), "+s"(hi));
    return (T*)(GAS T*)(((unsigned long long)hi << 32) | lo);
}
#ifndef PROBE_CAT
#define PROBE_CAT (-1)
#endif
#define TB() unsigned long long t0_ = (PROBE_CAT >= 0) ? __builtin_amdgcn_s_memrealtime() : 0ull; unsigned long long c0_ = (PROBE_CAT == 98) ? __builtin_readcyclecounter() : 0ull
#define TE(cat) do { if ((cat) == PROBE_CAT || (PROBE_CAT == 97 && (cat) < 10)) tacc_ += __builtin_amdgcn_s_memrealtime() - t0_; if (PROBE_CAT == 98 && (cat) == 10) tacc_ += (__builtin_readcyclecounter() - c0_) >> 5; (void)c0_; } while (0)
template <class Sched> __device__ __forceinline__ int rstd_table(Frame& F, const Sched& S) {
    pg8::Unit u; if (!S.next(0, u)) return -1;
    if (F.tid < 256) { const f32x4* p = (const f32x4*)((const float*)(F.ws + WS_SSQ) + (size_t)(u.pm * 256 + F.tid) * 16); const f32x4 a = p[0], b = p[1], c = p[2], d = p[3]; const f32x4 s = (a + b) + (c + d);
        ((LAS float*)(F.lds + RSTD_OFF))[F.tid] = 1.0f / sqrtf(((s[0] + s[1]) + (s[2] + s[3])) * (1.0f / DM) + NORM_EPS); }
    __syncthreads();
    return u.pm;
}
constexpr int PH_PER_LAYER = 10, N_PHASES = 1 + NLAYER * PH_PER_LAYER;
struct Args { const void* in[20]; float* out; unsigned char* ws; int ph_lo, ph_hi, li, pad; };
__global__ void __launch_bounds__(NWAVES * 64, 2) mk_fwd(Args args) {
    extern __shared__ __attribute__((aligned(16))) unsigned char lds[];
    Frame F;
    F.lds = (LAS unsigned char*)lds;
    F.MISC = (volatile LAS unsigned*)(F.lds + MISC_OFF);
    F.tid = threadIdx.x; F.lane = F.tid & 63; F.wave = __builtin_amdgcn_readfirstlane(F.tid >> 6); const int wave0_ = F.wave;
    F.G = gridDim.x; F.bx = blockIdx.x; F.vcu = 0;
    F.ws = args.ws; F.X = args.out;
    F.ctl = (gu32*)(args.ws + WS_CTL);
    for (int u = F.tid; u < (LDS_BYTES - LDSCTL_OFF) / 4; u += NWAVES * 64) ((LAS unsigned*)(F.lds + LDSCTL_OFF))[u] = 0u;
    __syncthreads();
    if (F.tid == 0) {
#pragma unroll
        for (int i = 0; i < 20; ++i) ((LAS unsigned long long*)(F.lds + INTAB_OFF))[i] = (unsigned long long)args.in[i];
    }
    __syncthreads();
    XcdBarrier bar; bar.bar = (unsigned*)(F.ctl + CW_BAR); bar.x = 0; bar.st = nullptr;
    if (!MK_PER_PHASE) bar = xcd_barrier_post((unsigned*)(F.ctl + CW_BAR), F.MISC + 8);
#ifdef EXTRA_BARS
    for (int i_ = 0; i_ < EXTRA_BARS; ++i_) xcd_barrier(bar);
#endif
    unsigned long long tacc_ = 0ull; const unsigned long long tk0_ = (PROBE_CAT == 99) ? __builtin_amdgcn_s_memrealtime() : 0ull;
    for (int ph = args.ph_lo; ph < args.ph_hi; ++ph) {
        { int wv_ = wave0_; asm volatile("" : "+s"(wv_)); int t_ = wv_ * 64 + (int)__builtin_amdgcn_mbcnt_hi(~0u, __builtin_amdgcn_mbcnt_lo(~0u, 0u)); asm volatile("" : "+v"(t_)); t_ &= 511;
          F.tid = t_; F.lane = t_ & 63; F.wave = __builtin_amdgcn_readfirstlane(t_ >> 6); }
        F.ws = launder(args.ws); F.X = launder(args.out);
        { int bx_ = blockIdx.x, g_ = gridDim.x; asm volatile("" : "+s"(bx_), "+s"(g_)); F.bx = bx_; F.G = g_; F.vcu = (g_ % 8 == 0) ? (bx_ % 8) * (g_ / 8) + bx_ / 8 : bx_; }
        const float* ssq = (const float*)(F.ws + WS_SSQ);
        pg8::bf16_t* XB = (pg8::bf16_t*)(F.ws + WS_XB);
        if (ph == 0) {
            { TB(); p0_rows(F); conv_set(F, 0, 0); TE(4); }
        } else {
            const int l = (ph - 1) / PH_PER_LAYER, k = (ph - 1) % PH_PER_LAYER;
            if (k == 0 || k == 8) {
                pg8::Gemm g{XB, XB, XB, (const pg8::bf16_t*)(F.ws + WS_S1), nullptr, nullptr, M, 2 * DFF, DM};
                pg8::StaticOrder S; S.init(M, 2 * DFF, F.G, F.bx);
                pg8::Unit u0_; const int rpm = S.next(0, u0_) ? u0_.pm : -1; pg8::EpiSwiglu E{(pg8::bf16_t*)(F.ws + WS_ACTH), ssq, (const LAS float*)(F.lds + RSTD_OFF), rpm};
                { TB(); pg8::gemm_phase<pg8::EpiSwiglu, pg8::StaticOrder, true>(F.lds + RING_OFF, g, S, E, F.tid); TE(0); TE(10); }
                { const int rem = S.nwg % F.G; if (rem == 0) tail_conv(F, ph, F.bx, F.G); else if (F.bx >= rem) tail_conv(F, ph, F.bx - rem, F.G - rem); }
            } else if (k == 1 || k == 9) {
                { TB(); if (k == 9 && l + 1 < NLAYER) { conv_set(F, 0, l + 1); __syncthreads(); } TE(4); }
                const pg8::bf16_t* A = (const pg8::bf16_t*)(F.ws + WS_ACTH);
                pg8::Gemm g{A, A, A, (const pg8::bf16_t*)(F.ws + WS_S2), nullptr, nullptr, M, DM, DFF};
                pg8::StaticOrder S; S.init(M, DM, F.G, F.bx);
                pg8::EpiResidual E{(k == 9 && l == NLAYER - 1) ? F.X : nullptr, XB, (float*)(F.ws + WS_SSQ), 0.5f, 2.0f};
                { TB(); pg8::gemm_phase<pg8::EpiResidual, pg8::StaticOrder, true>(F.lds + RING_OFF, g, S, E, F.tid); TE(0); TE(11); }
            } else if (k == 2) {
                pg8::Gemm g{XB, XB, XB, (const pg8::bf16_t*)(F.ws + WS_STATE), nullptr, nullptr, M, 7168, DM};
                pg8::StaticOrder S; S.init(M, 7168, F.G, F.bx);
                pg8::Unit u0_; const int rpm = S.next(0, u0_) ? u0_.pm : -1; pg8::EpiInProj E{F.ws, ssq, (const pg8::bf16_t*)(F.ws + WS_COS), (const LAS float*)(F.lds + RSTD_OFF), rpm, inptr(F, 7) + l * 64, inptr(F, 8) + l * 64, inptr(F, 9) + l * 64, inptr(F, 10) + l * 64, inptr(F, 13) + l * 256};
                { TB(); pg8::gemm_phase<pg8::EpiInProj, pg8::StaticOrder, true>(F.lds + RING_OFF, g, S, E, F.tid); TE(0); TE(12); }
            } else if (k == 3) {
                { TB(); gla1_phase(F); __syncthreads(); TE(2); } { TB(); attn_phase(F, l); TE(1); }
            } else if (k == 4) { { TB(); gla2_phase(F); TE(3); } { TB(); amerge_phase(F); TE(6); }
            } else if (k == 5) {
                { TB(); gla3_phase(F, l); __syncthreads(); TE(3); }
                pg8::Gemm g{XB, XB, XB, (const pg8::bf16_t*)(F.ws + WS_WG), nullptr, nullptr, M, 3 * DM, DM};
                pg8::StaticOrder S; S.init(M, 3 * DM, F.G, F.bx);
                pg8::Unit u0_; const int rpm = S.next(0, u0_) ? u0_.pm : -1; pg8::EpiSigmoid E{(pg8::bf16_t*)(F.ws + WS_GATES), ssq, (const LAS float*)(F.lds + RSTD_OFF), rpm};
                { TB(); pg8::gemm_phase<pg8::EpiSigmoid, pg8::StaticOrder, true>(F.lds + RING_OFF, g, S, E, F.tid); TE(0); TE(13); }
            } else if (k == 6) {
                const pg8::bf16_t* WB = (const pg8::bf16_t*)(F.ws + WS_WB);
                pg8::Gemm g{(const pg8::bf16_t*)(F.ws + WS_AQ0), (const pg8::bf16_t*)(F.ws + WS_BQ), (const pg8::bf16_t*)(F.ws + WS_CV), WB, WB + (size_t)DM * 512, WB + (size_t)2 * DM * 512, M, DM, 512};
                pg8::Seg3Order S; S.b.init(M, DM, F.G, F.bx);
                pg8::EpiMerge E{(const pg8::bf16_t*)(F.ws + WS_GATES), (pg8::bf16_t*)(F.ws + WS_MERGED)};
                { TB(); pg8::gemm_phase<pg8::EpiMerge, pg8::Seg3Order, true>(F.lds + RING_OFF, g, S, E, F.tid); TE(0); TE(14); }
            } else if (k == 7) {
                const pg8::bf16_t* A = (const pg8::bf16_t*)(F.ws + WS_MERGED);
                pg8::Gemm g{A, A, A, (const pg8::bf16_t*)(F.ws + WS_WO), nullptr, nullptr, M, DM, DM};
                pg8::StaticOrder S; S.init(M, DM, F.G, F.bx);
                pg8::EpiResidual E{nullptr, XB, (float*)(F.ws + WS_SSQ), 1.0f, 1.0f};
                { TB(); pg8::gemm_phase<pg8::EpiResidual, pg8::StaticOrder, true>(F.lds + RING_OFF, g, S, E, F.tid); TE(0); TE(15); }
            }
        }
        if (ph + 1 < args.ph_hi) { TB(); xcd_barrier_shadow(bar, F, ph); TE(5); }
    }
    if (PROBE_CAT == 99) tacc_ = __builtin_amdgcn_s_memrealtime() - tk0_;
    if (PROBE_CAT >= 0 && blockIdx.x == 0 && threadIdx.x == 0) { const unsigned long long ts_ = __builtin_amdgcn_s_memrealtime(); while (__builtin_amdgcn_s_memrealtime() - ts_ < tacc_) __builtin_amdgcn_s_sleep(8); }
}

extern "C" void kernel_launch(void* const* d_in, const int* in_sizes, int n_in, void* d_out, int out_size, void* d_ws, size_t ws_size, hipStream_t stream) {
    static int grid = 0;
    if (grid == 0) {
        if (n_in != 20 || out_size != M * DM || ws_size < WS_END) { fprintf(stderr, "kernel_launch: unexpected problem (n_in %d, out %d, ws %zu < %zu); nothing launched\n", n_in, out_size, ws_size, (size_t)WS_END); grid = -1; return; }
        int dev = 0, cus = 0, per_cu = 0;
        if (hipGetDevice(&dev) != hipSuccess || hipDeviceGetAttribute(&cus, hipDeviceAttributeMultiprocessorCount, dev) != hipSuccess) { grid = -1; return; }
        if (hipFuncSetAttribute((const void*)mk_fwd, hipFuncAttributeMaxDynamicSharedMemorySize, LDS_BYTES) != hipSuccess) { fprintf(stderr, "kernel_launch: hipFuncSetAttribute failed\n"); grid = -1; return; }
        if (hipOccupancyMaxActiveBlocksPerMultiprocessor(&per_cu, (const void*)mk_fwd, NWAVES * 64, LDS_BYTES) != hipSuccess || per_cu < 1)
            fprintf(stderr, "kernel_launch: note: occupancy query reports %d workgroups per CU\n", per_cu);
        (void)hipGetLastError();
        grid = cus;
    }
    if (grid < 0) return;
    if (hipMemsetAsync((char*)d_ws + WS_CTL, 0, CTL_ZERO_BYTES, stream) != hipSuccess) return;
    Args a{};
    for (int i = 0; i < 20; ++i) a.in[i] = d_in[i];
    a.out = (float*)d_out; a.ws = (unsigned char*)d_ws;
#if MK_PER_PHASE
    for (int p = 0; p < N_PHASES; ++p) { a.ph_lo = p; a.ph_hi = p + 1; a.li = p; hipLaunchKernelGGL(mk_fwd, dim3(grid), dim3(NWAVES * 64), LDS_BYTES, stream, a); }
#else
    a.ph_lo = 0; a.ph_hi = N_PHASES; a.li = 0;
    hipLaunchKernelGGL(mk_fwd, dim3(grid), dim3(NWAVES * 64), LDS_BYTES, stream, a);
#endif
}
```

```cpp
#include <hip/hip_runtime.h>
#include <cstdio>
#include <cstdint>

#ifndef MK_BF16
#define MK_BF16 0
#endif
#ifndef MK_PER_PHASE
#define MK_PER_PHASE 0
#endif
static_assert(MK_PER_PHASE == 0, "one launch only");

namespace pg8 {
#define PG8_LAS __attribute__((address_space(3)))
typedef unsigned short bf16_t;
typedef short bf16x8 __attribute__((ext_vector_type(8)));
typedef _Float16 h16x8_t __attribute__((ext_vector_type(8)));
typedef float f32x4 __attribute__((ext_vector_type(4)));
typedef unsigned u32x4 __attribute__((ext_vector_type(4)));
constexpr int BM = 256, BK = 64, HALF = 128, HTB = HALF * BK * 2  , STAGE_BYTES = 8 * HTB, NXCD = 8, WGM = 8;

__host__ __device__ __forceinline__ int lds_byte(int r, int c) { const int st = (r >> 4) * 2 + (c >> 5), rr = r & 15, cc = c & 31, ob = rr * 64 + cc * 2; return st * 1024 + (ob ^ (((ob >> 9) & 1) << 5)); }
__host__ __device__ __forceinline__ void stage_rc(int b, int& R, int& C) { const int st = b / 1024, sb = b % 1024, swz = sb ^ (((sb >> 9) & 1) << 5); R = (st >> 1) * 16 + swz / 64; C = (st & 1) * 32 + (swz % 64) / 2; }
__host__ __device__ __forceinline__ int perm32(int rho) { const int n = rho >> 4, i = rho & 15; return 8 * (i >> 2) + 4 * n + (i & 3); }

struct Unit { int pm, pn, seg; };
struct Gemm { const bf16_t* A0; const bf16_t* A1; const bf16_t* A2; const bf16_t* B0; const bf16_t* B1; const bf16_t* B2; int M, N, K; };

struct StaticOrder {
    int nM, nN, nwg, G, c;
    __host__ __device__ void init(int M, int N, int G_, int c_) { nM = M / BM; nN = N / BM; nwg = nM * nN; G = G_; c = c_; }
    __host__ __device__ bool next(int i, Unit& u) const {
        const long L = (long)i * G + c; if (L >= nwg) return false;
        int wgid = (int)L; { const int q = nwg / NXCD, r = nwg % NXCD, xcd = wgid % NXCD, off = wgid / NXCD; wgid = (xcd < r ? xcd * (q + 1) : r * (q + 1) + (xcd - r) * q) + off; }
        const int nig = WGM * nN, gid = wgid / nig, fm = gid * WGM, gsz = (nM - fm) < WGM ? (nM - fm) : WGM;
        u.pm = fm + ((wgid % nig) % gsz); u.pn = (wgid % nig) / gsz; u.seg = 0; return true;
    }
};
struct Seg3Order {
    StaticOrder b;
    __host__ __device__ bool next(int i, Unit& u) const { if (!b.next(i / 3, u)) return false; u.seg = i % 3; return true; }
};

typedef float f32x2_t __attribute__((ext_vector_type(2))); typedef __bf16 bf16x2_t __attribute__((ext_vector_type(2))); typedef _Float16 h16x2_t __attribute__((ext_vector_type(2)));
__device__ __forceinline__ unsigned cvt_pk_bf(float lo, float hi) { f32x2_t v = {lo, hi}; bf16x2_t b = __builtin_convertvector(v, bf16x2_t); return __builtin_bit_cast(unsigned, b); }
__device__ __forceinline__ unsigned cvt_pk_h16(float lo, float hi) { h16x2_t b = {(_Float16)lo, (_Float16)hi}; return __builtin_bit_cast(unsigned, b); }
__device__ __forceinline__ unsigned cvt_pk_h(float lo, float hi) { return MK_BF16 ? cvt_pk_bf(lo, hi) : cvt_pk_h16(lo, hi); }

template <class Epi, class Sched, bool ALIGN_EPI = false>
__device__ __forceinline__ void gemm_phase(PG8_LAS unsigned char* lds, const Gemm g, const Sched& S, const Epi& E, int tid_in) {
    int tid_ = tid_in; asm volatile("" : "+v"(tid_));
    const int tid = tid_ & 511, wid = __builtin_amdgcn_readfirstlane(tid >> 6), lane = tid & 63, wr = wid >> 2, wc = wid & 3, fr = lane & 15, fq = lane >> 4;
    const int K = g.K, nt = K / BK;
    unsigned voffA[2], voffB[2];
#pragma unroll
    for (int i = 0; i < 2; ++i) { int R, C; stage_rc(tid * 16 + i * 8192, R, C); const int Rb = Epi::PERM ? ((R & ~31) + perm32(R & 31)) : R;
        voffA[i] = (unsigned)(R * K + C) * 2u; voffB[i] = (unsigned)(Rb * K + C) * 2u; }
    const size_t kstep = (size_t)(BK * 2);
    const size_t hstep = (size_t)HALF * K * 2;
    const size_t tstep = 2 * hstep;
    const unsigned ldsw = (unsigned)wid * 1024u;
    const int aoff = lds_byte(wr * 64 + fr, fq * 8), boff = lds_byte(wc * 32 + fr, fq * 8);
#define PG8_SA(b, h) (((b) * 2 + (h)) * HTB)
#define PG8_SB(b, h) ((4 + (b) * 2 + (h)) * HTB)
#define PG8_STAGE(bufoff, gbase, voff) do { _Pragma("unroll") for (int _i = 0; _i < 2; ++_i) \
        __builtin_amdgcn_global_load_lds((const unsigned*)((const char*)(gbase) + (voff)[_i]), (PG8_LAS unsigned*)(lds + (bufoff) + ldsw + _i * 8192), 16, 0, 0); } while (0)
#define PG8_LDA(dst, b, h) do { _Pragma("unroll") for (int m = 0; m < 4; ++m) _Pragma("unroll") for (int k = 0; k < 2; ++k) dst[m][k] = *(const PG8_LAS bf16x8*)(lds + PG8_SA(b, h) + aoff + m * 2048 + k * 1024); } while (0)
#define PG8_LDB(dst, b, h) do { _Pragma("unroll") for (int n = 0; n < 2; ++n) _Pragma("unroll") for (int k = 0; k < 2; ++k) dst[n][k] = *(const PG8_LAS bf16x8*)(lds + PG8_SB(b, h) + boff + n * 2048 + k * 1024); } while (0)
#define PG8_MMA(ai, bj, At, Bt) do { __builtin_amdgcn_s_setprio(1); _Pragma("unroll") for (int m = 0; m < 4; ++m) _Pragma("unroll") for (int n = 0; n < 2; ++n) _Pragma("unroll") for (int k = 0; k < 2; ++k) \
        acc[ai][bj][m][n] = MK_BF16 ? __builtin_amdgcn_mfma_f32_16x16x32_bf16(Bt[n][k], At[m][k], acc[ai][bj][m][n], 0, 0, 0) : __builtin_amdgcn_mfma_f32_16x16x32_f16(__builtin_bit_cast(h16x8_t, Bt[n][k]), __builtin_bit_cast(h16x8_t, At[m][k]), acc[ai][bj][m][n], 0, 0, 0); __builtin_amdgcn_s_setprio(0); } while (0)
#define PG8_WAIT_V(n) asm volatile("s_waitcnt vmcnt(" #n ")" ::: "memory")
#define PG8_WAIT_L(n) asm volatile("s_waitcnt lgkmcnt(" #n ")" ::: "memory")
#define PG8_BAR __builtin_amdgcn_s_barrier()
#define PG8_SCHED __builtin_amdgcn_sched_barrier(0)
#define PG8_ASEL(u) ((u).seg == 0 ? g.A0 : ((u).seg == 1 ? g.A1 : g.A2))
#define PG8_BSEL(u) ((u).seg == 0 ? g.B0 : ((u).seg == 1 ? g.B1 : g.B2))
    Unit cur, nxt; int ui = 0;
    if (!S.next(0, cur)) return;
    f32x4 acc[2][2][4][2];
#pragma unroll
    for (int a = 0; a < 2; ++a)
#pragma unroll
        for (int b = 0; b < 2; ++b)
#pragma unroll
            for (int m = 0; m < 4; ++m)
#pragma unroll
                for (int n = 0; n < 2; ++n) acc[a][b][m][n] = (f32x4){0.f, 0.f, 0.f, 0.f};
    E.init(acc, cur, wr, wc, lane);
    typename Epi::Pro pro; E.pro_load(pro, cur, tid);
    bf16x8 At[4][2], B0[2][2], B1[2][2];
    const char* cA = (const char*)PG8_ASEL(cur) + (size_t)cur.pm * tstep; const char* cB = (const char*)PG8_BSEL(cur) + (size_t)cur.pn * tstep;
    PG8_STAGE(PG8_SB(0, 0), cB, voffB); PG8_STAGE(PG8_SB(0, 1), cB + hstep, voffB); PG8_STAGE(PG8_SA(0, 0), cA, voffA); PG8_STAGE(PG8_SA(0, 1), cA + hstep, voffA);
    E.pro_store(pro, tid);
    if (wr == 1) PG8_BAR;
    PG8_WAIT_V(2); PG8_BAR;
    PG8_STAGE(PG8_SB(1, 0), cB + kstep, voffB); PG8_STAGE(PG8_SA(1, 0), cA + kstep, voffA); PG8_STAGE(PG8_SB(1, 1), cB + hstep + kstep, voffB);
    PG8_WAIT_V(6); PG8_BAR;
    for (;;) {
        const bool has_next = S.next(ui + 1, nxt);
        const char* nA = has_next ? (const char*)PG8_ASEL(nxt) + (size_t)nxt.pm * tstep : cA; const char* nB = has_next ? (const char*)PG8_BSEL(nxt) + (size_t)nxt.pn * tstep : cB;
        for (int t = 0; t < nt; t += 2) {
            const bool last = (t == nt - 2);
            const char* a1 = cA + (size_t)(t + 1) * kstep;
            const char* a2 = last ? nA : cA + (size_t)(t + 2) * kstep; const char* b2 = last ? nB : cB + (size_t)(t + 2) * kstep;
            const char* a3 = a2 + kstep; const char* b3 = b2 + kstep;
            PG8_LDB(B0, 0, 0); PG8_LDB(B1, 0, 1); PG8_SCHED; PG8_LDA(At, 0, 0); PG8_STAGE(PG8_SA(1, 1), a1 + hstep, voffA);
            PG8_WAIT_V(8); PG8_WAIT_L(0); PG8_BAR; PG8_MMA(0, 0, At, B0); PG8_MMA(0, 1, At, B1); PG8_BAR; PG8_SCHED;
            PG8_LDA(At, 0, 1); PG8_STAGE(PG8_SB(0, 0), b2, voffB); PG8_STAGE(PG8_SB(0, 1), b2 + hstep, voffB); PG8_STAGE(PG8_SA(0, 0), a2, voffA);
            PG8_WAIT_V(8); PG8_WAIT_L(0); PG8_BAR; PG8_MMA(1, 0, At, B0); PG8_MMA(1, 1, At, B1); PG8_BAR; PG8_SCHED;
            PG8_LDB(B0, 1, 0); PG8_LDB(B1, 1, 1); PG8_SCHED; PG8_LDA(At, 1, 0); PG8_STAGE(PG8_SA(0, 1), a2 + hstep, voffA);
            PG8_WAIT_V(8); PG8_WAIT_L(0); PG8_BAR; PG8_MMA(0, 0, At, B0); PG8_MMA(0, 1, At, B1); PG8_BAR; PG8_SCHED;
            PG8_LDA(At, 1, 1); PG8_STAGE(PG8_SB(1, 0), b3, voffB); PG8_STAGE(PG8_SB(1, 1), b3 + hstep, voffB); PG8_STAGE(PG8_SA(1, 0), a3, voffA);
            PG8_WAIT_V(8); PG8_WAIT_L(0); PG8_BAR; PG8_MMA(1, 0, At, B0); PG8_MMA(1, 1, At, B1); PG8_BAR; PG8_SCHED;
        }
        if constexpr (ALIGN_EPI) { if (wr == 0) PG8_BAR; }
        const bool keep = E(acc, cur, wr, wc, fr, fq, lane);
#ifdef PROBE_EPI2
        if constexpr (Epi::IDEMP) {
#pragma unroll
            for (int a = 0; a < 2; ++a)
#pragma unroll
                for (int b = 0; b < 2; ++b)
#pragma unroll
                    for (int m = 0; m < 4; ++m)
#pragma unroll
                        for (int n = 0; n < 2; ++n) asm volatile("" : "+v"(acc[a][b][m][n]));
            asm volatile("" ::: "memory");
            (void)E(acc, cur, wr, wc, fr, fq, lane);
        }
#endif
        if (!has_next) break;
        if (!keep) {
#pragma unroll
        for (int a = 0; a < 2; ++a)
#pragma unroll
            for (int b = 0; b < 2; ++b)
#pragma unroll
                for (int m = 0; m < 4; ++m)
#pragma unroll
                    for (int n = 0; n < 2; ++n) acc[a][b][m][n] = (f32x4){0.f, 0.f, 0.f, 0.f};
        E.init(acc, nxt, wr, wc, lane);
        }
        cur = nxt; cA = nA; cB = nB; ++ui;
        if constexpr (ALIGN_EPI) { if (wr == 1) PG8_BAR; }
    }
    PG8_WAIT_V(0);
    if constexpr (!ALIGN_EPI) { if (wr == 0) PG8_BAR; }
    PG8_BAR;
#undef PG8_SA
#undef PG8_SB
#undef PG8_STAGE
#undef PG8_LDA
#undef PG8_LDB
#undef PG8_MMA
#undef PG8_WAIT_V
#undef PG8_WAIT_L
#undef PG8_BAR
#undef PG8_SCHED
#undef PG8_ASEL
#undef PG8_BSEL
}
}

constexpr int NWAVES = 8;
constexpr int BATCH = 2, SEQ = 8192, DM = 1024, M = BATCH * SEQ, DFF = 2816, NLAYER = 2, INW = 10000;
constexpr float NORM_EPS = 1e-6f;
constexpr float LOG2E = 1.4426950408889634f;
constexpr float QSCALE = 0.125f * LOG2E;

constexpr size_t MiB = 1u << 20;
constexpr size_t WS_CTL = 0, CTL_ZERO_BYTES = 64 * 1024;
constexpr size_t WS_SSQ = 1 * MiB;
constexpr size_t WS_COS = 2 * MiB;
constexpr size_t WS_S1 = 6 * MiB;
constexpr size_t WS_S2 = 17 * MiB;
constexpr size_t WS_DC = 22 * MiB + 512 * 1024;
constexpr size_t WS_WG = 23 * MiB;
constexpr size_t WS_WB = 29 * MiB;
constexpr size_t WS_WO = 32 * MiB;
constexpr size_t WS_ACT = 34 * MiB;
constexpr size_t UU = 4 * MiB;
constexpr size_t WS_AQ0 = WS_ACT + 0 * UU, WS_AQ1 = WS_ACT + 4 * UU, WS_AQ2 = WS_ACT + 8 * UU;
constexpr size_t WS_AK0 = WS_ACT + 12 * UU, WS_AV0 = WS_ACT + 24 * UU;
constexpr size_t WS_GATES = WS_ACT + 12 * UU;
constexpr size_t WS_MERGED = WS_ACT + 50 * UU;
constexpr size_t WS_BQ = WS_ACT + 36 * UU, WS_BK = WS_ACT + 40 * UU, WS_BV = WS_ACT + 41 * UU;
constexpr size_t WS_CQ = WS_ACT + 42 * UU, WS_CK = WS_ACT + 44 * UU, WS_CV = WS_ACT + 46 * UU;
constexpr size_t WS_LOGG = WS_ACT + 50 * UU;
constexpr size_t WS_CR = WS_ACT + 52 * UU;
constexpr size_t WS_STATE = WS_ACT + 56 * UU;
constexpr size_t WS_XB = WS_ACT + 60 * UU;
constexpr size_t WS_ACTH = WS_ACT;
constexpr size_t WS_LSE = WS_ACT + 68 * UU;
constexpr size_t WS_END = WS_LSE + 3 * (size_t)M * 8 * 4;
static_assert(WS_S1 + (size_t)2 * DFF * DM * 2 <= WS_S2 && WS_S2 + (size_t)DM * DFF * 2 <= WS_DC && WS_DC + 8 * 128 * 64 * 4 <= WS_WG, "ws map");
static_assert((size_t)M * DFF * 2 <= 22 * UU && (size_t)7168 * 1024 * 2 <= 4 * UU, "ws map 2");
constexpr int CW_TMO = 0, CW_CODE = 1;
constexpr int CW_BAR = 4096;

constexpr int RING_OFF = 0, RING_BYTES = 131072;
constexpr int LDSCTL_OFF = RING_BYTES, MISC_OFF = LDSCTL_OFF + 320;
constexpr int LDS_BYTES = 147456;
constexpr int INTAB_OFF = MISC_OFF + 256;
constexpr int RSTD_OFF = INTAB_OFF + 256;

#define GAS __attribute__((address_space(1)))
#define LAS __attribute__((address_space(3)))
typedef unsigned short bf16;
typedef unsigned v4u __attribute__((ext_vector_type(4)));
typedef unsigned v2u __attribute__((ext_vector_type(2)));
typedef float f32x4 __attribute__((ext_vector_type(4)));
typedef short bf16x8 __attribute__((ext_vector_type(8)));
typedef _Float16 h16x2 __attribute__((ext_vector_type(2)));
typedef GAS unsigned gu32;
#define RLX_AGENT __ATOMIC_RELAXED, __HIP_MEMORY_SCOPE_AGENT
#define LDS_WAIT() asm volatile("s_waitcnt lgkmcnt(0)" ::: "memory")
#define VM_WAIT() asm volatile("s_waitcnt vmcnt(0)" ::: "memory")
__device__ __forceinline__ unsigned f2bf(float f) { unsigned u = __builtin_bit_cast(unsigned, f); return (u + 0x7fffu + ((u >> 16) & 1u)) >> 16; }
__device__ __forceinline__ float h2f16(unsigned short b) { return (float)__builtin_bit_cast(_Float16, b); }
__device__ __forceinline__ float hlo16(unsigned w) { return h2f16((unsigned short)(w & 0xffffu)); }
__device__ __forceinline__ float hhi16(unsigned w) { return h2f16((unsigned short)(w >> 16)); }
__device__ __forceinline__ float h2f(unsigned short b) { return MK_BF16 ? __builtin_bit_cast(float, (unsigned)b << 16) : h2f16(b); }
__device__ __forceinline__ unsigned short f2h(float f) { return MK_BF16 ? (unsigned short)((__builtin_bit_cast(unsigned, f) + 0x7fffu + ((__builtin_bit_cast(unsigned, f) >> 16) & 1u)) >> 16) : __builtin_bit_cast(unsigned short, (_Float16)f); }
__device__ __forceinline__ float hlo(unsigned w) { return h2f((unsigned short)(w & 0xffffu)); }
__device__ __forceinline__ float hhi(unsigned w) { return h2f((unsigned short)(w >> 16)); }
__device__ __forceinline__ unsigned pk2(float lo, float hi) { return pg8::cvt_pk_h(lo, hi); }
__device__ __forceinline__ float bflo(unsigned w) { return __builtin_bit_cast(float, w << 16); }
__device__ __forceinline__ float bfhi(unsigned w) { return __builtin_bit_cast(float, w & 0xffff0000u); }
__device__ __forceinline__ float bf2f(bf16 h) { return __builtin_bit_cast(float, (unsigned)h << 16); }
__device__ __forceinline__ float fexp2(float x) { return __builtin_amdgcn_exp2f(x); }
__device__ __forceinline__ float fexp(float x) { return __builtin_amdgcn_exp2f(x * LOG2E); }
__device__ __forceinline__ float frcp(float x) { return __builtin_amdgcn_rcpf(x); }
__device__ __forceinline__ float sigmoidf_(float x) { return frcp(1.0f + fexp(-x)); }
__device__ __forceinline__ float siluf_(float x) { return x * sigmoidf_(x); }

#define XB_TMO      128
#define XB_XCNT(j)  (256  + 64 * (j))
#define XB_XSUB(j)  (1280 + 64 * (j))
#define XB_XGEN(j)  (2304 + 64 * (j))
#define XB_TOP      3328
#define XB_TOPGEN   3392
#define XCD_BAR_WORDS 3456
#define XB_SPIN_CAP (1u << 18)
__device__ __forceinline__ unsigned xb_ld(unsigned* p)              { return __hip_atomic_load(p, __ATOMIC_RELAXED, __HIP_MEMORY_SCOPE_AGENT); }
__device__ __forceinline__ unsigned xb_add(unsigned* p, unsigned v) { return __hip_atomic_fetch_add(p, v, __ATOMIC_RELAXED, __HIP_MEMORY_SCOPE_AGENT); }
__device__ __forceinline__ unsigned xb_xcc_id() { return (unsigned)__builtin_amdgcn_s_getreg((3 << 11) | 20) & 0xFu; }
#define XB_SPIN(cond, bar) do { unsigned _sp = 0; while (cond) { __builtin_amdgcn_s_sleep(1); \
    if ((++_sp & 255u) == 0u) { if (xb_ld(&(bar)[XB_TMO])) break; if (_sp > XB_SPIN_CAP) { atomicAdd(&(bar)[XB_TMO], 1u); break; } } } } while (0)
struct XcdBarrier { unsigned* bar; unsigned x; volatile LAS unsigned* st; };
__device__ __forceinline__ XcdBarrier xcd_barrier_post(unsigned* bar, volatile LAS unsigned* st) {
    XcdBarrier b; b.bar = bar; b.x = xb_xcc_id(); b.st = st;
    if (threadIdx.x == 0) (void)xb_add(&bar[XB_XCNT(b.x)], 1u);
    return b;
}
__device__ __forceinline__ void xcd_barrier_complete(unsigned* bar, unsigned x, unsigned& nloc, unsigned& nx) {
    const unsigned G = gridDim.x * gridDim.y * gridDim.z;
    unsigned sum, cnt, mine, sp = 0u;
    for (;;) {
        sum = 0u; cnt = 0u; mine = 0u;
#pragma unroll
        for (unsigned j = 0; j < 16; ++j) { const unsigned c = xb_ld(&bar[XB_XCNT(j)]); sum += c; cnt += (c > 0u) ? 1u : 0u; mine = (j == x) ? c : mine; }
        if (sum == G) break;
        __builtin_amdgcn_s_sleep(1);
        if ((++sp & 255u) == 0u) { if (xb_ld(&bar[XB_TMO])) break; if (sp > XB_SPIN_CAP) { atomicAdd(&bar[XB_TMO], 1u); break; } }
    }
    nloc = mine > 0u ? mine : 1u; nx = cnt > 0u ? cnt : 1u;
}
__device__ __forceinline__ void xcd_barrier(const XcdBarrier& b) {
    asm volatile("s_waitcnt vmcnt(0)" ::: "memory");
    __syncthreads();
    if (threadIdx.x == 0) {
        unsigned* bar = b.bar;
        __builtin_amdgcn_s_waitcnt(0);
        unsigned nloc = b.st[0], nx = b.st[1];
        if (nloc == 0u) { xcd_barrier_complete(bar, b.x, nloc, nx); b.st[0] = nloc; b.st[1] = nx; }
        const unsigned old = xb_add(&bar[XB_XSUB(b.x)], 1u);
        const unsigned gen = old / nloc;
        if (old + 1u == (gen + 1u) * nloc) {
            __builtin_amdgcn_fence(__ATOMIC_RELEASE, "agent");
            asm volatile("s_waitcnt vmcnt(0)" ::: "memory");
            const unsigned og = xb_add(&bar[XB_TOP], 1u);
            const unsigned tg = og / nx;
            if (og + 1u == (tg + 1u) * nx) xb_add(&bar[XB_TOPGEN], 1u);
            else XB_SPIN(xb_ld(&bar[XB_TOPGEN]) == tg, bar);
            __builtin_amdgcn_fence(__ATOMIC_ACQUIRE, "agent");
            xb_add(&bar[XB_XGEN(b.x)], 1u);
            asm volatile("s_waitcnt vmcnt(0)" ::: "memory");
        } else {
            XB_SPIN(xb_ld(&bar[XB_XGEN(b.x)]) == gen, bar);
            __builtin_amdgcn_fence(__ATOMIC_ACQUIRE, "agent");
            asm volatile("s_waitcnt vmcnt(0)" ::: "memory");
        }
    }
    __syncthreads();
}

struct Frame {
    LAS unsigned char* lds;
    volatile LAS unsigned* MISC;
    gu32* ctl;
    int tid, lane, wave;
    int vcu, G, bx;
    unsigned char* ws;
    float* X;
};
__device__ __forceinline__ const float* inptr(const Frame& F, int i) {
    const LAS unsigned* t = (const LAS unsigned*)(F.lds + INTAB_OFF); unsigned lo = t[2 * i], hi = t[2 * i + 1];
    lo = __builtin_amdgcn_readfirstlane(lo); hi = __builtin_amdgcn_readfirstlane(hi);
    return (const float*)(const GAS float*)(((unsigned long long)hi << 32) | lo);
}
__device__ __forceinline__ float wave_sum(float v) {
#pragma unroll
    for (int o = 1; o < 64; o <<= 1) v += __shfl_xor(v, o);
    return v;
}
__device__ __forceinline__ float wave_max(float v) {
#pragma unroll
    for (int o = 1; o < 64; o <<= 1) v = fmaxf(v, __shfl_xor(v, o));
    return v;
}

__device__ __forceinline__ unsigned hmin2(unsigned a, unsigned b) { typedef _Float16 hh2 __attribute__((ext_vector_type(2))); const hh2 x = __builtin_bit_cast(hh2, a), y = __builtin_bit_cast(hh2, b); return __builtin_bit_cast(unsigned, __builtin_elementwise_min(x, y)); }
__device__ __forceinline__ unsigned hmax2(unsigned a, unsigned b) { typedef _Float16 hh2 __attribute__((ext_vector_type(2))); const hh2 x = __builtin_bit_cast(hh2, a), y = __builtin_bit_cast(hh2, b); return __builtin_bit_cast(unsigned, __builtin_elementwise_max(x, y)); }
__device__ __forceinline__ void plswap32(float& a, float& b) { asm("s_nop 1\n\tv_permlane32_swap_b32 %0, %1" : "+v"(a), "+v"(b)); }
__device__ __forceinline__ void plswap16(float& a, float& b) { asm("s_nop 1\n\tv_permlane16_swap_b32 %0, %1" : "+v"(a), "+v"(b)); }
__device__ __forceinline__ float xsum32(float v) { float a = v, b = v; plswap32(a, b); return a + b; }
__device__ __forceinline__ float xsum16(float v) { float a = v, b = v; plswap16(a, b); return a + b; }
__device__ __forceinline__ float xmax32(float v) { float a = v, b = v; plswap32(a, b); return fmaxf(a, b); }
namespace pg8 {
__device__ __forceinline__ void load_rstd(const float* ssq, int pm, int wr, int lane, float (&rs)[2][4]) {
    float mine[2];
#pragma unroll
    for (int ai = 0; ai < 2; ++ai) { const f32x4* p = (const f32x4*)(ssq + (size_t)(pm * 256 + ai * 128 + wr * 64 + lane) * 16);
        const f32x4 a = p[0], b = p[1], c = p[2], d = p[3]; const f32x4 s = (a + b) + (c + d);
        mine[ai] = 1.0f / sqrtf(((s[0] + s[1]) + (s[2] + s[3])) * (1.0f / DM) + NORM_EPS); }
#pragma unroll
    for (int ai = 0; ai < 2; ++ai)
#pragma unroll
        for (int m = 0; m < 4; ++m) rs[ai][m] = __shfl(mine[ai], 16 * m + (lane & 15));
}
__device__ __forceinline__ void get_rstd(const PG8_LAS float* rtab, int rpm, const float* ssq, int pm, int wr, int fr, int lane, float (&rs)[2][4]) {
    if (pm == rpm) {
#pragma unroll
        for (int ai = 0; ai < 2; ++ai)
#pragma unroll
            for (int m = 0; m < 4; ++m) rs[ai][m] = rtab[ai * 128 + wr * 64 + m * 16 + fr];
    } else load_rstd(ssq, pm, wr, lane, rs);
}
__device__ __forceinline__ u32x4 pack8(const f32x4& a, const f32x4& b) { u32x4 w; w.x = cvt_pk_h(a[0], a[1]); w.y = cvt_pk_h(a[2], a[3]); w.z = cvt_pk_h(b[0], b[1]); w.w = cvt_pk_h(b[2], b[3]); return w; }
__device__ __forceinline__ u32x4 pack8_bf(const f32x4& a, const f32x4& b) { u32x4 w; w.x = cvt_pk_bf(a[0], a[1]); w.y = cvt_pk_bf(a[2], a[3]); w.z = cvt_pk_bf(b[0], b[1]); w.w = cvt_pk_bf(b[2], b[3]); return w; }

struct RstdPro { f32x4 a, b, c, d; };
struct NoPro {};
__device__ __forceinline__ void rstd_pro_load(RstdPro& p, const float* ssq, int pm, int tid) {
    p.a = p.b = p.c = p.d = (f32x4){0.f, 0.f, 0.f, 0.f};
    if (tid < 256) { const f32x4* q = (const f32x4*)(ssq + (size_t)(pm * 256 + tid) * 16); p.a = q[0]; p.b = q[1]; p.c = q[2]; p.d = q[3]; }
}
__device__ __forceinline__ void rstd_pro_store(const RstdPro& p, const PG8_LAS float* rtab, int tid) {
    if (tid < 256) { const f32x4 s = (p.a + p.b) + (p.c + p.d); ((PG8_LAS float*)rtab)[tid] = 1.0f / sqrtf(((s[0] + s[1]) + (s[2] + s[3])) * (1.0f / DM) + NORM_EPS); }
}
struct EpiSwiglu {
    static constexpr bool PERM = true;
    static constexpr bool IDEMP = true;
    typedef RstdPro Pro;
    __device__ __forceinline__ void pro_load(Pro& p, const Unit& u, int tid) const { rstd_pro_load(p, ssq, u.pm, tid); }
    __device__ __forceinline__ void pro_store(const Pro& p, int tid) const { rstd_pro_store(p, rtab, tid); }
    bf16_t* O; const float* ssq; const PG8_LAS float* rtab; int rpm;
    __device__ __forceinline__ void init(f32x4 (&)[2][2][4][2], const Unit&, int, int, int) const {}
    __device__ __forceinline__ bool operator()(f32x4 (&acc)[2][2][4][2], const Unit& u, int wr, int wc, int fr_, int fq_, int lane_) const {
        int lane = lane_; asm volatile("" : "+v"(lane)); lane &= 63; const int fr = lane & 15, fq = lane >> 4;
        float rs[2][4]; get_rstd(rtab, rpm, ssq, u.pm, wr, fr, lane, rs);
        const int col0 = u.pn * 128 + wc * 32 + 8 * fq;
#pragma unroll
        for (int ai = 0; ai < 2; ++ai)
#pragma unroll
            for (int m = 0; m < 4; ++m) { const float r = rs[ai][m]; const size_t row = (size_t)(u.pm * BM + ai * HALF + wr * 64 + m * 16 + fr);
                f32x4 o[2]; const float r2 = r * (-LOG2E), rr = r * r;
#pragma unroll
                for (int n = 0; n < 2; ++n) { const f32x4 g = acc[ai][0][m][n], t = g * r2; f32x4 e, s;
#pragma unroll
                    for (int j = 0; j < 4; ++j) e[j] = fexp2(t[j]);
                    const f32x4 d = e + 1.0f;
#pragma unroll
                    for (int j = 0; j < 4; ++j) s[j] = frcp(d[j]);
                    o[n] = (g * acc[ai][1][m][n]) * (s * rr); }
                *(u32x4*)(O + row * DFF + col0) = pack8(o[0], o[1]); }
        return false;
    }
};
struct EpiResidual {
    static constexpr bool PERM = true;
    static constexpr bool IDEMP = true;
    typedef NoPro Pro;
    __device__ __forceinline__ void pro_load(Pro&, const Unit&, int) const {}
    __device__ __forceinline__ void pro_store(const Pro&, int) const {}
    float* Xout; bf16_t* XB; float* ssq; float scale, inv_scale;
    __device__ __forceinline__ void init(f32x4 (&acc)[2][2][4][2], const Unit& u, int wr, int wc, int lane_) const {
        int lane = lane_; asm volatile("" : "+v"(lane)); lane &= 63; const int fr = lane & 15, fq = lane >> 4;
        const int col0 = u.pn * BM + wc * 32 + 8 * fq;
#pragma unroll
        for (int ai = 0; ai < 2; ++ai)
#pragma unroll
            for (int m = 0; m < 4; ++m) { const bf16_t* xr = XB + (size_t)(u.pm * BM + ai * HALF + wr * 64 + m * 16 + fr) * DM + col0;
#pragma unroll
                for (int bj = 0; bj < 2; ++bj) { const u32x4 w = *(const u32x4*)(xr + bj * HALF);
                    acc[ai][bj][m][0] = (f32x4){hlo(w.x), hhi(w.x), hlo(w.y), hhi(w.y)} * inv_scale; acc[ai][bj][m][1] = (f32x4){hlo(w.z), hhi(w.z), hlo(w.w), hhi(w.w)} * inv_scale; }
                if (m & 1) asm volatile("" ::: "memory"); }
    }
    __device__ __forceinline__ bool operator()(f32x4 (&acc)[2][2][4][2], const Unit& u, int wr, int wc, int fr_, int fq_, int lane_) const {
        int lane = lane_; asm volatile("" : "+v"(lane)); lane &= 63; const int fr = lane & 15, fq = lane >> 4;
        const int col0 = u.pn * BM + wc * 32 + 8 * fq;
#pragma unroll
        for (int ai = 0; ai < 2; ++ai)
#pragma unroll
            for (int m = 0; m < 4; ++m) { const size_t row = (size_t)(u.pm * BM + ai * HALF + wr * 64 + m * 16 + fr); float q = 0.f;
#pragma unroll
                for (int bj = 0; bj < 2; ++bj) {
                    const f32x4 x0 = acc[ai][bj][m][0] * scale, x1 = acc[ai][bj][m][1] * scale;
                    if (Xout) { float* xp = Xout + row * DM + col0 + bj * HALF; *(f32x4*)xp = x0; *(f32x4*)(xp + 4) = x1; }
                    q += (x0[0] * x0[0] + x0[1] * x0[1]) + (x0[2] * x0[2] + x0[3] * x0[3]) + (x1[0] * x1[0] + x1[1] * x1[1]) + (x1[2] * x1[2] + x1[3] * x1[3]);
                    if (!Xout) *(u32x4*)(XB + row * DM + col0 + bj * HALF) = pack8(x0, x1); }
                if (!Xout) { q = xsum32(xsum16(q));
                    if (fq == 0) ssq[row * 16 + u.pn * 4 + wc] = q; } }
        return false;
    }
};
struct EpiSigmoid {
    static constexpr bool PERM = true;
    static constexpr bool IDEMP = true;
    typedef RstdPro Pro;
    __device__ __forceinline__ void pro_load(Pro& p, const Unit& u, int tid) const { rstd_pro_load(p, ssq, u.pm, tid); }
    __device__ __forceinline__ void pro_store(const Pro& p, int tid) const { rstd_pro_store(p, rtab, tid); }
    bf16_t* O; const float* ssq; const PG8_LAS float* rtab; int rpm;
    __device__ __forceinline__ void init(f32x4 (&)[2][2][4][2], const Unit&, int, int, int) const {}
    __device__ __forceinline__ bool operator()(f32x4 (&acc)[2][2][4][2], const Unit& u, int wr, int wc, int fr_, int fq_, int lane_) const {
        int lane = lane_; asm volatile("" : "+v"(lane)); lane &= 63; const int fr = lane & 15, fq = lane >> 4;
        float rs[2][4]; get_rstd(rtab, rpm, ssq, u.pm, wr, fr, lane, rs);
        bf16_t* base = O + (size_t)(u.pn >> 2) * M * DM + (u.pn & 3) * 256 + wc * 32 + 8 * fq;
        const bool recip = (u.pn >> 2) != 0;
#pragma unroll
        for (int ai = 0; ai < 2; ++ai)
#pragma unroll
            for (int m = 0; m < 4; ++m) { const float r = rs[ai][m]; const size_t row = (size_t)(u.pm * BM + ai * HALF + wr * 64 + m * 16 + fr);
#pragma unroll
                for (int bj = 0; bj < 2; ++bj) { f32x4 o[2]; const float r2 = r * (-LOG2E);
#pragma unroll
                    for (int n = 0; n < 2; ++n) { const f32x4 t = acc[ai][bj][m][n] * r2; f32x4 e;
#pragma unroll
                        for (int j = 0; j < 4; ++j) e[j] = fexp2(t[j]);
                        const f32x4 d = e + 1.0f;
                        if (recip) { o[n] = d; } else {
#pragma unroll
                        for (int j = 0; j < 4; ++j) o[n][j] = frcp(d[j]); } }
                    u32x4 w = pack8(o[0], o[1]);
                    if (recip) { w.x = hmin2(w.x, 0x7BFF7BFFu); w.y = hmin2(w.y, 0x7BFF7BFFu); w.z = hmin2(w.z, 0x7BFF7BFFu); w.w = hmin2(w.w, 0x7BFF7BFFu); }
                    else { w.x = hmax2(w.x, 0x00010001u); w.y = hmax2(w.y, 0x00010001u); w.z = hmax2(w.z, 0x00010001u); w.w = hmax2(w.w, 0x00010001u); }
                    *(u32x4*)(base + row * DM + bj * HALF) = w; } }
        return false;
    }
};
struct EpiMerge {
    static constexpr bool PERM = true;
    static constexpr bool IDEMP = false;
    typedef NoPro Pro;
    __device__ __forceinline__ void pro_load(Pro&, const Unit&, int) const {}
    __device__ __forceinline__ void pro_store(const Pro&, int) const {}
    const bf16_t* GT; bf16_t* O;
    __device__ __forceinline__ void init(f32x4 (&)[2][2][4][2], const Unit&, int, int, int) const {}
    __device__ __forceinline__ void fetch(const bf16_t* g, const Unit& u, int ai, int wr, int col0, int fr, u32x4 (&t)[4][2]) const {
#pragma unroll
        for (int m = 0; m < 4; ++m)
#pragma unroll
            for (int bj = 0; bj < 2; ++bj) t[m][bj] = *(const u32x4*)(g + (size_t)(u.pm * BM + ai * HALF + wr * 64 + m * 16 + fr) * DM + col0 + bj * HALF);
    }
    __device__ __forceinline__ bool operator()(f32x4 (&acc)[2][2][4][2], const Unit& u, int wr, int wc, int fr_, int fq_, int lane_) const {
        int lane = lane_; asm volatile("" : "+v"(lane)); lane &= 63; const int fr = lane & 15, fq = lane >> 4;
        const int col0 = u.pn * BM + wc * 32 + 8 * fq; const int s = u.seg;
#pragma unroll
        for (int ai = 0; ai < 2; ++ai) {
            u32x4 t[4][2], t2[4][2];
            fetch(GT + (size_t)s * M * DM, u, ai, wr, col0, fr, t);
            if (s < 2) fetch(GT + (size_t)(s + 1) * M * DM, u, ai, wr, col0, fr, t2);
#pragma unroll
            for (int m = 0; m < 4; ++m)
#pragma unroll
                for (int bj = 0; bj < 2; ++bj) { const u32x4 a = t[m][bj];
                    const float ga[8] = {hlo(a.x), hhi(a.x), hlo(a.y), hhi(a.y), hlo(a.z), hhi(a.z), hlo(a.w), hhi(a.w)};
                    if (s == 0) {
#pragma unroll
                    for (int e = 0; e < 8; ++e) acc[ai][bj][m][e >> 2][e & 3] *= ga[e]; } else {
#pragma unroll
                    for (int e = 0; e < 8; ++e) acc[ai][bj][m][e >> 2][e & 3] *= frcp(ga[e]); } }
            if (s < 2) {
#pragma unroll
                for (int m = 0; m < 4; ++m)
#pragma unroll
                    for (int bj = 0; bj < 2; ++bj) { const u32x4 a = t2[m][bj];
                        const float gb[8] = {hlo(a.x), hhi(a.x), hlo(a.y), hhi(a.y), hlo(a.z), hhi(a.z), hlo(a.w), hhi(a.w)};
#pragma unroll
                        for (int e = 0; e < 8; ++e) acc[ai][bj][m][e >> 2][e & 3] *= gb[e]; }
            } else {
#pragma unroll
                for (int m = 0; m < 4; ++m)
#pragma unroll
                    for (int bj = 0; bj < 2; ++bj) *(u32x4*)(O + (size_t)(u.pm * BM + ai * HALF + wr * 64 + m * 16 + fr) * DM + col0 + bj * HALF) = pack8(acc[ai][bj][m][0], acc[ai][bj][m][1]);
            }
            asm volatile("" ::: "memory");
        }
        return s < 2;
    }
};
struct EpiInProj {
    static constexpr bool PERM = true;
    static constexpr bool IDEMP = true;
    typedef RstdPro Pro;
    __device__ __forceinline__ void pro_load(Pro& p, const Unit& u, int tid) const { rstd_pro_load(p, ssq, u.pm, tid); }
    __device__ __forceinline__ void pro_store(const Pro& p, int tid) const { rstd_pro_store(p, rtab, tid); }
    unsigned char* ws; const float* ssq; const bf16_t* rope; const PG8_LAS float* rtab; int rpm;
    const float* aq_n; const float* ak_n; const float* bq_n; const float* bk_n; const float* gbias;
    __device__ __forceinline__ void init(f32x4 (&)[2][2][4][2], const Unit&, int, int, int) const {}
    __device__ __forceinline__ bool operator()(f32x4 (&acc)[2][2][4][2], const Unit& u, int wr, int wc, int fr_, int fq_, int lane_) const {
        int lane = lane_; asm volatile("" : "+v"(lane)); lane &= 63; const int fr = lane & 15, fq = lane >> 4;
        float rs[2][4]; get_rstd(rtab, rpm, ssq, u.pm, wr, fr, lane, rs);
        const int t = u.pn;
        int mode, pitch, colA, colB; bf16_t* dst; const float* gain = nullptr; float sc = 1.f; bool act = false, asbf = false;
        if (t < 18) { const int w = t / 6, tt = t % 6, g = tt >> 1, hd = ((tt & 1) * 4 + wc) * 64 + 8 * fq;
            dst = (bf16_t*)(ws + (w == 0 ? (g == 0 ? WS_AQ0 : (g == 1 ? WS_AQ1 : WS_AQ2)) : (w == 1 ? WS_AK0 + (size_t)g * 4 * UU : WS_AV0 + (size_t)g * 4 * UU)));
            pitch = 512; colA = hd; colB = hd + 32; mode = (w == 2) ? 1 : 0; gain = (w == 0) ? aq_n : ak_n; sc = (w == 0) ? QSCALE : 1.f; }
        else if (t < 20) { dst = (bf16_t*)(ws + WS_BQ); pitch = 512; colA = ((t - 18) * 4 + wc) * 64 + 8 * fq; colB = colA + 32; mode = 0; gain = bq_n; sc = QSCALE; }
        else if (t == 20) { pitch = 128; colA = (wc & 1) * 64 + 8 * fq; colB = colA + 32;
            if (wc < 2) { dst = (bf16_t*)(ws + WS_BK); mode = 0; gain = bk_n; } else { dst = (bf16_t*)(ws + WS_BV); mode = 1; } }
        else { colA = wc * 32 + 8 * fq; colB = colA + 128; mode = 2;
            if (t == 21) { dst = (bf16_t*)(ws + WS_CQ); pitch = 256; sc = 0.125f; mode = 4; }
            else if (t == 22) { dst = (bf16_t*)(ws + WS_CK); pitch = 256; mode = 4; }
            else if (t < 25) { dst = (bf16_t*)(ws + WS_CV); pitch = 512; colA += (t - 23) * 256; colB += (t - 23) * 256; asbf = true; }
            else if (t == 25) { dst = (bf16_t*)(ws + WS_LOGG); pitch = 256; mode = 3; }
            else { dst = (bf16_t*)(ws + WS_CR); pitch = 512; colA += (t - 26) * 256; colB += (t - 26) * 256; act = true; } }
        if (mode == 0) {
            f32x4 gA[2], gB[2];
#pragma unroll
            for (int n = 0; n < 2; ++n) { gA[n] = *(const f32x4*)(gain + 8 * fq + 4 * n); gB[n] = *(const f32x4*)(gain + 32 + 8 * fq + 4 * n); }
#pragma unroll
            for (int ai = 0; ai < 2; ++ai) {
            u32x4 cw[4], sw[4];
#pragma unroll
            for (int m = 0; m < 4; ++m) { const bf16_t* rp = rope + (size_t)(u.pm * BM + ai * HALF + wr * 64 + m * 16 + fr) * 64 + fq * 16; cw[m] = *(const u32x4*)rp; sw[m] = *(const u32x4*)(rp + 8); }
#pragma unroll
                for (int m = 0; m < 4; ++m) { const float r = rs[ai][m]; const size_t row = (size_t)(u.pm * BM + ai * HALF + wr * 64 + m * 16 + fr);
                    f32x4 a[2], b[2]; float ss = 0.f;
#pragma unroll
                    for (int n = 0; n < 2; ++n) { a[n] = acc[ai][0][m][n]; b[n] = acc[ai][1][m][n];
                        ss += (a[n][0] * a[n][0] + a[n][1] * a[n][1]) + (a[n][2] * a[n][2] + a[n][3] * a[n][3]) + (b[n][0] * b[n][0] + b[n][1] * b[n][1]) + (b[n][2] * b[n][2] + b[n][3] * b[n][3]); }
                    ss = xsum32(xsum16(ss));
                    const float rn = r * sc * __builtin_amdgcn_rsqf(ss * (r * r) * (1.0f / 64.0f) + NORM_EPS);
                    const u32x4 cq = cw[m], sq = sw[m];
                    const f32x4 cs[2] = {(f32x4){hlo16(cq.x), hhi16(cq.x), hlo16(cq.y), hhi16(cq.y)}, (f32x4){hlo16(cq.z), hhi16(cq.z), hlo16(cq.w), hhi16(cq.w)}};
                    const f32x4 sn[2] = {(f32x4){hlo16(sq.x), hhi16(sq.x), hlo16(sq.y), hhi16(sq.y)}, (f32x4){hlo16(sq.z), hhi16(sq.z), hlo16(sq.w), hhi16(sq.w)}};
                    f32x4 oa[2], ob[2];
#pragma unroll
                    for (int n = 0; n < 2; ++n) { const f32x4 y1 = a[n] * (gA[n] * rn), y2 = b[n] * (gB[n] * rn);
                        oa[n] = y1 * cs[n] - y2 * sn[n]; ob[n] = y2 * cs[n] + y1 * sn[n]; }
                    *(u32x4*)(dst + row * pitch + colA) = pack8(oa[0], oa[1]); *(u32x4*)(dst + row * pitch + colB) = pack8(ob[0], ob[1]); }
            asm volatile("" ::: "memory"); }
        } else if (mode == 3) {
            f32x4 bA[2], bB[2];
#pragma unroll
            for (int n = 0; n < 2; ++n) { bA[n] = *(const f32x4*)(gbias + colA + 4 * n); bB[n] = *(const f32x4*)(gbias + colB + 4 * n); }
#pragma unroll
            for (int ai = 0; ai < 2; ++ai)
#pragma unroll
                for (int m = 0; m < 4; ++m) { const float r = rs[ai][m]; const size_t row = (size_t)(u.pm * BM + ai * HALF + wr * 64 + m * 16 + fr);
#pragma unroll
                    for (int bj = 0; bj < 2; ++bj) { float v[8];
#pragma unroll
                        for (int e = 0; e < 8; ++e) { const float x = acc[ai][bj][m][e >> 2][e & 3] * r + (bj == 0 ? bA[e >> 2][e & 3] : bB[e >> 2][e & 3]);
                            v[e] = (fminf(x, 0.f) - __builtin_amdgcn_logf(1.0f + fexp(-fabsf(x))) * 0.6931471805599453f) * (1.0f / 16.0f); }
                        u32x4 w; { h16x2 p0 = {(_Float16)v[0], (_Float16)v[1]}, p1 = {(_Float16)v[2], (_Float16)v[3]}, p2 = {(_Float16)v[4], (_Float16)v[5]}, p3 = {(_Float16)v[6], (_Float16)v[7]};
                            w.x = __builtin_bit_cast(unsigned, p0); w.y = __builtin_bit_cast(unsigned, p1); w.z = __builtin_bit_cast(unsigned, p2); w.w = __builtin_bit_cast(unsigned, p3); }
                        *(u32x4*)(dst + row * pitch + (bj == 0 ? colA : colB)) = w; } }
        } else if (mode == 4) {
#pragma unroll
            for (int ai = 0; ai < 2; ++ai)
#pragma unroll
                for (int m = 0; m < 4; ++m) { const float r = rs[ai][m] * sc; const size_t row = (size_t)(u.pm * BM + ai * HALF + wr * 64 + m * 16 + fr);
#pragma unroll
                    for (int bj = 0; bj < 2; ++bj) { float v[8];
#pragma unroll
                        for (int e = 0; e < 8; ++e) v[e] = acc[ai][bj][m][e >> 2][e & 3] * r;
                        u32x4 w; { h16x2 p0 = {(_Float16)v[0], (_Float16)v[1]}, p1 = {(_Float16)v[2], (_Float16)v[3]}, p2 = {(_Float16)v[4], (_Float16)v[5]}, p3 = {(_Float16)v[6], (_Float16)v[7]};
                            w.x = __builtin_bit_cast(unsigned, p0); w.y = __builtin_bit_cast(unsigned, p1); w.z = __builtin_bit_cast(unsigned, p2); w.w = __builtin_bit_cast(unsigned, p3); }
                        *(u32x4*)(dst + row * pitch + (bj == 0 ? colA : colB)) = w; } }
        } else {
#pragma unroll
            for (int ai = 0; ai < 2; ++ai)
#pragma unroll
                for (int m = 0; m < 4; ++m) { const float r = rs[ai][m] * sc; const size_t row = (size_t)(u.pm * BM + ai * HALF + wr * 64 + m * 16 + fr);
#pragma unroll
                    for (int bj = 0; bj < 2; ++bj) { f32x4 o[2];
#pragma unroll
                        for (int n = 0; n < 2; ++n) { o[n] = acc[ai][bj][m][n] * r;
                            if (act) {
#pragma unroll
                                for (int j = 0; j < 4; ++j) o[n][j] = siluf_(o[n][j]); } }
                        *(u32x4*)(dst + row * pitch + (bj == 0 ? colA : colB)) = asbf ? pack8_bf(o[0], o[1]) : pack8(o[0], o[1]); } }
        }
        return false;
    }
};
}

__constant__ float ROPE_INV[32] = {
    1.000000000e+00f, 7.498942614e-01f, 5.623413324e-01f, 4.216965139e-01f, 3.162277639e-01f, 2.371373773e-01f, 1.778279394e-01f, 1.333521307e-01f,
    1.000000015e-01f, 7.498941571e-02f, 5.623413250e-02f, 4.216965288e-02f, 3.162277490e-02f, 2.371373773e-02f, 1.778279431e-02f, 1.333521493e-02f,
    9.999999776e-03f, 7.498941850e-03f, 5.623413250e-03f, 4.216964822e-03f, 3.162277630e-03f, 2.371373586e-03f, 1.778279431e-03f, 1.333521446e-03f,
    1.000000047e-03f, 7.498942432e-04f, 5.623413017e-04f, 4.216965172e-04f, 3.162277571e-04f, 2.371373703e-04f, 1.778279402e-04f, 1.333521504e-04f};

struct ConvJob { const float* W; int ldw; int K; bf16* WT; int nrows; const float* gain; int mode; int base; const float* gate_up; };
__device__ __forceinline__ int conv_src0(int mode, int base, int n0) {
    if (mode == 0) return base + n0;
    const int t = n0 >> 8, c = n0 & 255;
    if (mode == 1) return c < 128 ? t * 128 + c : DFF + t * 128 + (c - 128);
    const int bj = c >> 7, wc = (c >> 5) & 3;
    if (t < 18) return (t / 6) * 1536 + (4 * (t % 6) + wc) * 64 + 32 * bj;
    if (t < 20) return 4608 + (4 * (t - 18) + wc) * 64 + 32 * bj;
    if (t == 20) return 5120 + wc * 64 + 32 * bj;
    if (t == 21) return 5376 + c;
    if (t == 22) return 5632 + c;
    if (t < 25) return 5888 + 256 * (t - 23) + c;
    if (t == 25) return -1;
    return 6416 + 256 * (t - 26) + c;
}
struct ConvRegs { f32x4 v[8]; f32x4 g0, g1; int n0, kr, c; };
__device__ __forceinline__ void conv_load(const ConvJob& J, int item, int lane, ConvRegs& R) {
    const int nblk = J.nrows / 32, kb = item / nblk, nb = item % nblk, k0 = 64 * kb, n0 = 32 * nb;
    const int src0 = conv_src0(J.mode, J.base, n0), g = lane >> 3, c = lane & 7, kr = k0 + 8 * g;
    R.n0 = n0; R.kr = kr; R.c = c;
    if (J.gain) { R.g0 = *(const f32x4*)(J.gain + kr); R.g1 = *(const f32x4*)(J.gain + kr + 4); }
    if (src0 >= 0) {
        const float* wp = J.W + (size_t)kr * J.ldw + src0 + 4 * c;
#pragma unroll
        for (int i = 0; i < 8; ++i) R.v[i] = __builtin_nontemporal_load((const f32x4*)(wp + (size_t)i * J.ldw));
    } else {
        f32x4 ug[16];
#pragma unroll
        for (int r = 0; r < 16; ++r) ug[r] = *(const f32x4*)(J.gate_up + r * 256 + (n0 & 255) + 4 * c);
#pragma unroll
        for (int i = 0; i < 8; ++i) { const f32x4* wr = (const f32x4*)(J.W + (size_t)(kr + i) * J.ldw + 6400); f32x4 s = {0.f, 0.f, 0.f, 0.f};
#pragma unroll
            for (int q = 0; q < 4; ++q) { const f32x4 w4 = wr[q]; s += ug[4 * q + 0] * w4[0]; s += ug[4 * q + 1] * w4[1]; s += ug[4 * q + 2] * w4[2]; s += ug[4 * q + 3] * w4[3]; }
            R.v[i] = s; }
    }
}
__device__ __forceinline__ void conv_store(const ConvJob& J, ConvRegs& R) {
    if (J.gain) { const f32x4 g0 = R.g0, g1 = R.g1;
#pragma unroll
        for (int i = 0; i < 4; ++i) { R.v[i] = R.v[i] * g0[i]; R.v[4 + i] = R.v[4 + i] * g1[i]; } }
#pragma unroll
    for (int j = 0; j < 4; ++j) { v4u o; o.x = pk2(R.v[0][j], R.v[1][j]); o.y = pk2(R.v[2][j], R.v[3][j]); o.z = pk2(R.v[4][j], R.v[5][j]); o.w = pk2(R.v[6][j], R.v[7][j]);
        *(GAS v4u*)(J.WT + (size_t)(R.n0 + 4 * R.c + j) * J.K + R.kr) = o; }
}
__device__ __forceinline__ void conv_job(Frame& F, const ConvJob& J) {
    const int gw = F.vcu * NWAVES + F.wave, NGW = F.G * NWAVES, nitems = (J.nrows / 32) * (J.K / 64);
    for (int it = gw; it < nitems; it += 2 * NGW) {
        ConvRegs A, B; conv_load(J, it, F.lane, A);
        const bool two = it + NGW < nitems; if (two) conv_load(J, it + NGW, F.lane, B);
        conv_store(J, A); if (two) conv_store(J, B);
    }
}
__device__ __forceinline__ void conv_set(Frame& F, int set, int l) {
    if (set == 0 || set == 4) { ConvJob J{inptr(F, set == 0 ? 3 : 18) + (size_t)l * DM * 2 * DFF, 2 * DFF, DM, (bf16*)(F.ws + WS_S1), 2 * DFF, inptr(F, set == 0 ? 2 : 17) + (size_t)l * DM, 1, 0, nullptr}; conv_job(F, J); }
    else if (set == 1 || set == 5) { ConvJob J{inptr(F, set == 1 ? 4 : 19) + (size_t)l * DFF * DM, DM, DFF, (bf16*)(F.ws + WS_S2), DM, nullptr, 0, 0, nullptr}; conv_job(F, J); }
    else if (set == 2) { ConvJob J{inptr(F, 6) + (size_t)l * DM * INW, INW, DM, (bf16*)(F.ws + WS_STATE), 7168, inptr(F, 5) + (size_t)l * DM, 2, 0, inptr(F, 12) + (size_t)l * 16 * 256}; conv_job(F, J); }
    else {
        { ConvJob J{inptr(F, 6) + (size_t)l * DM * INW, INW, DM, (bf16*)(F.ws + WS_WG), 3072, inptr(F, 5) + (size_t)l * DM, 0, 6928, nullptr}; conv_job(F, J); }
        for (int i = 0; i < 3; ++i) { ConvJob J{inptr(F, 15) + ((size_t)l * 3 + i) * 512 * DM, DM, 512, (bf16*)(F.ws + WS_WB) + (size_t)i * DM * 512, DM, nullptr, 0, 0, nullptr}; conv_job(F, J); }
        { ConvJob J{inptr(F, 16) + (size_t)l * DM * DM, DM, DM, (bf16*)(F.ws + WS_WO), DM, nullptr, 0, 0, nullptr}; conv_job(F, J); }
    }
}

__device__ __forceinline__ void conv_one(Frame& F, int set, int l, int idx) {
    ConvJob J;
    if (set == 0 || set == 4) J = ConvJob{inptr(F, set == 0 ? 3 : 18) + (size_t)l * DM * 2 * DFF, 2 * DFF, DM, (bf16*)(F.ws + WS_S1), 2 * DFF, inptr(F, set == 0 ? 2 : 17) + (size_t)l * DM, 1, 0, nullptr};
    else if (set == 1 || set == 5) J = ConvJob{inptr(F, set == 1 ? 4 : 19) + (size_t)l * DFF * DM, DM, DFF, (bf16*)(F.ws + WS_S2), DM, nullptr, 0, 0, nullptr};
    else if (set == 2) J = ConvJob{inptr(F, 6) + (size_t)l * DM * INW, INW, DM, (bf16*)(F.ws + WS_STATE), 7168, inptr(F, 5) + (size_t)l * DM, 2, 0, inptr(F, 12) + (size_t)l * 16 * 256};
    else if (idx < 1536) J = ConvJob{inptr(F, 6) + (size_t)l * DM * INW, INW, DM, (bf16*)(F.ws + WS_WG), 3072, inptr(F, 5) + (size_t)l * DM, 0, 6928, nullptr};
    else if (idx < 2304) { const int i = (idx - 1536) >> 8; idx = (idx - 1536) & 255; J = ConvJob{inptr(F, 15) + ((size_t)l * 3 + i) * 512 * DM, DM, 512, (bf16*)(F.ws + WS_WB) + (size_t)i * DM * 512, DM, nullptr, 0, 0, nullptr}; }
    else { idx -= 2304; J = ConvJob{inptr(F, 16) + (size_t)l * DM * DM, DM, DM, (bf16*)(F.ws + WS_WO), DM, nullptr, 0, 0, nullptr}; }
    ConvRegs R; conv_load(J, idx, F.lane, R); conv_store(J, R);
}
constexpr int CONV_N0 = 2816, CONV_N1 = 1408, CONV_N2 = 3584, CONV_N3 = 2816;
__device__ __forceinline__ void shadow_conv(Frame& F, int ph) {
    const int slot = F.vcu * (NWAVES - 1) + (F.wave - 1), nslot = F.G * (NWAVES - 1);
    int set = -1, l = 0, j = 0, nb = 2;
    switch (ph) {
        case 2:  set = 3; l = 0; j = 0; break;          case 3:  set = 3; l = 0; j = 1; break;
        case 11: set = 3; l = 1; j = 0; break;          case 12: set = 3; l = 1; j = 1; break;
        case 4:  set = 4; l = 0; j = 0; break;          case 5:  set = 4; l = 0; j = 1; break;
        case 6:  set = 5; l = 0; j = 0; nb = 1; break;
        case 13: set = 4; l = 1; j = 0; break;          case 14: set = 4; l = 1; j = 1; break;
        case 15: set = 5; l = 1; j = 0; nb = 1; break;
        default: break; }
    if (set < 0 || l >= NLAYER) return;
    const int n = (set == 2) ? CONV_N2 : (set == 3 ? CONV_N3 : (set == 4 ? CONV_N0 : CONV_N1)), quota = (n + nb - 1) / nb, lo = j * quota, hi = (lo + quota < n) ? lo + quota : n;
    for (int v = lo + slot; v < hi; v += nslot) conv_one(F, set, l, v);
}

__device__ __forceinline__ void tail_conv_set(Frame& F, int set, int l, int n, int idle_idx, int n_idle) {
    for (int it = idle_idx * NWAVES + F.wave; it < n; it += n_idle * NWAVES) conv_one(F, set, l, it);
}
__device__ __forceinline__ void tail_conv(Frame& F, int ph, int idle_idx, int n_idle) {
    if (ph == 1) { tail_conv_set(F, 1, 0, CONV_N1, idle_idx, n_idle); tail_conv_set(F, 2, 0, CONV_N2, idle_idx, n_idle); }
    else if (ph == 9 && NLAYER > 1) { tail_conv_set(F, 2, 1, CONV_N2, idle_idx, n_idle); }
    else if (ph == 11) { tail_conv_set(F, 1, 1, CONV_N1, idle_idx, n_idle); }
}

__device__ __forceinline__ void p0_rows(Frame& F) {
    const int gw = F.vcu * NWAVES + F.wave, NGW = F.G * NWAVES;
    const float* x = inptr(F, 0); const int* pos = (const int*)inptr(F, 1);
    bf16* XB = (bf16*)(F.ws + WS_XB); float* ssq = (float*)(F.ws + WS_SSQ);
    for (int m0 = gw; m0 < M; m0 += 4 * NGW) {
        f32x4 v[4][4]; int pq[4];
#pragma unroll
        for (int q = 0; q < 4; ++q) { const int m = m0 + q * NGW; pq[q] = 0; if (m < M) { pq[q] = pos[m]; const GAS f32x4* xr = (const GAS f32x4*)(x + (size_t)m * DM) + F.lane;
#pragma unroll
                for (int j = 0; j < 4; ++j) v[q][j] = __builtin_nontemporal_load(xr + 64 * j); } }
#pragma unroll
        for (int q = 0; q < 4; ++q) { const int m = m0 + q * NGW; if (m >= M) break;
            GAS v2u* o8 = (GAS v2u*)(XB + (size_t)m * DM) + F.lane; float s = 0.f;
#pragma unroll
            for (int j = 0; j < 4; ++j) { const f32x4 t = v[q][j]; s += (t.x * t.x + t.y * t.y) + (t.z * t.z + t.w * t.w);
                v2u w; w.x = pk2(t.x, t.y); w.y = pk2(t.z, t.w); o8[64 * j] = w; }
            s = wave_sum(s);
            if (F.lane < 16) ssq[(size_t)m * 16 + F.lane] = (F.lane == 0) ? s : 0.f;
            if (F.lane < 32) { const float ang = (float)pq[q] * ROPE_INV[F.lane];
                const double rev = (double)ang * 0.15915494309189535; const float fr = (float)(rev - __builtin_rint(rev));
                bf16* rp = (bf16*)(F.ws + WS_COS) + (size_t)m * 64 + (F.lane >> 3) * 16 + (F.lane & 7);
                rp[0] = __builtin_bit_cast(unsigned short, (_Float16)__builtin_amdgcn_cosf(fr)); rp[8] = __builtin_bit_cast(unsigned short, (_Float16)__builtin_amdgcn_sinf(fr)); } }
    }
}

typedef float f32x16 __attribute__((ext_vector_type(16)));
typedef _Float16 h16x8 __attribute__((ext_vector_type(8)));
typedef short v4i16_t __attribute__((ext_vector_type(4)));
constexpr int ATT_BIAS_OFF = RSTD_OFF + 2048;
static_assert(ATT_BIAS_OFF + 12288 <= LDS_BYTES && ATT_BIAS_OFF % 16 == 0, "attention mask tables");
constexpr int ATT_K_OFF = 0, ATT_V_OFF = 49152, ATT_OST_OFF = 98304, ATT_SCR_OFF = RSTD_OFF;
struct BandUnit { const bf16* Q; const bf16* K; const bf16* V; bf16* O; float* LSE; int pq, pk, d, q0, win; size_t row0; float sink2; };
__device__ __forceinline__ int crow16(int r, int hi) { return (r & 3) + 8 * (r >> 2) + 4 * hi; }
struct BandRegs { v4u kr[6], vr[6]; bf16x8 qr[4]; };
__device__ __forceinline__ void band_load(Frame& F, const BandUnit& U, BandRegs& R) {
    const int tid = F.tid, c = tid & 7, i32 = F.lane & 31, hi = F.lane >> 5;
#pragma unroll
    for (int i = 0; i < 6; ++i) { const int rr = (tid >> 3) + 64 * i, ci = U.q0 - 128 + rr;
        if (ci >= 0) { const size_t off = (U.row0 + (size_t)ci * U.d) * U.pk + c * 8; R.kr[i] = *(const v4u*)(U.K + off); R.vr[i] = *(const v4u*)(U.V + off); }
        else { R.kr[i] = (v4u){0u, 0u, 0u, 0u}; R.vr[i] = (v4u){0u, 0u, 0u, 0u}; } }
    const size_t qtok = U.row0 + (size_t)(U.q0 + 32 * F.wave + i32) * U.d;
#pragma unroll
    for (int ks = 0; ks < 4; ++ks) R.qr[ks] = *(const bf16x8*)(U.Q + qtok * U.pq + 16 * ks + 8 * hi);
}
__device__ __forceinline__ void band_unit(Frame& F, const BandUnit& U, BandRegs& R, bool has_next, const BandUnit& Un, BandRegs& Rn) {
    const int tid = F.tid, lane = F.lane, w = F.wave, i32 = lane & 31, hi = lane >> 5;
    LAS unsigned char* lds = F.lds;
    { const int c = tid & 7;
#pragma unroll
        for (int i = 0; i < 6; ++i) { const int rr = (tid >> 3) + 64 * i;
            *(LAS v4u*)(lds + ATT_K_OFF + rr * 128 + ((c ^ (rr & 7)) << 4)) = R.kr[i];
            *(LAS v4u*)(lds + ATT_V_OFF + rr * 128 + ((((c >> 1) ^ (((rr >> 1) & 1) << 1)) << 5) | ((c & 1) << 4))) = R.vr[i]; } }
    const size_t qtok = U.row0 + (size_t)(U.q0 + 32 * w + i32) * U.d;
    __syncthreads();
    if (has_next) band_load(F, Un, Rn);
    f32x16 p[5];
#pragma unroll
    for (int kt = 0; kt < 5; ++kt) { const int row = 32 * w + 32 * kt + i32;
        if (kt == 0 || kt == 4) {
            const LAS f32x4* bt = (const LAS f32x4*)(lds + ATT_BIAS_OFF + (kt == 4 ? 8192 : (U.win == 128 ? 0 : 4096))) + lane;
#pragma unroll
            for (int q4 = 0; q4 < 4; ++q4) { const f32x4 v = bt[q4 * 64]; p[kt][4 * q4 + 0] = v[0]; p[kt][4 * q4 + 1] = v[1]; p[kt][4 * q4 + 2] = v[2]; p[kt][4 * q4 + 3] = v[3]; }
        } else {
#pragma unroll
        for (int r = 0; r < 16; ++r) p[kt][r] = 0.f; }
#pragma unroll
        for (int ks = 0; ks < 4; ++ks) { const bf16x8 kf = *(const LAS bf16x8*)(lds + ATT_K_OFF + row * 128 + (((2 * ks + hi) ^ (row & 7)) << 4));
            p[kt] = MK_BF16 ? __builtin_amdgcn_mfma_f32_32x32x16_bf16(kf, R.qr[ks], p[kt], 0, 0, 0) : __builtin_amdgcn_mfma_f32_32x32x16_f16(__builtin_bit_cast(h16x8, kf), __builtin_bit_cast(h16x8, R.qr[ks]), p[kt], 0, 0, 0); } }
    if (U.q0 == 0 && w < 4) {
#pragma unroll
        for (int kt = 0; kt < 4; ++kt)
#pragma unroll
            for (int r = 0; r < 16; ++r) if (32 * w - 128 + 32 * kt + crow16(r, hi) < 0) p[kt][r] = -INFINITY; }
    float mx = U.sink2;
#pragma unroll
    for (int kt = 0; kt < 5; ++kt)
#pragma unroll
        for (int r = 0; r < 16; ++r) mx = fmaxf(mx, p[kt][r]);
    mx = fmaxf(mx, __shfl_xor(mx, 32));
    float ls = 0.f;
#pragma unroll
    for (int kt = 0; kt < 5; ++kt)
#pragma unroll
        for (int r = 0; r < 16; ++r) { p[kt][r] = fexp2(p[kt][r] - mx); ls += p[kt][r]; }
    ls += __shfl_xor(ls, 32);
    ls += fexp2(U.sink2 - mx);
    f32x16 o[2];
#pragma unroll
    for (int r = 0; r < 16; ++r) { o[0][r] = 0.f; o[1][r] = 0.f; }
    const int q_ = (lane & 15) >> 2;
    const int vbase = ATT_V_OFF + (32 * w + 4 * hi + q_) * 128 + 8 * (lane & 3);
    const int gsw = ((q_ >> 1) & 1) << 1, dh = (lane >> 4) & 1;
#pragma unroll
    for (int kt = 0; kt < 5; ++kt)
#pragma unroll
        for (int s = 0; s < 2; ++s) {
            v4u pw; pw.x = pg8::cvt_pk_h(p[kt][8 * s + 0], p[kt][8 * s + 1]); pw.y = pg8::cvt_pk_h(p[kt][8 * s + 2], p[kt][8 * s + 3]);
            pw.z = pg8::cvt_pk_h(p[kt][8 * s + 4], p[kt][8 * s + 5]); pw.w = pg8::cvt_pk_h(p[kt][8 * s + 6], p[kt][8 * s + 7]);
            const bf16x8 pf = __builtin_bit_cast(bf16x8, pw);
#pragma unroll
            for (int db = 0; db < 2; ++db) { const int a = vbase + (32 * kt + 16 * s) * 128 + ((((2 * db + dh) ^ gsw)) << 5);
                const v4i16_t lo = __builtin_amdgcn_ds_read_tr16_b64_v4i16((LAS v4i16_t*)(lds + a)), hv = __builtin_amdgcn_ds_read_tr16_b64_v4i16((LAS v4i16_t*)(lds + a + 8 * 128));
                const bf16x8 vf = {lo[0], lo[1], lo[2], lo[3], hv[0], hv[1], hv[2], hv[3]};
                o[db] = MK_BF16 ? __builtin_amdgcn_mfma_f32_32x32x16_bf16(pf, vf, o[db], 0, 0, 0) : __builtin_amdgcn_mfma_f32_32x32x16_f16(__builtin_bit_cast(h16x8, pf), __builtin_bit_cast(h16x8, vf), o[db], 0, 0, 0); } }
    LAS float* scr = (LAS float*)(lds + ATT_SCR_OFF) + w * 64;
    if (hi == 0) { scr[i32] = frcp(ls); if (U.LSE) U.LSE[qtok * 8] = mx + __builtin_amdgcn_logf(ls); }
    LDS_WAIT();
    LAS bf16* ost = (LAS bf16*)(lds + ATT_OST_OFF) + w * 2048;
#pragma unroll
    for (int r = 0; r < 16; ++r) { const int qi = crow16(r, hi); const float li = scr[qi];
        ost[qi * 64 + i32] = (bf16)f2h(o[0][r] * li); ost[qi * 64 + 32 + i32] = (bf16)f2h(o[1][r] * li); }
    LDS_WAIT();
#pragma unroll
    for (int i = 0; i < 4; ++i) { const int qi = i * 8 + (lane >> 3), ch = lane & 7; const v4u v = *(const LAS v4u*)(ost + qi * 64 + ch * 8);
        *(v4u*)(U.O + (U.row0 + (size_t)(U.q0 + 32 * w + qi) * U.d) * U.pq + ch * 8) = v; }
    __syncthreads();
}
__device__ __forceinline__ void band_make(Frame& F, int u, const float* sinks, BandUnit& U) {
    if (u < 1536) { const int t32 = u & 31, h = (u >> 5) & 7, g = (u >> 8) % 3, b = u / 768, d = (g == 0) ? 1 : (g == 1 ? 4 : 16), tpc = 32 / d, cls = t32 / tpc;
        bf16* q = (bf16*)(F.ws + (g == 0 ? WS_AQ0 : (g == 1 ? WS_AQ1 : WS_AQ2))) + h * 64;
        U.Q = q; U.O = q; U.K = (const bf16*)(F.ws + WS_AK0 + (size_t)g * 4 * UU) + h * 64; U.V = (const bf16*)(F.ws + WS_AV0 + (size_t)g * 4 * UU) + h * 64;
        U.LSE = (float*)(F.ws + WS_LSE) + (size_t)g * M * 8 + h; U.pq = 512; U.pk = 512; U.d = d; U.q0 = (t32 % tpc) * 256; U.win = 128; U.row0 = (size_t)b * SEQ + cls; U.sink2 = -INFINITY;
    } else { const int ub = u - 1536, t32 = ub & 31, hq = (ub >> 5) & 7, b = ub >> 8;
        bf16* q = (bf16*)(F.ws + WS_BQ) + hq * 64;
        U.Q = q; U.O = q; U.K = (const bf16*)(F.ws + WS_BK) + (hq >> 2) * 64; U.V = (const bf16*)(F.ws + WS_BV) + (hq >> 2) * 64;
        U.LSE = nullptr; U.pq = 512; U.pk = 128; U.d = 1; U.q0 = t32 * 256; U.win = 127; U.row0 = (size_t)b * SEQ; U.sink2 = sinks[hq] * LOG2E; }
}
__device__ __forceinline__ void attn_phase(Frame& F, int l) {
    const float* sinks = inptr(F, 11) + l * 8;
    int u = F.vcu; if (u >= 2048) return;
    BandUnit U, Un; BandRegs R, Rn;
    band_make(F, u, sinks, U); band_load(F, U, R);
    if (F.wave == 0) { const int lane = F.lane, i32 = lane & 31, hi = lane >> 5;
#pragma unroll
        for (int q4 = 0; q4 < 4; ++q4) { f32x4 a, b, c;
#pragma unroll
            for (int e = 0; e < 4; ++e) { const int j = crow16(4 * q4 + e, hi); a[e] = (j < i32) ? -INFINITY : 0.f; b[e] = (j < i32 + 1) ? -INFINITY : 0.f; c[e] = (j > i32) ? -INFINITY : 0.f; }
            LAS f32x4* bt = (LAS f32x4*)(F.lds + ATT_BIAS_OFF) + q4 * 64 + lane; bt[0] = a; bt[256] = b; bt[512] = c; } }
    for (;;) {
        const int nu = u + F.G; const bool has_next = nu < 2048;
        if (has_next) band_make(F, nu, sinks, Un); else Un = U;
        band_unit(F, U, R, has_next, Un, Rn);
        if (!has_next) break;
        U = Un; R = Rn; u = nu;
    }
}
__device__ __forceinline__ void amerge_phase(Frame& F) {
    const float* LSE = (const float*)(F.ws + WS_LSE);
    const int step = F.G * 512, N = M * 64;
    v4u a, b, cc; float l0, l1, l2;
#define AM_FETCH(it_) do { const int row_ = (it_) >> 6, h_ = ((it_) >> 3) & 7, c_ = (it_) & 7; const size_t off_ = (size_t)row_ * 512 + h_ * 64 + c_ * 8; \
        l0 = LSE[(size_t)row_ * 8 + h_]; l1 = LSE[(size_t)M * 8 + (size_t)row_ * 8 + h_]; l2 = LSE[(size_t)2 * M * 8 + (size_t)row_ * 8 + h_]; \
        a = *(const v4u*)((const bf16*)(F.ws + WS_AQ0) + off_); b = *(const v4u*)((const bf16*)(F.ws + WS_AQ1) + off_); cc = *(const v4u*)((const bf16*)(F.ws + WS_AQ2) + off_); } while (0)
    int it = F.vcu * 512 + F.tid;
    if (it < N) AM_FETCH(it);
    for (; it < N; it += step) {
        const int row = it >> 6, h = (it >> 3) & 7, c = it & 7; const size_t off = (size_t)row * 512 + h * 64 + c * 8;
        const v4u a0 = a, b0 = b, c0 = cc; const float m0 = l0, m1 = l1, m2 = l2;
        if (it + step < N) AM_FETCH(it + step);
        const float mx = fmaxf(m0, fmaxf(m1, m2)); float w0 = fexp2(m0 - mx), w1 = fexp2(m1 - mx), w2 = fexp2(m2 - mx); const float inv = frcp(w0 + w1 + w2); w0 *= inv; w1 *= inv; w2 *= inv;
        v4u o;
        o.x = pk2(w0 * hlo(a0.x) + w1 * hlo(b0.x) + w2 * hlo(c0.x), w0 * hhi(a0.x) + w1 * hhi(b0.x) + w2 * hhi(c0.x));
        o.y = pk2(w0 * hlo(a0.y) + w1 * hlo(b0.y) + w2 * hlo(c0.y), w0 * hhi(a0.y) + w1 * hhi(b0.y) + w2 * hhi(c0.y));
        o.z = pk2(w0 * hlo(a0.z) + w1 * hlo(b0.z) + w2 * hlo(c0.z), w0 * hhi(a0.z) + w1 * hhi(b0.z) + w2 * hhi(c0.z));
        o.w = pk2(w0 * hlo(a0.w) + w1 * hlo(b0.w) + w2 * hlo(c0.w), w0 * hhi(a0.w) + w1 * hhi(b0.w) + w2 * hhi(c0.w));
        *(v4u*)((bf16*)(F.ws + WS_AQ0) + off) = o;
    }
#undef AM_FETCH
}

constexpr int GL_LG = 0, GL_K = 8192, GL_Q = 16384, GL_V = 24576, GL_S = 40960, GL_SCR = 57344;
__device__ __forceinline__ int off128(int row, int col) { return row * 128 + ((((col >> 4) ^ (((row >> 1) & 1) << 1))) << 5) + ((col & 15) << 1); }
__device__ __forceinline__ int off256(int row, int col) { return row * 256 + ((((col >> 4) ^ ((row & 3) << 1))) << 5) + ((col & 15) << 1); }
__device__ __forceinline__ v4i16_t trrd(LAS unsigned char* p) { return __builtin_amdgcn_ds_read_tr16_b64_v4i16((LAS v4i16_t*)p); }
template <bool W256> __device__ __forceinline__ bf16x8 tr_frag(LAS unsigned char* img, int rlo, int rhi, int c0, int lane) {
    const int q = (lane & 15) >> 2, col = c0 + 16 * ((lane >> 4) & 1) + 4 * (lane & 3);
    const v4i16_t lo = trrd(img + (W256 ? off256(rlo + q, col) : off128(rlo + q, col))), hv = trrd(img + (W256 ? off256(rhi + q, col) : off128(rhi + q, col)));
    return (bf16x8){lo[0], lo[1], lo[2], lo[3], hv[0], hv[1], hv[2], hv[3]};
}
__device__ __forceinline__ h16x8 tri_frag(int tok, int ks, int h) {
    h16x8 f;
#pragma unroll
    for (int j = 0; j < 8; ++j) f[j] = (16 * ks + 8 * h + j <= tok) ? (_Float16)1.0f : (_Float16)0.0f;
    return f;
}
__device__ __forceinline__ void split8(const float (&x)[8], bf16x8& hi, bf16x8& lo) {
    v4u h, l;
    h.x = pg8::cvt_pk_bf(x[0], x[1]); h.y = pg8::cvt_pk_bf(x[2], x[3]); h.z = pg8::cvt_pk_bf(x[4], x[5]); h.w = pg8::cvt_pk_bf(x[6], x[7]);
    l.x = pg8::cvt_pk_bf(x[0] - bflo(h.x), x[1] - bfhi(h.x)); l.y = pg8::cvt_pk_bf(x[2] - bflo(h.y), x[3] - bfhi(h.y));
    l.z = pg8::cvt_pk_bf(x[4] - bflo(h.z), x[5] - bfhi(h.z)); l.w = pg8::cvt_pk_bf(x[6] - bflo(h.w), x[7] - bfhi(h.w));
    hi = __builtin_bit_cast(bf16x8, h); lo = __builtin_bit_cast(bf16x8, l);
}
__device__ __forceinline__ void split4(const float (&x)[4], v2u& h, v2u& l) {
    h.x = pg8::cvt_pk_bf(x[0], x[1]); h.y = pg8::cvt_pk_bf(x[2], x[3]);
    l.x = pg8::cvt_pk_bf(x[0] - bflo(h.x), x[1] - bfhi(h.x)); l.y = pg8::cvt_pk_bf(x[2] - bflo(h.y), x[3] - bfhi(h.y));
}
constexpr int GL_TP = 136, GL_QH = 61440, GL_QL = GL_QH + 64 * GL_TP, GL_KH = GL_QL + 64 * GL_TP, GL_KL = GL_KH + 64 * GL_TP;
static_assert(GL_KL + 64 * GL_TP <= 131072, "GLA images");
__device__ __forceinline__ void gla_load64(LAS unsigned char* img, const bf16* src, int pitch, int tid) {
    const int row = tid >> 3, c = tid & 7; *(LAS v4u*)(img + off128(row, 8 * c)) = *(const v4u*)(src + (size_t)row * pitch + 8 * c);
}
__device__ __forceinline__ void gla_load128(LAS unsigned char* img, const bf16* src, int pitch, int tid) {
#pragma unroll
    for (int i = 0; i < 2; ++i) { const int row = (tid >> 4) + 32 * i, c = tid & 15; *(LAS v4u*)(img + off256(row, 8 * c)) = *(const v4u*)(src + (size_t)row * pitch + 8 * c); }
}
__device__ __forceinline__ void gla1_phase(Frame& F) {
    const int tid = F.tid, lane = F.lane, w = F.wave, l31 = lane & 31, hi = lane >> 5, db = w >> 2, eb = w & 3;
    LAS unsigned char* lds = F.lds;
    const bf16* CK = (const bf16*)(F.ws + WS_CK); const bf16* CV = (const bf16*)(F.ws + WS_CV); const bf16* LG = (const bf16*)(F.ws + WS_LOGG);
    bf16* ST = (bf16*)(F.ws + WS_STATE); float* DC = (float*)(F.ws + WS_DC);
    v4u rlg, rk, rv[2];
#define GLA1_FETCH(it_) do { const int bh_ = (it_) >> 7, c_ = (it_) & 127; const size_t r0_ = (size_t)(bh_ >> 2) * SEQ + c_ * 64; const int h_ = bh_ & 3, ra_ = tid >> 3, ca_ = (tid & 7) * 8; \
        rlg = *(const v4u*)(LG + (r0_ + ra_) * 256 + h_ * 64 + ca_); rk = *(const v4u*)(CK + (r0_ + ra_) * 256 + h_ * 64 + ca_); \
        _Pragma("unroll") for (int i_ = 0; i_ < 2; ++i_) { const int rb_ = (tid >> 4) + 32 * i_, cb_ = (tid & 15) * 8; rv[i_] = *(const v4u*)(CV + (r0_ + rb_) * 512 + h_ * 128 + cb_); } } while (0)
    if (F.bx < 8 * 128) GLA1_FETCH(F.bx);
    for (int item = F.bx; item < 8 * 128; item += F.G) {
        { const int ra = tid >> 3, ca = (tid & 7) * 8;
            *(LAS v4u*)(lds + GL_LG + off128(ra, ca)) = rlg; *(LAS v4u*)(lds + GL_K + off128(ra, ca)) = rk;
#pragma unroll
            for (int i = 0; i < 2; ++i) { const int rb = (tid >> 4) + 32 * i, cb = (tid & 15) * 8; *(LAS v4u*)(lds + GL_V + off256(rb, cb)) = rv[i]; } }
        __syncthreads();
        if (item + F.G < 8 * 128) GLA1_FETCH(item + F.G);
        f32x16 bN[2];
#pragma unroll
        for (int tb = 0; tb < 2; ++tb) {
#pragma unroll
            for (int r = 0; r < 16; ++r) bN[tb][r] = 0.f;
#pragma unroll
            for (int ks = 0; ks < 2 * tb + 2; ++ks) { const h16x8 lg = __builtin_bit_cast(h16x8, tr_frag<false>(lds + GL_LG, 16 * ks + 8 * hi, 16 * ks + 8 * hi + 4, 32 * db, lane));
                bN[tb] = __builtin_amdgcn_mfma_f32_32x32x16_f16(tri_frag(32 * tb + l31, ks, hi), lg, bN[tb], 0, 0, 0); } }
        const float bl = __shfl(bN[1][15], 32 + l31);
        f32x16 ut;
#pragma unroll
        for (int r = 0; r < 16; ++r) ut[r] = 0.f;
#pragma unroll
        for (int tb = 0; tb < 2; ++tb) { float kp[16];
#pragma unroll
            for (int g = 0; g < 4; ++g) { const v4i16_t kv = trrd(lds + GL_K + off128(32 * tb + 8 * g + 4 * hi + ((lane & 15) >> 2), 32 * db + 16 * ((lane >> 4) & 1) + 4 * (lane & 3)));
#pragma unroll
                for (int q = 0; q < 4; ++q) kp[4 * g + q] = h2f16((unsigned short)kv[q]) * fexp(bl - bN[tb][4 * g + q]); }
#pragma unroll
            for (int s = 0; s < 2; ++s) { const float x8[8] = {kp[8 * s + 0], kp[8 * s + 1], kp[8 * s + 2], kp[8 * s + 3], kp[8 * s + 4], kp[8 * s + 5], kp[8 * s + 6], kp[8 * s + 7]}; bf16x8 kh, kl; split8(x8, kh, kl);
                const bf16x8 vf = tr_frag<true>(lds + GL_V, 32 * tb + 16 * s + 4 * hi, 32 * tb + 16 * s + 8 + 4 * hi, 32 * eb, lane);
                ut = __builtin_amdgcn_mfma_f32_32x32x16_bf16(vf, kh, ut, 0, 0, 0); ut = __builtin_amdgcn_mfma_f32_32x32x16_bf16(vf, kl, ut, 0, 0, 0); } }
        bf16* dst = ST + ((size_t)item * 64 + 32 * db + l31) * 128 + 32 * eb + 4 * hi;
#pragma unroll
        for (int g = 0; g < 4; ++g) { v2u o; o.x = pg8::cvt_pk_bf(ut[4 * g + 0], ut[4 * g + 1]); o.y = pg8::cvt_pk_bf(ut[4 * g + 2], ut[4 * g + 3]); *(v2u*)(dst + 8 * g) = o; }
        if (eb == 0 && hi == 0) DC[(size_t)item * 64 + 32 * db + l31] = fexp(bl);
        __syncthreads();
    }
}
#undef GLA1_FETCH
constexpr int SCAN_DC_OFF = RSTD_OFF;
__device__ __forceinline__ void gla2_phase(Frame& F) {
    bf16* ST = (bf16*)(F.ws + WS_STATE); const float* DC = (const float*)(F.ws + WS_DC);
    const int tid = F.tid; LAS unsigned char* lds = F.lds; LAS float* dct = (LAS float*)(lds + SCAN_DC_OFF);
    for (int item = F.vcu; item < 8 * 32; item += F.G) {
        const int bh = item >> 5, d0 = (item & 31) * 2;
        bf16* base = ST + ((size_t)bh * 128 * 64 + d0) * 128;
        { v4u r[8];
#pragma unroll
            for (int i = 0; i < 8; ++i) { const int q = tid + 512 * i, c = q >> 5, o = (q & 31) * 8; r[i] = *(const v4u*)(base + (size_t)c * 64 * 128 + o); }
            const float dcv = (tid < 256) ? DC[((size_t)bh * 128 + (tid >> 1)) * 64 + d0 + (tid & 1)] : 0.f;
#pragma unroll
            for (int i = 0; i < 8; ++i) { const int q = tid + 512 * i; *(LAS v4u*)(lds + q * 16) = r[i]; }
            if (tid < 256) dct[tid] = dcv; }
        __syncthreads();
        if (tid < 256) { const int dl = tid >> 7; LAS bf16* p = (LAS bf16*)lds + tid; float S = 0.f;
#pragma unroll 8
            for (int c = 0; c < 128; ++c) { const float u = bf2f(p[c * 256]); p[c * 256] = (bf16)f2bf(S); S = dct[c * 2 + dl] * S + u; } }
        __syncthreads();
        { v4u r[8];
#pragma unroll
            for (int i = 0; i < 8; ++i) { const int q = tid + 512 * i; r[i] = *(const LAS v4u*)(lds + q * 16); }
#pragma unroll
            for (int i = 0; i < 8; ++i) { const int q = tid + 512 * i, c = q >> 5, o = (q & 31) * 8; *(v4u*)(base + (size_t)c * 64 * 128 + o) = r[i]; } }
        __syncthreads();
    }
}
__device__ __forceinline__ void gla3_phase(Frame& F, int l) {
    const int tid = F.tid, lane = F.lane, w = F.wave, l31 = lane & 31, hi = lane >> 5, tb = w >> 2, eb = w & 3;
    LAS unsigned char* lds = F.lds;
    const bf16* CQ = (const bf16*)(F.ws + WS_CQ); const bf16* CK = (const bf16*)(F.ws + WS_CK); bf16* CV = (bf16*)(F.ws + WS_CV); const bf16* LG = (const bf16*)(F.ws + WS_LOGG);
    const bf16* CR = (const bf16*)(F.ws + WS_CR); const bf16* ST = (const bf16*)(F.ws + WS_STATE); const float* gain = inptr(F, 14) + l * 128;
    LAS float* scr = (LAS float*)(lds + GL_SCR);
    v4u rlg, rk, rq, rv[2], rs[2];
#define GLA3_FETCH(it_) do { const int bh_ = (it_) >> 7, c_ = (it_) & 127; const size_t r0_ = (size_t)(bh_ >> 2) * SEQ + c_ * 64; const int h_ = bh_ & 3, ra_ = tid >> 3, ca_ = (tid & 7) * 8; \
        rlg = *(const v4u*)(LG + (r0_ + ra_) * 256 + h_ * 64 + ca_); rk = *(const v4u*)(CK + (r0_ + ra_) * 256 + h_ * 64 + ca_); rq = *(const v4u*)(CQ + (r0_ + ra_) * 256 + h_ * 64 + ca_); \
        _Pragma("unroll") for (int i_ = 0; i_ < 2; ++i_) { const int rb_ = (tid >> 4) + 32 * i_, cb_ = (tid & 15) * 8; rv[i_] = *(const v4u*)(CV + (r0_ + rb_) * 512 + h_ * 128 + cb_); rs[i_] = *(const v4u*)(ST + (size_t)(it_) * 64 * 128 + rb_ * 128 + cb_); } } while (0)
    f32x4 gnv[4];
#pragma unroll
    for (int g = 0; g < 4; ++g) gnv[g] = *(const f32x4*)(gain + 32 * eb + 4 * hi + 8 * g);
    if (F.bx < 8 * 128) GLA3_FETCH(F.bx);
    for (int item = F.bx; item < 8 * 128; item += F.G) {
        const int bh = item >> 7, c = item & 127, b = bh >> 2, h = bh & 3; const size_t row0 = (size_t)b * SEQ + c * 64;
        { const int ra = tid >> 3, ca = (tid & 7) * 8;
            *(LAS v4u*)(lds + GL_LG + off128(ra, ca)) = rlg; *(LAS v4u*)(lds + GL_K + off128(ra, ca)) = rk; *(LAS v4u*)(lds + GL_Q + off128(ra, ca)) = rq;
#pragma unroll
            for (int i = 0; i < 2; ++i) { const int rb = (tid >> 4) + 32 * i, cb = (tid & 15) * 8; *(LAS v4u*)(lds + GL_V + off256(rb, cb)) = rv[i]; *(LAS v4u*)(lds + GL_S + off256(rb, cb)) = rs[i]; } }
        __syncthreads();
        if (item + F.G < 8 * 128) GLA3_FETCH(item + F.G);
        v2u crv[4];
        { const size_t tok_ = row0 + 32 * tb + l31; const int ecol_ = h * 128 + 32 * eb + 4 * hi;
#pragma unroll
            for (int g = 0; g < 4; ++g) crv[g] = *(const v2u*)(CR + tok_ * 512 + ecol_ + 8 * g); }
        {   const int dbi = w & 1, xb = (w >> 1) & 1, gh = w >> 2, t = 32 * xb + l31;
            f32x16 bt;
#pragma unroll
            for (int r = 0; r < 16; ++r) bt[r] = 0.f;
            for (int ks = 0; ks < 2 * xb + 2; ++ks) { const h16x8 lg = __builtin_bit_cast(h16x8, tr_frag<false>(lds + GL_LG, 16 * ks + 8 * hi, 16 * ks + 8 * hi + 4, 32 * dbi, lane));
                bt = __builtin_amdgcn_mfma_f32_32x32x16_f16(lg, tri_frag(t, ks, hi), bt, 0, 0, 0); }
#pragma unroll
            for (int gg = 0; gg < 2; ++gg) { const int dcol = 32 * dbi + 8 * (2 * gh + gg) + 4 * hi;
                const v2u qa = *(const LAS v2u*)(lds + GL_Q + off128(t, dcol)), ka = *(const LAS v2u*)(lds + GL_K + off128(t, dcol));
                const float qv[4] = {hlo16(qa.x), hhi16(qa.x), hlo16(qa.y), hhi16(qa.y)}, kv[4] = {hlo16(ka.x), hhi16(ka.x), hlo16(ka.y), hhi16(ka.y)}; float qx[4], kx[4];
#pragma unroll
                for (int j = 0; j < 4; ++j) { const float bb = gh == 0 ? bt[4 * gg + j] : bt[8 + 4 * gg + j]; qx[j] = qv[j] * fexp(bb); kx[j] = kv[j] * fexp(-bb); }
                v2u qh, ql2, kh2, kl2; split4(qx, qh, ql2); split4(kx, kh2, kl2);
                const int o = t * GL_TP + dcol * 2;
                *(LAS v2u*)(lds + GL_QH + o) = qh; *(LAS v2u*)(lds + GL_QL + o) = ql2; *(LAS v2u*)(lds + GL_KH + o) = kh2; *(LAS v2u*)(lds + GL_KL + o) = kl2; } }
        __syncthreads();
        bf16x8 qf[2][2], ql[2][2];
#pragma unroll
        for (int dbi = 0; dbi < 2; ++dbi)
#pragma unroll
            for (int s = 0; s < 2; ++s) { const int o = (32 * tb + l31) * GL_TP + (32 * dbi + 16 * s + 4 * hi) * 2;
                const v2u a = *(const LAS v2u*)(lds + GL_QH + o), b2 = *(const LAS v2u*)(lds + GL_QH + o + 16), c = *(const LAS v2u*)(lds + GL_QL + o), d2 = *(const LAS v2u*)(lds + GL_QL + o + 16);
                qf[dbi][s] = __builtin_bit_cast(bf16x8, (v4u){a.x, a.y, b2.x, b2.y}); ql[dbi][s] = __builtin_bit_cast(bf16x8, (v4u){c.x, c.y, d2.x, d2.y}); }
        f32x16 ot;
#pragma unroll
        for (int r = 0; r < 16; ++r) ot[r] = 0.f;
#pragma unroll
        for (int dbi = 0; dbi < 2; ++dbi)
#pragma unroll
            for (int s = 0; s < 2; ++s) { const bf16x8 sf = tr_frag<true>(lds + GL_S, 32 * dbi + 16 * s + 4 * hi, 32 * dbi + 16 * s + 8 + 4 * hi, 32 * eb, lane);
                ot = __builtin_amdgcn_mfma_f32_32x32x16_bf16(sf, qf[dbi][s], ot, 0, 0, 0); ot = __builtin_amdgcn_mfma_f32_32x32x16_bf16(sf, ql[dbi][s], ot, 0, 0, 0); }
#pragma unroll
        for (int sb = 0; sb < 2; ++sb) if (sb <= tb) {
            f32x16 at;
#pragma unroll
            for (int r = 0; r < 16; ++r) at[r] = 0.f;
#pragma unroll
            for (int dbi = 0; dbi < 2; ++dbi)
#pragma unroll
                for (int s = 0; s < 2; ++s) { const int o = (32 * sb + l31) * GL_TP + (32 * dbi + 16 * s + 4 * hi) * 2;
                    const v2u a = *(const LAS v2u*)(lds + GL_KH + o), b2 = *(const LAS v2u*)(lds + GL_KH + o + 16), c = *(const LAS v2u*)(lds + GL_KL + o), d2 = *(const LAS v2u*)(lds + GL_KL + o + 16);
                    const bf16x8 kh = __builtin_bit_cast(bf16x8, (v4u){a.x, a.y, b2.x, b2.y}), kl = __builtin_bit_cast(bf16x8, (v4u){c.x, c.y, d2.x, d2.y});
                    at = __builtin_amdgcn_mfma_f32_32x32x16_bf16(kh, qf[dbi][s], at, 0, 0, 0); at = __builtin_amdgcn_mfma_f32_32x32x16_bf16(kl, qf[dbi][s], at, 0, 0, 0); at = __builtin_amdgcn_mfma_f32_32x32x16_bf16(kh, ql[dbi][s], at, 0, 0, 0); }
            if (sb == tb) {
#pragma unroll
                for (int r = 0; r < 16; ++r) if (crow16(r, hi) > l31) at[r] = 0.f; }
#pragma unroll
            for (int s = 0; s < 2; ++s) { const float x8[8] = {at[8 * s + 0], at[8 * s + 1], at[8 * s + 2], at[8 * s + 3], at[8 * s + 4], at[8 * s + 5], at[8 * s + 6], at[8 * s + 7]}; bf16x8 ph, pl; split8(x8, ph, pl);
                const bf16x8 vf = tr_frag<true>(lds + GL_V, 32 * sb + 16 * s + 4 * hi, 32 * sb + 16 * s + 8 + 4 * hi, 32 * eb, lane);
                ot = __builtin_amdgcn_mfma_f32_32x32x16_bf16(vf, ph, ot, 0, 0, 0); ot = __builtin_amdgcn_mfma_f32_32x32x16_bf16(vf, pl, ot, 0, 0, 0); } }
        float q2 = 0.f;
#pragma unroll
        for (int r = 0; r < 16; ++r) q2 += ot[r] * ot[r];
        q2 = xsum32(q2);
        if (hi == 0) scr[(tb * 4 + eb) * 32 + l31] = q2;
        __syncthreads();
        const float rn = 1.0f / sqrtf(((scr[(tb * 4 + 0) * 32 + l31] + scr[(tb * 4 + 1) * 32 + l31]) + (scr[(tb * 4 + 2) * 32 + l31] + scr[(tb * 4 + 3) * 32 + l31])) * (1.0f / 128.0f) + NORM_EPS);
        const size_t tok = row0 + 32 * tb + l31; const int ecol = h * 128 + 32 * eb + 4 * hi;
#pragma unroll
        for (int g = 0; g < 4; ++g) { const v2u cr = crv[g]; const f32x4 gn = gnv[g];
            v2u o; o.x = pg8::cvt_pk_h(ot[4 * g + 0] * rn * gn[0] * hlo(cr.x), ot[4 * g + 1] * rn * gn[1] * hhi(cr.x)); o.y = pg8::cvt_pk_h(ot[4 * g + 2] * rn * gn[2] * hlo(cr.y), ot[4 * g + 3] * rn * gn[3] * hhi(cr.y));
            *(v2u*)(CV + tok * 512 + ecol + 8 * g) = o; }
        __syncthreads();
    }
}
#undef GLA3_FETCH

__device__ __forceinline__ void xcd_barrier_shadow(const XcdBarrier& b, Frame& F, int ph) {
    asm volatile("s_waitcnt vmcnt(0)" ::: "memory");
    __syncthreads();
    if (F.wave == 0) __builtin_amdgcn_s_setprio(3);
    if (F.tid == 0) {
        unsigned* bar = b.bar;
        __builtin_amdgcn_s_waitcnt(0);
        unsigned nloc = b.st[0], nx = b.st[1];
        if (nloc == 0u) { xcd_barrier_complete(bar, b.x, nloc, nx); b.st[0] = nloc; b.st[1] = nx; }
        const unsigned old = xb_add(&bar[XB_XSUB(b.x)], 1u);
        const unsigned gen = old / nloc;
        if (old + 1u == (gen + 1u) * nloc) {
            __builtin_amdgcn_fence(__ATOMIC_RELEASE, "agent");
            asm volatile("s_waitcnt vmcnt(0)" ::: "memory");
            const unsigned og = xb_add(&bar[XB_TOP], 1u);
            const unsigned tg = og / nx;
            __builtin_amdgcn_fence(__ATOMIC_ACQUIRE, "agent");
            if (og + 1u == (tg + 1u) * nx) xb_add(&bar[XB_TOPGEN], 1u);
            else XB_SPIN(xb_ld(&bar[XB_TOPGEN]) == tg, bar);
            xb_add(&bar[XB_XGEN(b.x)], 1u);
            asm volatile("s_waitcnt vmcnt(0)" ::: "memory");
        } else {
            __builtin_amdgcn_fence(__ATOMIC_ACQUIRE, "agent");
            XB_SPIN(xb_ld(&bar[XB_XGEN(b.x)]) == gen, bar);
            asm volatile("s_waitcnt vmcnt(0)" ::: "memory");
        }
    } else if (F.wave != 0) {
        shadow_conv(F, ph);
    }
    if (F.wave == 0) __builtin_amdgcn_s_setprio(0);
    __syncthreads();
}
template <class T> __device__ __forceinline__ T* launder(T* p) {
    unsigned long long v = (unsigned long long)p; unsigned lo = (unsigned)v, hi = (unsigned)(v >> 32);
    asm volatile("" : "+s"(lo), "+s"(hi));
    return (T*)(GAS T*)(((unsigned long long)hi << 32) | lo);
}
#ifndef PROBE_CAT
#define PROBE_CAT (-1)
#endif
#define TB() unsigned long long t0_ = (PROBE_CAT >= 0) ? __builtin_amdgcn_s_memrealtime() : 0ull; unsigned long long c0_ = (PROBE_CAT == 98) ? __builtin_readcyclecounter() : 0ull
#define TE(cat) do { if ((cat) == PROBE_CAT || (PROBE_CAT == 97 && (cat) < 10)) tacc_ += __builtin_amdgcn_s_memrealtime() - t0_; if (PROBE_CAT == 98 && (cat) == 10) tacc_ += (__builtin_readcyclecounter() - c0_) >> 5; (void)c0_; } while (0)
template <class Sched> __device__ __forceinline__ int rstd_table(Frame& F, const Sched& S) {
    pg8::Unit u; if (!S.next(0, u)) return -1;
    if (F.tid < 256) { const f32x4* p = (const f32x4*)((const float*)(F.ws + WS_SSQ) + (size_t)(u.pm * 256 + F.tid) * 16); const f32x4 a = p[0], b = p[1], c = p[2], d = p[3]; const f32x4 s = (a + b) + (c + d);
        ((LAS float*)(F.lds + RSTD_OFF))[F.tid] = 1.0f / sqrtf(((s[0] + s[1]) + (s[2] + s[3])) * (1.0f / DM) + NORM_EPS); }
    __syncthreads();
    return u.pm;
}
constexpr int PH_PER_LAYER = 10, N_PHASES = 1 + NLAYER * PH_PER_LAYER;
struct Args { const void* in[20]; float* out; unsigned char* ws; int ph_lo, ph_hi, li, pad; };
__global__ void __launch_bounds__(NWAVES * 64, 2) mk_fwd(Args args) {
    extern __shared__ __attribute__((aligned(16))) unsigned char lds[];
    Frame F;
    F.lds = (LAS unsigned char*)lds;
    F.MISC = (volatile LAS unsigned*)(F.lds + MISC_OFF);
    F.tid = threadIdx.x; F.lane = F.tid & 63; F.wave = __builtin_amdgcn_readfirstlane(F.tid >> 6); const int wave0_ = F.wave;
    F.G = gridDim.x; F.bx = blockIdx.x; F.vcu = 0;
    F.ws = args.ws; F.X = args.out;
    F.ctl = (gu32*)(args.ws + WS_CTL);
    for (int u = F.tid; u < (LDS_BYTES - LDSCTL_OFF) / 4; u += NWAVES * 64) ((LAS unsigned*)(F.lds + LDSCTL_OFF))[u] = 0u;
    __syncthreads();
    if (F.tid == 0) {
#pragma unroll
        for (int i = 0; i < 20; ++i) ((LAS unsigned long long*)(F.lds + INTAB_OFF))[i] = (unsigned long long)args.in[i];
    }
    __syncthreads();
    XcdBarrier bar; bar.bar = (unsigned*)(F.ctl + CW_BAR); bar.x = 0; bar.st = nullptr;
    if (!MK_PER_PHASE) bar = xcd_barrier_post((unsigned*)(F.ctl + CW_BAR), F.MISC + 8);
#ifdef EXTRA_BARS
    for (int i_ = 0; i_ < EXTRA_BARS; ++i_) xcd_barrier(bar);
#endif
    unsigned long long tacc_ = 0ull; const unsigned long long tk0_ = (PROBE_CAT == 99) ? __builtin_amdgcn_s_memrealtime() : 0ull;
    for (int ph = args.ph_lo; ph < args.ph_hi; ++ph) {
        { int wv_ = wave0_; asm volatile("" : "+s"(wv_)); int t_ = wv_ * 64 + (int)__builtin_amdgcn_mbcnt_hi(~0u, __builtin_amdgcn_mbcnt_lo(~0u, 0u)); asm volatile("" : "+v"(t_)); t_ &= 511;
          F.tid = t_; F.lane = t_ & 63; F.wave = __builtin_amdgcn_readfirstlane(t_ >> 6); }
        F.ws = launder(args.ws); F.X = launder(args.out);
        { int bx_ = blockIdx.x, g_ = gridDim.x; asm volatile("" : "+s"(bx_), "+s"(g_)); F.bx = bx_; F.G = g_; F.vcu = (g_ % 8 == 0) ? (bx_ % 8) * (g_ / 8) + bx_ / 8 : bx_; }
        const float* ssq = (const float*)(F.ws + WS_SSQ);
        pg8::bf16_t* XB = (pg8::bf16_t*)(F.ws + WS_XB);
        if (ph == 0) {
            { TB(); p0_rows(F); conv_set(F, 0, 0); TE(4); }
        } else {
            const int l = (ph - 1) / PH_PER_LAYER, k = (ph - 1) % PH_PER_LAYER;
            if (k == 0 || k == 8) {
                pg8::Gemm g{XB, XB, XB, (const pg8::bf16_t*)(F.ws + WS_S1), nullptr, nullptr, M, 2 * DFF, DM};
                pg8::StaticOrder S; S.init(M, 2 * DFF, F.G, F.bx);
                pg8::Unit u0_; const int rpm = S.next(0, u0_) ? u0_.pm : -1; pg8::EpiSwiglu E{(pg8::bf16_t*)(F.ws + WS_ACTH), ssq, (const LAS float*)(F.lds + RSTD_OFF), rpm};
                { TB(); pg8::gemm_phase<pg8::EpiSwiglu, pg8::StaticOrder, true>(F.lds + RING_OFF, g, S, E, F.tid); TE(0); TE(10); }
                { const int rem = S.nwg % F.G; if (rem == 0) tail_conv(F, ph, F.bx, F.G); else if (F.bx >= rem) tail_conv(F, ph, F.bx - rem, F.G - rem); }
            } else if (k == 1 || k == 9) {
                { TB(); if (k == 9 && l + 1 < NLAYER) { conv_set(F, 0, l + 1); __syncthreads(); } TE(4); }
                const pg8::bf16_t* A = (const pg8::bf16_t*)(F.ws + WS_ACTH);
                pg8::Gemm g{A, A, A, (const pg8::bf16_t*)(F.ws + WS_S2), nullptr, nullptr, M, DM, DFF};
                pg8::StaticOrder S; S.init(M, DM, F.G, F.bx);
                pg8::EpiResidual E{(k == 9 && l == NLAYER - 1) ? F.X : nullptr, XB, (float*)(F.ws + WS_SSQ), 0.5f, 2.0f};
                { TB(); pg8::gemm_phase<pg8::EpiResidual, pg8::StaticOrder, true>(F.lds + RING_OFF, g, S, E, F.tid); TE(0); TE(11); }
            } else if (k == 2) {
                pg8::Gemm g{XB, XB, XB, (const pg8::bf16_t*)(F.ws + WS_STATE), nullptr, nullptr, M, 7168, DM};
                pg8::StaticOrder S; S.init(M, 7168, F.G, F.bx);
                pg8::Unit u0_; const int rpm = S.next(0, u0_) ? u0_.pm : -1; pg8::EpiInProj E{F.ws, ssq, (const pg8::bf16_t*)(F.ws + WS_COS), (const LAS float*)(F.lds + RSTD_OFF), rpm, inptr(F, 7) + l * 64, inptr(F, 8) + l * 64, inptr(F, 9) + l * 64, inptr(F, 10) + l * 64, inptr(F, 13) + l * 256};
                { TB(); pg8::gemm_phase<pg8::EpiInProj, pg8::StaticOrder, true>(F.lds + RING_OFF, g, S, E, F.tid); TE(0); TE(12); }
            } else if (k == 3) {
                { TB(); gla1_phase(F); __syncthreads(); TE(2); } { TB(); attn_phase(F, l); TE(1); }
            } else if (k == 4) { { TB(); gla2_phase(F); TE(3); } { TB(); amerge_phase(F); TE(6); }
            } else if (k == 5) {
                { TB(); gla3_phase(F, l); __syncthreads(); TE(3); }
                pg8::Gemm g{XB, XB, XB, (const pg8::bf16_t*)(F.ws + WS_WG), nullptr, nullptr, M, 3 * DM, DM};
                pg8::StaticOrder S; S.init(M, 3 * DM, F.G, F.bx);
                pg8::Unit u0_; const int rpm = S.next(0, u0_) ? u0_.pm : -1; pg8::EpiSigmoid E{(pg8::bf16_t*)(F.ws + WS_GATES), ssq, (const LAS float*)(F.lds + RSTD_OFF), rpm};
                { TB(); pg8::gemm_phase<pg8::EpiSigmoid, pg8::StaticOrder, true>(F.lds + RING_OFF, g, S, E, F.tid); TE(0); TE(13); }
            } else if (k == 6) {
                const pg8::bf16_t* WB = (const pg8::bf16_t*)(F.ws + WS_WB);
                pg8::Gemm g{(const pg8::bf16_t*)(F.ws + WS_AQ0), (const pg8::bf16_t*)(F.ws + WS_BQ), (const pg8::bf16_t*)(F.ws + WS_CV), WB, WB + (size_t)DM * 512, WB + (size_t)2 * DM * 512, M, DM, 512};
                pg8::Seg3Order S; S.b.init(M, DM, F.G, F.bx);
                pg8::EpiMerge E{(const pg8::bf16_t*)(F.ws + WS_GATES), (pg8::bf16_t*)(F.ws + WS_MERGED)};
                { TB(); pg8::gemm_phase<pg8::EpiMerge, pg8::Seg3Order, true>(F.lds + RING_OFF, g, S, E, F.tid); TE(0); TE(14); }
            } else if (k == 7) {
                const pg8::bf16_t* A = (const pg8::bf16_t*)(F.ws + WS_MERGED);
                pg8::Gemm g{A, A, A, (const pg8::bf16_t*)(F.ws + WS_WO), nullptr, nullptr, M, DM, DM};
                pg8::StaticOrder S; S.init(M, DM, F.G, F.bx);
                pg8::EpiResidual E{nullptr, XB, (float*)(F.ws + WS_SSQ), 1.0f, 1.0f};
                { TB(); pg8::gemm_phase<pg8::EpiResidual, pg8::StaticOrder, true>(F.lds + RING_OFF, g, S, E, F.tid); TE(0); TE(15); }
            }
        }
        if (ph + 1 < args.ph_hi) { TB(); xcd_barrier_shadow(bar, F, ph); TE(5); }
    }
    if (PROBE_CAT == 99) tacc_ = __builtin_amdgcn_s_memrealtime() - tk0_;
    if (PROBE_CAT >= 0 && blockIdx.x == 0 && threadIdx.x == 0) { const unsigned long long ts_ = __builtin_amdgcn_s_memrealtime(); while (__builtin_amdgcn_s_memrealtime() - ts_ < tacc_) __builtin_amdgcn_s_sleep(8); }
}

extern "C" void kernel_launch(void* const* d_in, const int* in_sizes, int n_in, void* d_out, int out_size, void* d_ws, size_t ws_size, hipStream_t stream) {
    static int grid = 0;
    if (grid == 0) {
        if (n_in != 20 || out_size != M * DM || ws_size < WS_END) { fprintf(stderr, "kernel_launch: unexpected problem (n_in %d, out %d, ws %zu < %zu); nothing launched\n", n_in, out_size, ws_size, (size_t)WS_END); grid = -1; return; }
        int dev = 0, cus = 0, per_cu = 0;
        if (hipGetDevice(&dev) != hipSuccess || hipDeviceGetAttribute(&cus, hipDeviceAttributeMultiprocessorCount, dev) != hipSuccess) { grid = -1; return; }
        if (hipFuncSetAttribute((const void*)mk_fwd, hipFuncAttributeMaxDynamicSharedMemorySize, LDS_BYTES) != hipSuccess) { fprintf(stderr, "kernel_launch: hipFuncSetAttribute failed\n"); grid = -1; return; }
        if (hipOccupancyMaxActiveBlocksPerMultiprocessor(&per_cu, (const void*)mk_fwd, NWAVES * 64, LDS_BYTES) != hipSuccess || per_cu < 1)
            fprintf(stderr, "kernel_launch: note: occupancy query reports %d workgroups per CU\n", per_cu);
        (void)hipGetLastError();
        grid = cus;
    }
    if (grid < 0) return;
    if (hipMemsetAsync((char*)d_ws + WS_CTL, 0, CTL_ZERO_BYTES, stream) != hipSuccess) return;
    Args a{};
    for (int i = 0; i < 20; ++i) a.in[i] = d_in[i];
    a.out = (float*)d_out; a.ws = (unsigned char*)d_ws;
#if MK_PER_PHASE
    for (int p = 0; p < N_PHASES; ++p) { a.ph_lo = p; a.ph_hi = p + 1; a.li = p; hipLaunchKernelGGL(mk_fwd, dim3(grid), dim3(NWAVES * 64), LDS_BYTES, stream, a); }
#else
    a.ph_lo = 0; a.ph_hi = N_PHASES; a.li = 0;
    hipLaunchKernelGGL(mk_fwd, dim3(grid), dim3(NWAVES * 64), LDS_BYTES, stream, a);
#endif
}
```
